# Optimizing an MI355X kernel written in HIP

```python
import math
import jax
import jax.numpy as jnp
from jax import lax
import numpy as np

D_MODEL = 1024
BATCH = 4
SEQ = 8192
DEPTH = 2

CTX_LEN = 256
GRID_W = 64
QBLOCK = 128
ROPE_THETA = 10000.0
EPS = 1e-6
F32 = jnp.float32

DIFF_HEADS = 4
DIFF_HEAD_DIM = 64
LRU_WIDTH = 512
LRU_BLOCKS = 8
LRU_BW = LRU_WIDTH // LRU_BLOCKS
CONV_W = 4
LRU_C = 8.0
GQA_HEADS = 8
GQA_KV_HEADS = 2
GQA_HEAD_DIM = 64
MLA_HEADS = 8
MLA_Q_RANK = 256
MLA_KV_RANK = 128
MLA_NOPE = 32
MLA_ROPE = 16
MLA_V = 64
N_EXPERTS = 64
N_GROUPS = 8
TOPK_GROUPS = 4
TOP_K = 8
EXPERT_FF = 256
SHARED_FF = 256
ROUTED_SCALE = 2.5
MOE_BLOCK = 128

AB_SPLITS = (DIFF_HEADS * 2 * DIFF_HEAD_DIM, DIFF_HEADS * 2 * DIFF_HEAD_DIM,
             DIFF_HEADS * 2 * DIFF_HEAD_DIM, LRU_WIDTH, LRU_WIDTH)
AB_IN = sum(AB_SPLITS)
AB_OUT = DIFF_HEADS * 2 * DIFF_HEAD_DIM + LRU_WIDTH
CD_SPLITS = (GQA_HEADS * GQA_HEAD_DIM, GQA_KV_HEADS * GQA_HEAD_DIM, GQA_KV_HEADS * GQA_HEAD_DIM,
             MLA_Q_RANK, MLA_KV_RANK, MLA_ROPE)
CD_IN = sum(CD_SPLITS)
CD_OUT = GQA_HEADS * GQA_HEAD_DIM + MLA_HEADS * MLA_V

kernel_name = 'hybrid_diffattn_rglru_gqa_mla_moe'


def split_cols(p, sizes):
    return jnp.split(p, np.cumsum(sizes)[:-1].tolist(), axis=-1)


def rms_norm(x):
    xf = x.astype(F32)
    return (xf * lax.rsqrt(jnp.mean(xf * xf, axis=-1, keepdims=True) + EPS)).astype(x.dtype)


def modulate(x, shift, scale):
    return rms_norm(x) * (1.0 + scale) + shift


def grid_positions(length):
    rows = length // GRID_W
    row = jnp.repeat(jnp.arange(rows, dtype=F32), GRID_W)
    col = jnp.tile(jnp.arange(GRID_W, dtype=F32), rows)
    return row, col


def _rotate(x, pos):
    m = x.shape[-1]
    inv = ROPE_THETA ** (-jnp.arange(0, m, 2, dtype=F32) / m)
    ang = pos[:, None] * inv[None, :]
    cos, sin = jnp.cos(ang), jnp.sin(ang)
    x1 = x[..., : m // 2].astype(F32)
    x2 = x[..., m // 2:].astype(F32)
    return jnp.concatenate([x1 * cos - x2 * sin, x1 * sin + x2 * cos], axis=-1)


def axial_rope(x, row, col):
    half = x.shape[-1] // 2
    out = jnp.concatenate([_rotate(x[..., :half], row), _rotate(x[..., half:], col)], axis=-1)
    return out.astype(x.dtype)


def sweep_query_blocks(fn, q):
    L = q.shape[-2]
    nb = L // QBLOCK
    qb = jnp.moveaxis(q.reshape(q.shape[:-2] + (nb, QBLOCK, q.shape[-1])), -3, 0)
    out = jnp.moveaxis(lax.map(fn, qb), 0, -3)
    return out.reshape(out.shape[:-3] + (L, out.shape[-1]))


def gqa_attention(q, k, v):
    scale = q.shape[-1] ** -0.5

    def block(qb):
        s = jnp.einsum('bkgqd,bkmd->bkgqm', qb, k).astype(F32) * scale
        p = jax.nn.softmax(s, axis=-1)
        return jnp.einsum('bkgqm,bkmd->bkgqd', p.astype(v.dtype), v)

    return sweep_query_blocks(block, q)


def diff_attention(q, k, v, lam):
    scale = q.shape[-1] ** -0.5

    def block(qb):
        s = jnp.einsum('bhjqd,bhjmd->bhjqm', qb, k).astype(F32) * scale
        p = jax.nn.softmax(s, axis=-1)
        w = p[:, :, 0] - lam * p[:, :, 1]
        return jnp.einsum('bhqm,bhmd->bhqd', w.astype(v.dtype), v)

    return sweep_query_blocks(block, q)


def short_conv(u, w, b):
    y = lax.conv_general_dilated(
        u, w[:, None, :].astype(u.dtype), window_strides=(1,),
        padding=[(CONV_W // 2, CONV_W - 1 - CONV_W // 2)],
        dimension_numbers=('NWC', 'WIO', 'NWC'), feature_group_count=u.shape[-1])
    return y + b


def rglru_coeffs(u, w_a, b_a, w_x, b_x, lam):
    bsz, L, C = u.shape
    ub = u.reshape(bsz, L, LRU_BLOCKS, LRU_BW)
    r = jax.nn.sigmoid((jnp.einsum('blni,nij->blnj', ub, w_a) + b_a).astype(F32)).reshape(bsz, L, C)
    i = jax.nn.sigmoid((jnp.einsum('blni,nij->blnj', ub, w_x) + b_x).astype(F32)).reshape(bsz, L, C)
    log_a = -LRU_C * r * jax.nn.softplus(-lam.astype(F32)).reshape(C)
    a = jnp.exp(log_a)
    b = jnp.sqrt(-jnp.expm1(2.0 * log_a)) * i * u.astype(F32)
    return a, b


def _combine(e1, e2):
    a1, b1 = e1
    a2, b2 = e2
    return a1 * a2, a2 * b1 + b2


def linear_scan(a, b, h0, reverse):
    if reverse:
        a, b = jnp.flip(a, 1), jnp.flip(b, 1)
    b = b.at[:, 0].add(a[:, 0] * h0)
    _, h = lax.associative_scan(_combine, (a, b), axis=1)
    return jnp.flip(h, 1) if reverse else h


def rglru_bidirectional(uc, ux, w_a, b_a, w_x, b_x, lam):
    hc_sum, hx_sum = 0.0, 0.0
    for d, reverse in enumerate((False, True)):
        ac, bc = rglru_coeffs(uc, w_a[d], b_a[d], w_x[d], b_x[d], lam[d])
        hc = linear_scan(ac, bc, jnp.zeros_like(ac[:, 0]), reverse)
        h0 = hc[:, 0] if reverse else hc[:, -1]
        ax, bx = rglru_coeffs(ux, w_a[d], b_a[d], w_x[d], b_x[d], lam[d])
        hx = linear_scan(ax, bx, h0, reverse)
        hc_sum = hc_sum + hc
        hx_sum = hx_sum + hx
    return hc_sum, hx_sum


def mixer_ab(hc, hx, w_in, w_out, lam_q, lam_k, subln, conv_w, conv_b, w_a, b_a, w_x, b_x,
             lru_lam, lambda_init, row, col, need_ctx):
    lam = (jnp.exp(jnp.sum(lam_q[0] * lam_k[0]).astype(F32))
           - jnp.exp(jnp.sum(lam_q[1] * lam_k[1]).astype(F32)) + lambda_init)

    def project(h):
        bsz, L, _ = h.shape
        q, k, v, u, g = split_cols(h @ w_in, AB_SPLITS)
        q = q.reshape(bsz, L, DIFF_HEADS, 2, DIFF_HEAD_DIM).transpose(0, 2, 3, 1, 4)
        k = k.reshape(bsz, L, DIFF_HEADS, 2, DIFF_HEAD_DIM).transpose(0, 2, 3, 1, 4)
        v = v.reshape(bsz, L, DIFF_HEADS, 2 * DIFF_HEAD_DIM).transpose(0, 2, 1, 3)
        return q, k, v, short_conv(u, conv_w, conv_b), g

    qc, kc, vc, uc, gc = project(hc)
    qx, kx, vx, ux, gx = project(hx)
    qx, kx = axial_rope(qx, row, col), axial_rope(kx, row, col)
    lc, lx = rglru_bidirectional(uc, ux, w_a, b_a, w_x, b_x, lru_lam)

    def finish(o_att, l, g):
        bsz, H, L, dv = o_att.shape
        o_att = (rms_norm(o_att) * subln * (1.0 - lambda_init)).transpose(0, 2, 1, 3).reshape(bsz, L, H * dv)
        o_rec = (l * jax.nn.gelu(g.astype(F32))).astype(o_att.dtype)
        return jnp.concatenate([o_att, o_rec], axis=-1) @ w_out

    ox = finish(diff_attention(qx, jnp.concatenate([kc, kx], axis=-2),
                               jnp.concatenate([vc, vx], axis=-2), lam), lx, gx)
    oc = finish(diff_attention(qc, kc, vc, lam), lc, gc) if need_ctx else None
    return oc, ox


def mixer_cd(hc, hx, w_in, w_out, q_norm, k_norm, cq_norm, ckv_norm, w_uq, w_ukv, row, col, need_ctx):
    groups = GQA_HEADS // GQA_KV_HEADS

    def project(h):
        bsz, L, _ = h.shape
        q, k, v, cq, ckv, kr = split_cols(h @ w_in, CD_SPLITS)
        q = (rms_norm(q.reshape(bsz, L, GQA_KV_HEADS, groups, GQA_HEAD_DIM)) * q_norm).transpose(0, 2, 3, 1, 4)
        k = (rms_norm(k.reshape(bsz, L, GQA_KV_HEADS, GQA_HEAD_DIM)) * k_norm).transpose(0, 2, 1, 3)
        v = v.reshape(bsz, L, GQA_KV_HEADS, GQA_HEAD_DIM).transpose(0, 2, 1, 3)
        mq = ((rms_norm(cq) * cq_norm) @ w_uq).reshape(bsz, L, MLA_HEADS, MLA_NOPE + MLA_ROPE).transpose(0, 2, 1, 3)
        mkv = ((rms_norm(ckv) * ckv_norm) @ w_ukv).reshape(bsz, L, MLA_HEADS, MLA_NOPE + MLA_V).transpose(0, 2, 1, 3)
        return q, k, v, mq, mkv[..., :MLA_NOPE], mkv[..., MLA_NOPE:], kr[:, None]

    def mla_keys(k_nope, kr):
        return jnp.concatenate([k_nope, jnp.broadcast_to(kr, k_nope.shape[:-1] + (MLA_ROPE,))], axis=-1)

    qc, kc, vc, mqc, knc, mvc, krc = project(hc)
    qx, kx, vx, mqx, knx, mvx, krx = project(hx)
    qx, kx = axial_rope(qx, row, col), axial_rope(kx, row, col)
    mqx = jnp.concatenate([mqx[..., :MLA_NOPE], axial_rope(mqx[..., MLA_NOPE:], row, col)], axis=-1)
    krx = axial_rope(krx, row, col)
    mkc, mkx = mla_keys(knc, krc), mla_keys(knx, krx)

    def finish(o_gqa, o_mla):
        bsz, L = o_gqa.shape[0], o_gqa.shape[3]
        o_gqa = o_gqa.transpose(0, 3, 1, 2, 4).reshape(bsz, L, GQA_HEADS * GQA_HEAD_DIM)
        o_mla = o_mla[:, :, 0].transpose(0, 2, 1, 3).reshape(bsz, L, MLA_HEADS * MLA_V)
        return jnp.concatenate([o_gqa, o_mla], axis=-1) @ w_out

    ox = finish(
        gqa_attention(qx, jnp.concatenate([kc, kx], axis=-2), jnp.concatenate([vc, vx], axis=-2)),
        gqa_attention(mqx[:, :, None], jnp.concatenate([mkc, mkx], axis=-2), jnp.concatenate([mvc, mvx], axis=-2)))
    oc = finish(gqa_attention(qc, kc, vc), gqa_attention(mqc[:, :, None], mkc, mvc)) if need_ctx else None
    return oc, ox


def moe_ffn(t, router_w, router_bias, w_gate, w_up, w_down, sh_gate, sh_up, sh_down):
    n_tok, d = t.shape
    per_group = N_EXPERTS // N_GROUPS

    def block(tb):
        scores = jax.nn.sigmoid((tb @ router_w).astype(F32))
        choice = scores + router_bias.astype(F32)
        grp_score = lax.top_k(choice.reshape(-1, N_GROUPS, per_group), 2)[0].sum(-1)
        _, g_idx = lax.top_k(grp_score, TOPK_GROUPS)
        g_mask = jax.nn.one_hot(g_idx, N_GROUPS, dtype=F32).sum(1)
        e_mask = jnp.repeat(g_mask, per_group, axis=1) > 0
        _, e_idx = lax.top_k(jnp.where(e_mask, choice, -jnp.inf), TOP_K)
        w = jnp.take_along_axis(scores, e_idx, axis=-1)
        w = w / jnp.sum(w, axis=-1, keepdims=True) * ROUTED_SCALE
        gates = jnp.sum(jax.nn.one_hot(e_idx, N_EXPERTS, dtype=F32) * w[..., None], axis=1)
        h = jax.nn.silu(jnp.einsum('nd,edf->nef', tb, w_gate)) * jnp.einsum('nd,edf->nef', tb, w_up)
        routed = jnp.einsum('nef,efd->nd', h * gates[..., None].astype(h.dtype), w_down)
        shared = (jax.nn.silu(tb @ sh_gate) * (tb @ sh_up)) @ sh_down
        return routed + shared

    y = lax.map(block, t.reshape(n_tok // MOE_BLOCK, MOE_BLOCK, d))
    return y.reshape(n_tok, d)


def setup_inputs(seed: int = 0) -> dict:
    key = jax.random.key(seed)
    keys = iter(jax.random.split(key, 48))

    def nrm(shape, scale):
        return jax.random.normal(next(keys), shape, F32) * scale

    d = D_MODEL
    n_even = (DEPTH + 1) // 2
    n_odd = DEPTH // 2
    x = nrm((BATCH, SEQ, d), 1.0)
    c = nrm((BATCH, d), 1.0)
    ctx = nrm((BATCH, CTX_LEN, d), 1.0)
    c_ctx = nrm((d,), 1.0)
    mod_w = nrm((DEPTH, d, 6 * d), 0.5 * d ** -0.5)
    mod_b = nrm((DEPTH, 6 * d), 0.02)
    ab_w_in = nrm((n_even, d, AB_IN), d ** -0.5)
    ab_w_out = nrm((n_even, AB_OUT, d), AB_OUT ** -0.5)
    diff_lambda_q = nrm((n_even, 2, DIFF_HEAD_DIM), 0.1)
    diff_lambda_k = nrm((n_even, 2, DIFF_HEAD_DIM), 0.1)
    diff_subln = 1.0 + nrm((n_even, 2 * DIFF_HEAD_DIM), 0.02)
    lru_conv_w = nrm((n_even, CONV_W, LRU_WIDTH), CONV_W ** -0.5)
    lru_conv_b = nrm((n_even, LRU_WIDTH), 0.02)
    lru_w_a = nrm((n_even, 2, LRU_BLOCKS, LRU_BW, LRU_BW), LRU_BW ** -0.5)
    lru_b_a = nrm((n_even, 2, LRU_BLOCKS, LRU_BW), 0.02)
    lru_w_x = nrm((n_even, 2, LRU_BLOCKS, LRU_BW, LRU_BW), LRU_BW ** -0.5)
    lru_b_x = nrm((n_even, 2, LRU_BLOCKS, LRU_BW), 0.02)
    a0 = jax.random.uniform(next(keys), (n_even, 2, LRU_BLOCKS, LRU_BW), F32, 0.9, 0.999)
    s = a0 ** (1.0 / LRU_C)
    lru_lambda = jnp.log(s) - jnp.log1p(-s)
    cd_w_in = nrm((n_odd, d, CD_IN), d ** -0.5)
    cd_w_out = nrm((n_odd, CD_OUT, d), CD_OUT ** -0.5)
    gqa_q_norm = 1.0 + nrm((n_odd, GQA_HEAD_DIM), 0.02)
    gqa_k_norm = 1.0 + nrm((n_odd, GQA_HEAD_DIM), 0.02)
    mla_q_norm = 1.0 + nrm((n_odd, MLA_Q_RANK), 0.02)
    mla_kv_norm = 1.0 + nrm((n_odd, MLA_KV_RANK), 0.02)
    mla_w_uq = nrm((n_odd, MLA_Q_RANK, MLA_HEADS * (MLA_NOPE + MLA_ROPE)), MLA_Q_RANK ** -0.5)
    mla_w_ukv = nrm((n_odd, MLA_KV_RANK, MLA_HEADS * (MLA_NOPE + MLA_V)), MLA_KV_RANK ** -0.5)
    router_w = nrm((DEPTH, d, N_EXPERTS), d ** -0.5)
    router_bias = nrm((DEPTH, N_EXPERTS), 0.01)
    exp_w_gate = nrm((DEPTH, N_EXPERTS, d, EXPERT_FF), d ** -0.5)
    exp_w_up = nrm((DEPTH, N_EXPERTS, d, EXPERT_FF), d ** -0.5)
    exp_w_down = nrm((DEPTH, N_EXPERTS, EXPERT_FF, d), EXPERT_FF ** -0.5)
    sh_w_gate = nrm((DEPTH, d, SHARED_FF), d ** -0.5)
    sh_w_up = nrm((DEPTH, d, SHARED_FF), d ** -0.5)
    sh_w_down = nrm((DEPTH, SHARED_FF, d), SHARED_FF ** -0.5)
    final_norm = 1.0 + nrm((d,), 0.02)
    return {'x': x, 'c': c, 'ctx': ctx, 'c_ctx': c_ctx, 'mod_w': mod_w, 'mod_b': mod_b,
            'ab_w_in': ab_w_in, 'ab_w_out': ab_w_out, 'diff_lambda_q': diff_lambda_q,
            'diff_lambda_k': diff_lambda_k, 'diff_subln': diff_subln, 'lru_conv_w': lru_conv_w,
            'lru_conv_b': lru_conv_b, 'lru_w_a': lru_w_a, 'lru_b_a': lru_b_a, 'lru_w_x': lru_w_x,
            'lru_b_x': lru_b_x, 'lru_lambda': lru_lambda, 'cd_w_in': cd_w_in, 'cd_w_out': cd_w_out,
            'gqa_q_norm': gqa_q_norm, 'gqa_k_norm': gqa_k_norm, 'mla_q_norm': mla_q_norm,
            'mla_kv_norm': mla_kv_norm, 'mla_w_uq': mla_w_uq, 'mla_w_ukv': mla_w_ukv,
            'router_w': router_w, 'router_bias': router_bias, 'exp_w_gate': exp_w_gate,
            'exp_w_up': exp_w_up, 'exp_w_down': exp_w_down, 'sh_w_gate': sh_w_gate,
            'sh_w_up': sh_w_up, 'sh_w_down': sh_w_down, 'final_norm': final_norm}


def reference(x, c, ctx, c_ctx, mod_w, mod_b, ab_w_in, ab_w_out, diff_lambda_q, diff_lambda_k,
              diff_subln, lru_conv_w, lru_conv_b, lru_w_a, lru_b_a, lru_w_x, lru_b_x, lru_lambda,
              cd_w_in, cd_w_out, gqa_q_norm, gqa_k_norm, mla_q_norm, mla_kv_norm, mla_w_uq, mla_w_ukv,
              router_w, router_bias, exp_w_gate, exp_w_up, exp_w_down, sh_w_gate, sh_w_up, sh_w_down,
              final_norm):
    d = x.shape[-1]
    row, col = grid_positions(x.shape[1])
    xc = ctx
    for i in range(DEPTH):
        last = i == DEPTH - 1
        mod_x = (jax.nn.silu(c) @ mod_w[i] + mod_b[i])[:, None, :]
        mod_c = (jax.nn.silu(c_ctx) @ mod_w[i] + mod_b[i])[None, None, :]
        sh1x, sc1x, g1x, sh2x, sc2x, g2x = jnp.split(mod_x, 6, axis=-1)
        sh1c, sc1c, g1c, sh2c, sc2c, g2c = jnp.split(mod_c, 6, axis=-1)
        hx = modulate(x, sh1x, sc1x)
        hc = modulate(xc, sh1c, sc1c)
        j = i // 2
        if i % 2 == 0:
            oc, ox = mixer_ab(hc, hx, ab_w_in[j], ab_w_out[j], diff_lambda_q[j], diff_lambda_k[j],
                              diff_subln[j], lru_conv_w[j], lru_conv_b[j], lru_w_a[j], lru_b_a[j],
                              lru_w_x[j], lru_b_x[j], lru_lambda[j],
                              0.8 - 0.6 * math.exp(-0.3 * i), row, col, not last)
        else:
            oc, ox = mixer_cd(hc, hx, cd_w_in[j], cd_w_out[j], gqa_q_norm[j], gqa_k_norm[j],
                              mla_q_norm[j], mla_kv_norm[j], mla_w_uq[j], mla_w_ukv[j],
                              row, col, not last)
        x = x + g1x * ox
        hx2 = modulate(x, sh2x, sc2x)
        if last:
            y = moe_ffn(hx2.reshape(-1, d), router_w[i], router_bias[i], exp_w_gate[i], exp_w_up[i],
                        exp_w_down[i], sh_w_gate[i], sh_w_up[i], sh_w_down[i])
            x = x + g2x * y.reshape(x.shape)
        else:
            xc = xc + g1c * oc
            hc2 = modulate(xc, sh2c, sc2c)
            n_ctx = hc2.shape[0] * hc2.shape[1]
            y = moe_ffn(jnp.concatenate([hc2.reshape(-1, d), hx2.reshape(-1, d)], axis=0),
                        router_w[i], router_bias[i], exp_w_gate[i], exp_w_up[i], exp_w_down[i],
                        sh_w_gate[i], sh_w_up[i], sh_w_down[i])
            xc = xc + g2c * y[:n_ctx].reshape(xc.shape)
            x = x + g2x * y[n_ctx:].reshape(x.shape)
    return rms_norm(x) * final_norm
```

```cpp
#include <hip/hip_runtime.h>
#include <stdint.h>
#include <stdio.h>
#include <string.h>
#include <type_traits>

#ifndef MK_REPEAT_MASK
#define MK_REPEAT_MASK 0ull
#endif
#ifndef MK_FUSED
#define MK_FUSED 1
#endif

#define DI __device__ __forceinline__
typedef unsigned short bf16_t;
typedef short bf16x8 __attribute__((ext_vector_type(8)));
typedef float f32x16 __attribute__((ext_vector_type(16)));
typedef float f32x2_t __attribute__((ext_vector_type(2)));
typedef __bf16 bf16x2_t __attribute__((ext_vector_type(2)));

constexpr int NB = 4, LX = 8192, LC = 256, LT = LX + LC, NT = NB * LT, DM = 1024;
constexpr int AB_IN = 2560, CD_IN = 1168, CD_INP = 1280;
constexpr int NE = 64, FF = 256, NSEGC = 65, NCH = 4, NSEG = NSEGC * NCH;
constexpr int NPAIR = NT * 9;
constexpr int NCHUNK_T = LT / 64;
constexpr int NTHR = 256;
constexpr int SMEM_BYTES = 76800;
constexpr int SM_OFF = 64;
constexpr float EPSV = 1e-6f;
constexpr float LOG2E = 1.4426950408889634f;

#define XB_TMO      128
#define XB_XCNT(j)  (256  + 64 * (j))
#define XB_XSUB(j)  (1280 + 64 * (j))
#define XB_XGEN(j)  (2304 + 64 * (j))
#define XB_TOP      3328
#define XB_TOPGEN   3392
#define XCD_BAR_WORDS 3456
#define XB_SPIN_CAP (1u << 18)
#define LAS __attribute__((address_space(3)))

__device__ __forceinline__ unsigned xb_ld(unsigned* p)              { return __hip_atomic_load(p, __ATOMIC_RELAXED, __HIP_MEMORY_SCOPE_AGENT); }
__device__ __forceinline__ unsigned xb_add(unsigned* p, unsigned v) { return __hip_atomic_fetch_add(p, v, __ATOMIC_RELAXED, __HIP_MEMORY_SCOPE_AGENT); }
__device__ __forceinline__ unsigned xb_xcc_id() { return (unsigned)__builtin_amdgcn_s_getreg((3 << 11) | 20) & 0xFu; }
#define XB_SPIN(cond, bar) do { unsigned _sp = 0; while (cond) { __builtin_amdgcn_s_sleep(1); \
    if ((++_sp & 255u) == 0u) { if (xb_ld(&(bar)[XB_TMO])) break; if (_sp > XB_SPIN_CAP) { atomicAdd(&(bar)[XB_TMO], 1u); break; } } } } while (0)

struct XcdBarrier { unsigned* bar; unsigned x; volatile LAS unsigned* st; };

__device__ __forceinline__ XcdBarrier xcd_barrier_post(unsigned* bar, volatile LAS unsigned* st) {
    XcdBarrier b; b.bar = bar; b.x = xb_xcc_id(); b.st = st;
    if (threadIdx.x == 0) (void)xb_add(&bar[XB_XCNT(b.x)], 1u);
    return b;
}
__device__ __forceinline__ void xcd_barrier_complete(unsigned* bar, unsigned x, unsigned& nloc, unsigned& nx) {
    const unsigned G = gridDim.x * gridDim.y * gridDim.z;
    unsigned sum, cnt, mine, sp = 0u;
    for (;;) {
        sum = 0u; cnt = 0u; mine = 0u;
#pragma unroll
        for (unsigned j = 0; j < 16; ++j) { const unsigned c = xb_ld(&bar[XB_XCNT(j)]); sum += c; cnt += (c > 0u) ? 1u : 0u; mine = (j == x) ? c : mine; }
        if (sum == G) break;
        __builtin_amdgcn_s_sleep(1);
        if ((++sp & 255u) == 0u) { if (xb_ld(&bar[XB_TMO])) break; if (sp > XB_SPIN_CAP) { atomicAdd(&bar[XB_TMO], 1u); break; } }
    }
    nloc = mine > 0u ? mine : 1u; nx = cnt > 0u ? cnt : 1u;
}
__device__ __forceinline__ void xcd_barrier(const XcdBarrier& b) {
    asm volatile("s_waitcnt vmcnt(0)" ::: "memory");
    __syncthreads();
    if (threadIdx.x == 0) {
        unsigned* bar = b.bar;
        __builtin_amdgcn_s_waitcnt(0);
        unsigned nloc = b.st[0], nx = b.st[1];
        if (nloc == 0u) { xcd_barrier_complete(bar, b.x, nloc, nx); b.st[0] = nloc; b.st[1] = nx; }
        const unsigned old = xb_add(&bar[XB_XSUB(b.x)], 1u);
        const unsigned gen = old / nloc;
        if (old + 1u == (gen + 1u) * nloc) {
            __builtin_amdgcn_fence(__ATOMIC_RELEASE, "agent");
            asm volatile("s_waitcnt vmcnt(0)" ::: "memory");
            const unsigned og = xb_add(&bar[XB_TOP], 1u);
            const unsigned tg = og / nx;
            if (og + 1u == (tg + 1u) * nx) xb_add(&bar[XB_TOPGEN], 1u);
            else XB_SPIN(xb_ld(&bar[XB_TOPGEN]) == tg, bar);
            __builtin_amdgcn_fence(__ATOMIC_ACQUIRE, "agent");
            xb_add(&bar[XB_XGEN(b.x)], 1u);
            asm volatile("s_waitcnt vmcnt(0)" ::: "memory");
        } else {
            XB_SPIN(xb_ld(&bar[XB_XGEN(b.x)]) == gen, bar);
            __builtin_amdgcn_fence(__ATOMIC_ACQUIRE, "agent");
            asm volatile("s_waitcnt vmcnt(0)" ::: "memory");
        }
    }
    __syncthreads();
}

struct Params {
    const float* in[35];
    float* out;
    unsigned* bar;
    int* cnt;
    unsigned* kmax;
    float* mod;
    float* tab;
    float* lamv;
    bf16_t* w_in0;
    bf16_t* w_out0;
    bf16_t* w_in1;
    bf16_t* w_out1;
    bf16_t* w_uq;
    bf16_t* w_ukv;
    bf16_t* lw;
    bf16_t* rwh;
    bf16_t* rwl;
    bf16_t* ew1;
    bf16_t* ew2;
    float* rc;
    int* tk_e;
    float* tk_w;
    int* ppos;
    int* stok;
    float* sw;
    float* agg;
    float* carry;
    char* x1;
    char* x2;
    char* x4;
    bf16_t* h1;
    int nch;
    int chrows;
};

constexpr int TB_CR = 0, TB_SR = 2048, TB_CC = 4096, TB_SC = 5120, TB_CR4 = 6144, TB_SR4 = 6656, TB_CC4 = 7168, TB_SC4 = 7424, TB_TOTAL = 7680;

DI int unit_first() { return (int)((blockIdx.x & 7u) * (gridDim.x >> 3) + (blockIdx.x >> 3)); }
DI int tid() { int t = threadIdx.x; asm volatile("" : "+v"(t)); return t; }
DI unsigned pk_bf16(float a, float b) { f32x2_t v = {a, b}; bf16x2_t r = __builtin_convertvector(v, bf16x2_t); return __builtin_bit_cast(unsigned, r); }
DI bf16_t f2bf(float a) { return (bf16_t)(pk_bf16(a, 0.f) & 0xffffu); }
DI float bf2f(bf16_t v) { return __uint_as_float(((unsigned)v) << 16); }
DI float bflo(unsigned u) { return __uint_as_float(u << 16); }
DI float bfhi(unsigned u) { return __uint_as_float(u & 0xffff0000u); }
DI float sigm(float x) { return __builtin_amdgcn_rcpf(1.f + __builtin_amdgcn_exp2f(-1.4426950408889634f * x)); }
DI float silu_f(float x) { return x * sigm(x); }
DI float gelu_tanh(float x) { const float u = 0.7978845608028654f * (x + 0.044715f * x * x * x); return x * sigm(2.f * u); }
DI float wave_sum(float v) {
    const int l = tid() & 63;
#pragma unroll
    for (int o = 32; o > 0; o >>= 1) v += __int_as_float(__builtin_amdgcn_ds_bpermute((l ^ o) << 2, __float_as_int(v)));
    return v;
}
DI int shfl_up_i(int v, int o, int l) { return __builtin_amdgcn_ds_bpermute((l >= o ? l - o : l) << 2, v); }
DI float half_max(float x) { auto r = __builtin_amdgcn_permlane32_swap(__float_as_uint(x), __float_as_uint(x), false, false); return fmaxf(__uint_as_float(r[0]), __uint_as_float(r[1])); }
DI float half_sum(float x) { auto r = __builtin_amdgcn_permlane32_swap(__float_as_uint(x), __float_as_uint(x), false, false); return __uint_as_float(r[0]) + __uint_as_float(r[1]); }
#define MFMA32(a, b, c) __builtin_amdgcn_mfma_f32_32x32x16_bf16((a), (b), (c), 0, 0, 0)
DI int acc_row(int i, int h) { return (i & 3) + 8 * (i >> 2) + 4 * h; }

DI float* res_row(const Params& p, int r) {
    const int b = r / LT, pos = r - b * LT;
    return pos < LC ? p.rc + (size_t)(b * LC + pos) * DM : p.out + (size_t)(b * LX + pos - LC) * DM;
}
DI const float* in_row(const Params& p, int r) {
    const int b = r / LT, pos = r - b * LT;
    return pos < LC ? p.in[2] + (size_t)(b * LC + pos) * DM : p.in[0] + (size_t)(b * LX + pos - LC) * DM;
}
DI int mod_row(int r) { const int b = r / LT, pos = r - b * LT; return pos < LC ? 4 : b; }

DI void mod_gemv_unit(const Params& p, int u, char* smem) {
    float* s = (float*)smem;
    float* red = s + 5 * 1024;
    const int t = tid();
    for (int i = t; i < 5 * 1024; i += NTHR) { const int m = i >> 10, k = i & 1023; const float v = (m < 4) ? p.in[1][m * 1024 + k] : p.in[3][k]; s[i] = silu_f(v); }
    __syncthreads();
    const int layer = u / 96, n0 = (u % 96) * 64, col = t & 63, kg = t >> 6;
    const float* w = p.in[4] + (size_t)layer * 1024 * 6144 + n0 + col;
    float a0 = 0.f, a1 = 0.f, a2 = 0.f, a3 = 0.f, a4 = 0.f;
    for (int k0 = kg * 256; k0 < kg * 256 + 256; k0 += 16) {
        float wv[16];
#pragma unroll
        for (int j = 0; j < 16; ++j) wv[j] = w[(size_t)(k0 + j) * 6144];
#pragma unroll
        for (int j = 0; j < 16; ++j) { const int k = k0 + j;
            a0 += s[k] * wv[j]; a1 += s[1024 + k] * wv[j]; a2 += s[2048 + k] * wv[j]; a3 += s[3072 + k] * wv[j]; a4 += s[4096 + k] * wv[j]; }
    }
    red[(kg * 5 + 0) * 64 + col] = a0; red[(kg * 5 + 1) * 64 + col] = a1; red[(kg * 5 + 2) * 64 + col] = a2; red[(kg * 5 + 3) * 64 + col] = a3; red[(kg * 5 + 4) * 64 + col] = a4;
    __syncthreads();
    if (t < 64) {
        const float bias = p.in[5][layer * 6144 + n0 + t];
#pragma unroll
        for (int m = 0; m < 5; ++m) {
            const float v = red[(0 * 5 + m) * 64 + t] + red[(1 * 5 + m) * 64 + t] + red[(2 * 5 + m) * 64 + t] + red[(3 * 5 + m) * 64 + t] + bias;
            p.mod[(size_t)(layer * 5 + m) * 6144 + n0 + t] = v;
        }
    }
    __syncthreads();
}

DI void cvt_tile(const float* src, int ld_src, int k0, int n0, int nvalid, bf16_t* dst, int ld_dst, char* smem, bf16_t* dst_lo = nullptr, bool tiled = false) {
    float* s = (float*)smem;
    const int t = tid();
#pragma unroll
    for (int it = 0; it < 2; ++it) {
        const int idx = t + NTHR * it, k = idx >> 3, n4 = (idx & 7) * 4;
        const float* sp = src + (size_t)(k0 + k) * ld_src + n0 + n4;
        float v0 = 0.f, v1 = 0.f, v2 = 0.f, v3 = 0.f;
        if (n0 + n4 + 3 < nvalid) { const float4 v = *(const float4*)sp; v0 = v.x; v1 = v.y; v2 = v.z; v3 = v.w; }
        else { if (n0 + n4 + 0 < nvalid) v0 = sp[0]; if (n0 + n4 + 1 < nvalid) v1 = sp[1]; if (n0 + n4 + 2 < nvalid) v2 = sp[2]; if (n0 + n4 + 3 < nvalid) v3 = sp[3]; }
        s[k * 33 + n4 + 0] = v0; s[k * 33 + n4 + 1] = v1; s[k * 33 + n4 + 2] = v2; s[k * 33 + n4 + 3] = v3;
    }
    __syncthreads();
    {
        const int n = t >> 3, c = t & 7;
        uint4 o;
        o.x = pk_bf16(s[(c * 8 + 0) * 33 + n], s[(c * 8 + 1) * 33 + n]);
        o.y = pk_bf16(s[(c * 8 + 2) * 33 + n], s[(c * 8 + 3) * 33 + n]);
        o.z = pk_bf16(s[(c * 8 + 4) * 33 + n], s[(c * 8 + 5) * 33 + n]);
        o.w = pk_bf16(s[(c * 8 + 6) * 33 + n], s[(c * 8 + 7) * 33 + n]);
        if (tiled) *(uint4*)(dst + (size_t)((((k0 >> 4) + (c >> 1)) * 64 + (c & 1) * 32 + n) * 8)) = o;
        else *(uint4*)(dst + (size_t)n * ld_dst + k0 + c * 8) = o;
        if (dst_lo) {
            float r[8];
#pragma unroll
            for (int j = 0; j < 8; ++j) { const float w = s[(c * 8 + j) * 33 + n]; r[j] = w - bf2f(f2bf(w)); }
            uint4 o2; o2.x = pk_bf16(r[0], r[1]); o2.y = pk_bf16(r[2], r[3]); o2.z = pk_bf16(r[4], r[5]); o2.w = pk_bf16(r[6], r[7]);
            *(uint4*)(dst_lo + (size_t)n * ld_dst + k0 + c * 8) = o2;
        }
    }
    __syncthreads();
}

constexpr int CS0 = 1280, CS1 = CS0 + 512, CS2 = CS1 + 640, CS3 = CS2 + 512, CS4 = CS3 + 64, CS5 = CS4 + 48, CS6 = CS5 + 64, CS7 = CS6 + 64;
constexpr int CVT_SMALL_TILES = CS7;
DI void cvt_small(const Params& p, int u, char* smem) {
    if (u < CS0) { const int kt = u / 80, nt = u % 80; cvt_tile(p.in[6], AB_IN, kt * 64, nt * 32, AB_IN, p.w_in0 + (size_t)nt * 32 * 1024, 1024, smem, nullptr, true); }
    else if (u < CS1) { const int v = u - CS0, kt = v / 32, nt = v % 32; cvt_tile(p.in[7], 1024, kt * 64, nt * 32, 1024, p.w_out0 + (size_t)nt * 32 * 1024, 1024, smem, nullptr, true); }
    else if (u < CS2) { const int v = u - CS1, kt = v / 40, nt = v % 40; cvt_tile(p.in[18], CD_IN, kt * 64, nt * 32, CD_IN, p.w_in1 + (size_t)nt * 32 * 1024, 1024, smem, nullptr, true); }
    else if (u < CS3) { const int v = u - CS2, kt = v / 32, nt = v % 32; cvt_tile(p.in[19], 1024, kt * 64, nt * 32, 1024, p.w_out1 + (size_t)nt * 32 * 1024, 1024, smem, nullptr, true); }
    else if (u < CS4) { const int v = u - CS3, kt = v / 16, nt = v % 16; cvt_tile(p.in[24], 384, kt * 64, nt * 32, 384, p.w_uq + (size_t)nt * 32 * 256, 256, smem, nullptr, true); }
    else if (u < CS5) { const int v = u - CS4, kt = v / 24, nt = v % 24; cvt_tile(p.in[25], 768, kt * 64, nt * 32, 768, p.w_ukv + (size_t)nt * 32 * 128, 128, smem, nullptr, true); }
    else if (u < CS6) {
        const int v = u - CS5, gate = v & 1, jh = (v >> 1) & 1, d = (v >> 2) & 1, n = v >> 3;
        const float* src = (gate ? p.in[15] : p.in[13]) + (size_t)(d * 8 + n) * 64 * 64;
        cvt_tile(src, 64, 0, jh * 32, 64, p.lw + (size_t)v * 32 * 64, 64, smem);
    } else {
        const int v = u - CS6, layer = v >> 5, kt = (v >> 1) & 15, nt = v & 1;
        cvt_tile(p.in[26] + (size_t)layer * 1024 * 64, 64, kt * 64, nt * 32, 64, p.rwh + ((size_t)layer * 64 + nt * 32) * 1024, 1024, smem, p.rwl + ((size_t)layer * 64 + nt * 32) * 1024);
    }
}
constexpr int CVT_EXP_TILES = 3 * 8192 + 3 * 128;
DI void cvt_expert(const Params& p, int layer, int u, char* smem) {
    if (u < 16384) {
        const int up = u >= 8192, v = u & 8191, e = v >> 7, kt = (v >> 3) & 15, nt = v & 7;
        const float* src = (up ? p.in[29] : p.in[28]) + (size_t)(layer * NE + e) * 1024 * 256;
        cvt_tile(src, 256, kt * 64, nt * 32, 256, p.ew1 + ((size_t)e * 512 + nt * 64 + up * 32) * 1024, 1024, smem, nullptr, true);
    } else if (u < 24576) {
        const int v = u - 16384, e = v >> 7, kt = (v >> 5) & 3, nt = v & 31;
        const float* src = p.in[30] + (size_t)(layer * NE + e) * 256 * 1024;
        cvt_tile(src, 1024, kt * 64, nt * 32, 1024, p.ew2 + ((size_t)e * 1024 + nt * 32) * 256, 256, smem, nullptr, true);
    } else {
        const int v = u - 24576;
        if (v < 256) { const int up = v >= 128, w = v & 127, kt = w >> 3, nt = w & 7;
            const float* src = (up ? p.in[32] : p.in[31]) + (size_t)layer * 1024 * 256;
            cvt_tile(src, 256, kt * 64, nt * 32, 256, p.ew1 + ((size_t)NE * 512 + nt * 64 + up * 32) * 1024, 1024, smem, nullptr, true);
        } else { const int w = v - 256, kt = w >> 5, nt = w & 31;
            const float* src = p.in[33] + (size_t)layer * 256 * 1024;
            cvt_tile(src, 1024, kt * 64, nt * 32, 1024, p.ew2 + ((size_t)NE * 1024 + nt * 32) * 256, 256, smem, nullptr, true);
        }
    }
}
DI void tables_unit(const Params& p) {
    const int t = tid();
    for (int i = t; i < 128 * 16; i += NTHR) { const int pos = i >> 4, f = i & 15; const float ang = (float)pos * powf(10000.f, -(float)f / 16.f); float s, c; sincosf(ang, &s, &c); p.tab[TB_CR + i] = c; p.tab[TB_SR + i] = s; }
    for (int i = t; i < 64 * 16; i += NTHR) { const int pos = i >> 4, f = i & 15; const float ang = (float)pos * powf(10000.f, -(float)f / 16.f); float s, c; sincosf(ang, &s, &c); p.tab[TB_CC + i] = c; p.tab[TB_SC + i] = s; }
    for (int i = t; i < 128 * 4; i += NTHR) { const int pos = i >> 2, f = i & 3; const float ang = (float)pos * powf(10000.f, -(float)f / 4.f); float s, c; sincosf(ang, &s, &c); p.tab[TB_CR4 + i] = c; p.tab[TB_SR4 + i] = s; }
    for (int i = t; i < 64 * 4; i += NTHR) { const int pos = i >> 2, f = i & 3; const float ang = (float)pos * powf(10000.f, -(float)f / 4.f); float s, c; sincosf(ang, &s, &c); p.tab[TB_CC4 + i] = c; p.tab[TB_SC4 + i] = s; }
    if (t < 64) {
        const float s0 = wave_sum(p.in[8][t] * p.in[9][t]), s1 = wave_sum(p.in[8][64 + t] * p.in[9][64 + t]);
        if (t == 0) p.lamv[0] = expf(s0) - expf(s1) + 0.2f;
    }
}
DI void phase_prologue(const Params& p, char* smem) {
    const int n_units = 192 + 1 + CVT_SMALL_TILES;
    for (int u = unit_first(); u < n_units; u += gridDim.x) {
        if (u < 192) mod_gemv_unit(p, u, smem);
        else if (u == 192) tables_unit(p);
        else cvt_small(p, u - 193, smem);
    }
}

DI void phase_norm1(const Params& p, int layer) {
    const int lane = tid() & 63, wave = tid() >> 6;
    bf16_t* H = (bf16_t*)p.x4;
    for (int u = unit_first(); u < NT / 64; u += gridDim.x) {
        for (int rr = 0; rr < 16; rr += 4) {
            float4 v[4][4]; float ss[4];
#pragma unroll
            for (int q = 0; q < 4; ++q) {
                const int r = u * 64 + wave * 16 + rr + q;
                const float* src = layer == 0 ? in_row(p, r) : res_row(p, r);
#pragma unroll
                for (int i = 0; i < 4; ++i) v[q][i] = *(const float4*)(src + lane * 4 + 256 * i);
            }
#pragma unroll
            for (int q = 0; q < 4; ++q) {
                float s = 0.f;
#pragma unroll
                for (int i = 0; i < 4; ++i) s += v[q][i].x * v[q][i].x + v[q][i].y * v[q][i].y + v[q][i].z * v[q][i].z + v[q][i].w * v[q][i].w;
                ss[q] = wave_sum(s);
            }
#pragma unroll
            for (int q = 0; q < 4; ++q) {
                const int r = u * 64 + wave * 16 + rr + q;
                const float* md = p.mod + (size_t)(layer * 5 + mod_row(r)) * 6144;
                const float rinv = rsqrtf(ss[q] * (1.f / 1024.f) + EPSV);
#pragma unroll
                for (int i = 0; i < 4; ++i) {
                    const int c = lane * 4 + 256 * i;
                    const float4 sh = *(const float4*)(md + c), sc = *(const float4*)(md + 1024 + c);
                    uint2 o;
                    o.x = pk_bf16(v[q][i].x * rinv * (1.f + sc.x) + sh.x, v[q][i].y * rinv * (1.f + sc.y) + sh.y);
                    o.y = pk_bf16(v[q][i].z * rinv * (1.f + sc.z) + sh.z, v[q][i].w * rinv * (1.f + sc.w) + sh.w);
                    *(uint2*)(H + (size_t)r * DM + c) = o;
                }
            }
        }
    }
}

constexpr int LDT = 72;
constexpr int CT_LD = 132;
template <class Epi>
DI void gemm_tile(const bf16_t* a0, const bf16_t* a1, const bf16_t* a2, const bf16_t* a3,
                  const bf16_t* b0, const bf16_t* b1, const bf16_t* b2, const bf16_t* b3,
                  int K, char* smem, const Epi& epi, int row0, int col0) {
    bf16_t* As = (bf16_t*)smem;
    bf16_t* Bs = As + 2 * 128 * LDT;
    const int t = tid(), lane = t & 63, wave = t >> 6, wm = wave >> 1, wn = wave & 1, l32 = lane & 31, h = lane >> 5;
    const int srow = t >> 3, scol = (t & 7) * 8;
    uint4 ra0, ra1, ra2, ra3, rb0, rb1, rb2, rb3;
    ra0 = *(const uint4*)(a0 + scol); ra1 = *(const uint4*)(a1 + scol); ra2 = *(const uint4*)(a2 + scol); ra3 = *(const uint4*)(a3 + scol);
    rb0 = *(const uint4*)(b0 + scol); rb1 = *(const uint4*)(b1 + scol); rb2 = *(const uint4*)(b2 + scol); rb3 = *(const uint4*)(b3 + scol);
    {
        bf16_t* ad = As + srow * LDT + scol; bf16_t* bd = Bs + srow * LDT + scol;
        *(uint4*)(ad) = ra0; *(uint4*)(ad + 32 * LDT) = ra1; *(uint4*)(ad + 64 * LDT) = ra2; *(uint4*)(ad + 96 * LDT) = ra3;
        *(uint4*)(bd) = rb0; *(uint4*)(bd + 32 * LDT) = rb1; *(uint4*)(bd + 64 * LDT) = rb2; *(uint4*)(bd + 96 * LDT) = rb3;
    }
    __syncthreads();
    f32x16 acc[2][2];
#pragma unroll
    for (int i = 0; i < 2; ++i)
#pragma unroll
        for (int j = 0; j < 2; ++j)
#pragma unroll
            for (int e = 0; e < 16; ++e) acc[i][j][e] = 0.f;
    const int nk = K >> 6;
    for (int kt = 0; kt < nk; ++kt) {
        const int cur = kt & 1;
        const bool more = (kt + 1 < nk);
        if (more) {
            const int ko = (kt + 1) * 64 + scol;
            ra0 = *(const uint4*)(a0 + ko); ra1 = *(const uint4*)(a1 + ko); ra2 = *(const uint4*)(a2 + ko); ra3 = *(const uint4*)(a3 + ko);
            rb0 = *(const uint4*)(b0 + ko); rb1 = *(const uint4*)(b1 + ko); rb2 = *(const uint4*)(b2 + ko); rb3 = *(const uint4*)(b3 + ko);
        }
        __builtin_amdgcn_sched_barrier(0);
        const bf16_t* Ac = As + cur * 128 * LDT + (wm * 64 + l32) * LDT + h * 8;
        const bf16_t* Bc = Bs + cur * 128 * LDT + (wn * 64 + l32) * LDT + h * 8;
        bf16x8 fa0[4], fa1[4], fb0[4], fb1[4];
#pragma unroll
        for (int ks = 0; ks < 4; ++ks) {
            fa0[ks] = *(const bf16x8*)(Ac + ks * 16); fb0[ks] = *(const bf16x8*)(Bc + ks * 16);
            fa1[ks] = *(const bf16x8*)(Ac + 32 * LDT + ks * 16); fb1[ks] = *(const bf16x8*)(Bc + 32 * LDT + ks * 16);
        }
        __builtin_amdgcn_sched_barrier(0);
#pragma unroll
        for (int ks = 0; ks < 4; ++ks) {
            acc[0][0] = MFMA32(fa0[ks], fb0[ks], acc[0][0]); acc[0][1] = MFMA32(fa0[ks], fb1[ks], acc[0][1]);
            acc[1][0] = MFMA32(fa1[ks], fb0[ks], acc[1][0]); acc[1][1] = MFMA32(fa1[ks], fb1[ks], acc[1][1]);
        }
        __builtin_amdgcn_sched_barrier(0);
        if (more) {
            bf16_t* ad = As + (cur ^ 1) * 128 * LDT + srow * LDT + scol; bf16_t* bd = Bs + (cur ^ 1) * 128 * LDT + srow * LDT + scol;
            *(uint4*)(ad) = ra0; *(uint4*)(ad + 32 * LDT) = ra1; *(uint4*)(ad + 64 * LDT) = ra2; *(uint4*)(ad + 96 * LDT) = ra3;
            *(uint4*)(bd) = rb0; *(uint4*)(bd + 32 * LDT) = rb1; *(uint4*)(bd + 64 * LDT) = rb2; *(uint4*)(bd + 96 * LDT) = rb3;
        }
        __syncthreads();
    }
    {
        float* ct = (float*)smem;
#pragma unroll
        for (int mi = 0; mi < 2; ++mi)
#pragma unroll
            for (int ni = 0; ni < 2; ++ni)
#pragma unroll
                for (int i = 0; i < 16; ++i) ct[(wm * 64 + mi * 32 + acc_row(i, h)) * CT_LD + wn * 64 + ni * 32 + l32] = acc[mi][ni][i];
        __syncthreads();
        epi(ct, row0, col0);
        __syncthreads();
    }
}

template <class Epi, class RowOf>
DI void gemm_phase(const bf16_t* A, int lda, const bf16_t* Bt, int K, int n_mt, int ntn, char* smem, const Epi& epi, const RowOf& row_of) {
    const int srow = tid() >> 3;
    for (int u = unit_first(); u < n_mt * ntn; u += gridDim.x) {
        const int mt = u / ntn, nt = u - mt * ntn;
        const int row0 = row_of(mt), col0 = nt * 128;
        const bf16_t* ap = A + (size_t)(row0 + srow) * lda;
        const bf16_t* bp = Bt + (size_t)(col0 + srow) * K;
        gemm_tile(ap, ap + (size_t)32 * lda, ap + (size_t)64 * lda, ap + (size_t)96 * lda,
                  bp, bp + (size_t)32 * K, bp + (size_t)64 * K, bp + (size_t)96 * K, K, smem, epi, row0, col0);
    }
}

struct WEpiSplit { static constexpr int MODE = 0; static constexpr bool TILE = false; bf16_t* O0; int ld0; bf16_t* O1; int ld1; int split; int ncol;
    DI void store(int row, int col, uint4 v) const { if (col < split) { if (col < ncol) *(uint4*)(O0 + (size_t)row * ld0 + col) = v; } else *(uint4*)(O1 + (size_t)row * ld1 + (col - split)) = v; } };
struct WEpiResidual { static constexpr int MODE = 0; static constexpr bool TILE = false; const Params* pp; int layer;
    DI void store(int row, int col, uint4 v) const {
        const Params& p = *pp;
        const float* md = p.mod + (size_t)(layer * 5 + mod_row(row)) * 6144 + 2048 + col;
        float* dst = res_row(p, row) + col;
        const float* srcp = layer == 0 ? in_row(p, row) + col : dst;
        const float4 x0 = *(const float4*)srcp, x1 = *(const float4*)(srcp + 4), g0 = *(const float4*)md, g1 = *(const float4*)(md + 4);
        float4 o0 = {x0.x + g0.x * bflo(v.x), x0.y + g0.y * bfhi(v.x), x0.z + g0.z * bflo(v.y), x0.w + g0.w * bfhi(v.y)};
        float4 o1 = {x1.x + g1.x * bflo(v.z), x1.y + g1.y * bfhi(v.z), x1.z + g1.z * bflo(v.w), x1.w + g1.w * bfhi(v.w)};
        *(float4*)dst = o0; *(float4*)(dst + 4) = o1;
    } };
struct WEpiRows { static constexpr int MODE = 0; static constexpr bool TILE = false; bf16_t* O; int ld; int rbase; int row_end;
    DI void store(int row, int col, uint4 v) const { if (row < row_end) *(uint4*)(O + (size_t)(row - rbase) * ld + col) = v; } };
constexpr float YP_SCALE = 4.f;
struct WEpiRows8 { static constexpr int MODE = 2; static constexpr bool TILE = false; unsigned char* O; int rbase; int row_end;
    DI void store8(int row, int col, uint4 v) const { if (row < row_end) *(uint4*)(O + (size_t)(row - rbase) * DM + col) = v; } };
struct WEpiGateUp { static constexpr int MODE = 1; bf16_t* HID; const float* sw; int pos_end;
    DI float row_w(int pos) const { return pos < pos_end ? sw[pos] * YP_SCALE : 0.f; }
    DI void store(int pos, int f, uint4 v) const { if (pos < pos_end) *(uint4*)(HID + (size_t)pos * FF + f) = v; } };
constexpr int LDA = 72;
constexpr int CBP = 264;
template <class Epi> struct GUnit { const bf16_t *a0, *a1, *a2, *a3, *bw; int row0, col0, K; Epi epi; };
struct GOff { unsigned a0, a1, a2, a3, bw; };
template <class Epi, class UnitFn>
DI void gemm_stream_w(int n_units, const UnitFn& unit_fn, char* smem, const char* base) {
    bf16_t* As = (bf16_t*)smem;
    const int t = tid(), lane = t & 63, wave = t >> 6, l32 = lane & 31, h = lane >> 5;
    const int srow = t >> 3, scol = (t & 7) * 8;
    int u = unit_first();
    if (u >= n_units) return;
    uint4 ra0, ra1, ra2, ra3;
    bf16x8 fbA[2][2], fbB[2][2];
#define GW_OFF(g) GOff{(unsigned)((const char*)(g).a0 - base) + (unsigned)scol * 2u, (unsigned)((const char*)(g).a1 - base) + (unsigned)scol * 2u, \
                       (unsigned)((const char*)(g).a2 - base) + (unsigned)scol * 2u, (unsigned)((const char*)(g).a3 - base) + (unsigned)scol * 2u, (unsigned)((const char*)(g).bw - base)}
    const __amdgpu_buffer_rsrc_t wrs = __builtin_amdgcn_make_buffer_rsrc((void*)base, 0, 0x7FFFFFFF, 0x00020000);
#define GW_LD(vo, so) __builtin_bit_cast(uint4, __builtin_amdgcn_raw_buffer_load_b128(wrs, (int)(vo), (int)(so), 0))
#define GW_LDF(vo, so) __builtin_bit_cast(bf16x8, __builtin_amdgcn_raw_buffer_load_b128(wrs, (int)(vo), (int)(so), 0))
#define GW_LOADA(o, ko) do { ra0 = GW_LD((o).a0, ko); ra1 = GW_LD((o).a1, ko); ra2 = GW_LD((o).a2, ko); ra3 = GW_LD((o).a3, ko); } while (0)
#define GW_STOREA(buf) do { bf16_t* ad = As + (buf) * 128 * LDA + srow * LDA + scol; *(uint4*)(ad) = ra0; *(uint4*)(ad + 32 * LDA) = ra1; \
        *(uint4*)(ad + 64 * LDA) = ra2; *(uint4*)(ad + 96 * LDA) = ra3; } while (0)
#define GW_LOADB(fb, bv, bs, K) do { fb[0][0] = GW_LDF(bv, bs); fb[1][0] = GW_LDF(bv, (bs) + 1024u); \
        fb[0][1] = GW_LDF(bv, (bs) + 64u * (unsigned)(K)); fb[1][1] = GW_LDF(bv, (bs) + 64u * (unsigned)(K) + 1024u); } while (0)
#define GW_COMPUTE(Ac, fb) do { \
        bf16x8 fa[2][4]; \
        _Pragma("unroll") for (int ks = 0; ks < 2; ++ks) \
            _Pragma("unroll") for (int mi = 0; mi < 4; ++mi) fa[ks][mi] = *(const bf16x8*)((Ac) + mi * 32 * LDA + ks * 16); \
        __builtin_amdgcn_sched_barrier(0); \
        _Pragma("unroll") for (int ks = 0; ks < 2; ++ks) \
            _Pragma("unroll") for (int mi = 0; mi < 4; ++mi) { acc[mi][0] = MFMA32(fb[ks][0], fa[ks][mi], acc[mi][0]); acc[mi][1] = MFMA32(fb[ks][1], fa[ks][mi], acc[mi][1]); } \
        __builtin_amdgcn_sched_barrier(0); } while (0)
    GUnit<Epi> cur = unit_fn(u, srow, wave, lane);
    GOff co = GW_OFF(cur);
    GW_LOADA(co, 0u);
    GW_LOADB(fbA, co.bw, 0u, cur.K);
    for (;;) {
        const int ns = cur.K >> 6;
        GW_STOREA(0);
        __syncthreads();
        const int un = u + (int)gridDim.x;
        const bool has_next = un < n_units;
        GUnit<Epi> nxt = cur;
        if (has_next) nxt = unit_fn(un, srow, wave, lane);
        const GOff no = GW_OFF(nxt);
        f32x16 acc[4][2];
#pragma unroll
        for (int i = 0; i < 4; ++i)
#pragma unroll
            for (int j = 0; j < 2; ++j)
#pragma unroll
                for (int e = 0; e < 16; ++e) acc[i][j][e] = 0.f;
        for (int st = 0; st < ns; ++st) {
            const bool more = (st + 1 < ns);
            const bf16_t* Ac = As + (st & 1) * 128 * LDA + l32 * LDA + h * 8;
            {
                const unsigned ko = more ? (unsigned)(st + 1) * 128u : 0u;
                ra0 = GW_LD(more ? co.a0 : no.a0, ko); ra1 = GW_LD(more ? co.a1 : no.a1, ko);
                ra2 = GW_LD(more ? co.a2 : no.a2, ko); ra3 = GW_LD(more ? co.a3 : no.a3, ko);
            }
            GW_LOADB(fbB, co.bw, (unsigned)(2 * st + 1) * 2048u, cur.K);
            __builtin_amdgcn_sched_barrier(0);
            GW_COMPUTE(Ac, fbA);
            {
                const unsigned pbv = more ? co.bw : no.bw, pbs = more ? (unsigned)(2 * st + 2) * 2048u : 0u;
                const int K = more ? cur.K : nxt.K;
                GW_LOADB(fbA, pbv, pbs, K);
            }
            __builtin_amdgcn_sched_barrier(0);
            GW_COMPUTE(Ac + 32, fbB);
            if (more) GW_STOREA((st + 1) & 1);
            __syncthreads();
        }
        {
            bf16_t* cb = (bf16_t*)smem;
            if constexpr (Epi::MODE == 0) {
#pragma unroll
                for (int mi = 0; mi < 4; ++mi)
#pragma unroll
                    for (int ni = 0; ni < 2; ++ni)
#pragma unroll
                        for (int q = 0; q < 4; ++q) {
                            uint2 w; w.x = pk_bf16(acc[mi][ni][4 * q], acc[mi][ni][4 * q + 1]); w.y = pk_bf16(acc[mi][ni][4 * q + 2], acc[mi][ni][4 * q + 3]);
                            *(uint2*)(cb + (mi * 32 + l32) * CBP + wave * 64 + ni * 32 + 8 * q + 4 * h) = w;
                        }
                __syncthreads();
                if constexpr (Epi::TILE) cur.epi.tile(cb, cur.row0, cur.col0, smem);
                else {
#pragma unroll 4
                    for (int it = 0; it < 16; ++it) {
                        const int idx = t + NTHR * it, row = idx >> 5, c8 = (idx & 31) * 8;
                        cur.epi.store(cur.row0 + row, cur.col0 + c8, *(const uint4*)(cb + row * CBP + c8));
                    }
                }
            } else if constexpr (Epi::MODE == 2) {
                unsigned char* c8 = (unsigned char*)smem;
                constexpr int C8P = 272;
#pragma unroll
                for (int mi = 0; mi < 4; ++mi)
#pragma unroll
                    for (int ni = 0; ni < 2; ++ni)
#pragma unroll
                        for (int q = 0; q < 4; ++q) {
                            int w = __builtin_amdgcn_cvt_pk_fp8_f32(acc[mi][ni][4 * q], acc[mi][ni][4 * q + 1], 0, false);
                            w = __builtin_amdgcn_cvt_pk_fp8_f32(acc[mi][ni][4 * q + 2], acc[mi][ni][4 * q + 3], w, true);
                            *(int*)(c8 + (mi * 32 + l32) * C8P + wave * 64 + ni * 32 + 8 * q + 4 * h) = w;
                        }
                __syncthreads();
#pragma unroll 4
                for (int it = 0; it < 8; ++it) {
                    const int idx = t + NTHR * it, row = idx >> 4, c16 = (idx & 15) * 16;
                    cur.epi.store8(cur.row0 + row, cur.col0 + c16, *(const uint4*)(c8 + row * C8P + c16));
                }
            } else {
#pragma unroll
                for (int mi = 0; mi < 4; ++mi) {
                    const float wr = cur.epi.row_w(cur.row0 + mi * 32 + l32);
#pragma unroll
                    for (int q = 0; q < 4; ++q) {
                        float o[4];
#pragma unroll
                        for (int j = 0; j < 4; ++j) o[j] = silu_f(acc[mi][0][4 * q + j]) * acc[mi][1][4 * q + j] * wr;
                        uint2 w; w.x = pk_bf16(o[0], o[1]); w.y = pk_bf16(o[2], o[3]);
                        *(uint2*)(cb + (mi * 32 + l32) * CBP + wave * 32 + 8 * q + 4 * h) = w;
                    }
                }
                __syncthreads();
#pragma unroll 4
                for (int it = 0; it < 8; ++it) {
                    const int idx = t + NTHR * it, row = idx >> 4, c8 = (idx & 15) * 8;
                    cur.epi.store(cur.row0 + row, (cur.col0 >> 1) + c8, *(const uint4*)(cb + row * CBP + c8));
                }
            }
            __syncthreads();
        }
        if (!has_next) break;
        cur = nxt; co = no; u = un;
    }
#undef GW_OFF
#undef GW_LD
#undef GW_LDF
#undef GW_LOADA
#undef GW_STOREA
#undef GW_LOADB
#undef GW_COMPUTE
}
template <class Epi, class RowOf>
DI void gemm_phase_w(const char* base, const bf16_t* A, int lda, const bf16_t* Bt, int K, int n_mt, int ntn, char* smem, const Epi& epi, const RowOf& row_of) {
    auto unit_fn = [&](int u, int srow, int wave, int lane) {
        const int mt = u / ntn, nt = u - mt * ntn;
        const int row0 = row_of(mt), col0 = nt * 256;
        const bf16_t* ap = A + (size_t)(row0 + srow) * lda;
        const bf16_t* bw = Bt + (size_t)(col0 + wave * 64) * K + lane * 8;
        return GUnit<Epi>{ap, ap + (size_t)32 * lda, ap + (size_t)64 * lda, ap + (size_t)96 * lda, bw, row0, col0, K, epi};
    };
    gemm_stream_w<Epi>(n_mt * ntn, unit_fn, smem, base);
}
struct RowIdent { DI int operator()(int mt) const { return mt * 128; } };
struct RowLatent { DI int operator()(int mt) const { return (mt >> 6) * LT + LC + (mt & 63) * 128; } };

DI uint4 pack8(const float* s) {
    const float4 a = *(const float4*)s, b = *(const float4*)(s + 4);
    uint4 o; o.x = pk_bf16(a.x, a.y); o.y = pk_bf16(a.z, a.w); o.z = pk_bf16(b.x, b.y); o.w = pk_bf16(b.z, b.w); return o;
}
struct EpiSplitBf16 {
    bf16_t* O0; int ld0; bf16_t* O1; int ld1; int split;
    DI void operator()(const float* ct, int row0, int col0) const {
        bf16_t* base; int ld;
        if (col0 < split) { base = O0 + col0; ld = ld0; } else { base = O1 + (col0 - split); ld = ld1; }
#pragma unroll 2
        for (int it = 0; it < 8; ++it) {
            const int idx = tid() + NTHR * it, row = idx >> 4, c8 = (idx & 15) * 8;
            *(uint4*)(base + (size_t)(row0 + row) * ld + c8) = pack8(ct + row * CT_LD + c8);
        }
    }
};
struct EpiResidual {
    Params p; int layer;
    DI void operator()(const float* ct, int row0, int col0) const {
        const float* md = p.mod + (size_t)(layer * 5 + mod_row(row0)) * 6144 + 2048 + col0;
#pragma unroll 2
        for (int it = 0; it < 16; ++it) {
            const int idx = tid() + NTHR * it, row = idx >> 5, c4 = (idx & 31) * 4, r = row0 + row;
            const float4 a = *(const float4*)(ct + row * CT_LD + c4), g = *(const float4*)(md + c4);
            float* dst = res_row(p, r) + col0 + c4;
            const float4 x = layer == 0 ? *(const float4*)(in_row(p, r) + col0 + c4) : *(const float4*)dst;
            float4 o = {x.x + g.x * a.x, x.y + g.y * a.y, x.z + g.z * a.z, x.w + g.w * a.w};
            *(float4*)dst = o;
        }
    }
};

template <int DK, int DV, bool LSUM_MFMA>
DI void attn_core(const bf16_t* Qh, const bf16_t* Kh, const bf16_t* VTh, int qpos0, int nkeys, float c, float kmax2, char* smem,
                  f32x16 (&O)[DV / 32], float& l_tot) {
    constexpr int KS = DK / 16, NDB = DV / 32, LDK = DK + 8, KCH = DK / 8, NKCH = 64 * KCH, NKC = (NKCH + NTHR - 1) / NTHR, NVC = DV * 8 / NTHR;
    bf16_t* Ks = (bf16_t*)smem;
    bf16_t* Vs = Ks + 2 * 64 * LDK;
    const int t = tid(), lane = t & 63, wave = t >> 6, l32 = lane & 31, h = lane >> 5;
    bf16x8 qf[KS];
    {
        const bf16_t* qp = Qh + (size_t)(qpos0 + wave * 32 + l32) * DK + h * 8;
#pragma unroll
        for (int ks = 0; ks < KS; ++ks) qf[ks] = *(const bf16x8*)(qp + ks * 16);
    }
    static_assert(NKC == 2 && (NVC == 2 || NVC == 4), "staging shape");
    uint4 rk0, rk1, rv0, rv1, rv2 = {0u, 0u, 0u, 0u}, rv3 = {0u, 0u, 0u, 0u};
    const int kidx1 = (NKCH % NTHR == 0 || t + NTHR < NKCH) ? t + NTHR : NKCH - 1;
    const bool k1ok = (NKCH % NTHR == 0) || (t + NTHR < NKCH);
    const __amdgpu_buffer_rsrc_t krs = __builtin_amdgcn_make_buffer_rsrc((void*)Kh, 0, 0x7FFFFFFF, 0x00020000);
    const __amdgpu_buffer_rsrc_t vrs = __builtin_amdgcn_make_buffer_rsrc((void*)VTh, 0, 0x7FFFFFFF, 0x00020000);
    const int ko0 = t * 16, ko1 = kidx1 * 16;
    const int vo0 = ((t >> 3) * LT + (t & 7) * 8) * 2;
    const int ks0 = (t / KCH) * LDK + (t % KCH) * 8, ks1 = ((t + NTHR) / KCH) * LDK + ((t + NTHR) % KCH) * 8;
    const int vs0 = (t >> 3) * LDT + (t & 7) * 8;
#define ATT_BL(rs, vo, so) __builtin_bit_cast(uint4, __builtin_amdgcn_raw_buffer_load_b128(rs, vo, so, 0))
#define ATT_LOAD(key0) do { const int kso_ = (key0) * (DK * 2), vso_ = (key0) * 2; \
        rk0 = ATT_BL(krs, ko0, kso_); rk1 = ATT_BL(krs, ko1, kso_); \
        rv0 = ATT_BL(vrs, vo0, vso_); rv1 = ATT_BL(vrs, vo0, vso_ + 32 * LT * 2); \
        if constexpr (NVC == 4) { rv2 = ATT_BL(vrs, vo0, vso_ + 64 * LT * 2); rv3 = ATT_BL(vrs, vo0, vso_ + 96 * LT * 2); } } while (0)
#define ATT_STORE(buf) do { *(uint4*)(Ks + (buf) * 64 * LDK + ks0) = rk0; if (k1ok) *(uint4*)(Ks + (buf) * 64 * LDK + ks1) = rk1; \
        *(uint4*)(Vs + (buf) * DV * LDT + vs0) = rv0; *(uint4*)(Vs + (buf) * DV * LDT + 32 * LDT + vs0) = rv1; \
        if constexpr (NVC == 4) { *(uint4*)(Vs + (buf) * DV * LDT + 64 * LDT + vs0) = rv2; *(uint4*)(Vs + (buf) * DV * LDT + 96 * LDT + vs0) = rv3; } } while (0)
    ATT_LOAD(0);
    ATT_STORE(0);
    __syncthreads();
#pragma unroll
    for (int d = 0; d < NDB; ++d)
#pragma unroll
        for (int e = 0; e < 16; ++e) O[d][e] = 0.f;
    float qn2 = 0.f;
#pragma unroll
    for (int ks = 0; ks < KS; ++ks) {
        float qv[8];
#pragma unroll
        for (int j = 0; j < 8; ++j) qv[j] = bf2f((bf16_t)qf[ks][j]) * c;
        uint4 w; w.x = pk_bf16(qv[0], qv[1]); w.y = pk_bf16(qv[2], qv[3]); w.z = pk_bf16(qv[4], qv[5]); w.w = pk_bf16(qv[6], qv[7]);
        qf[ks] = __builtin_bit_cast(bf16x8, w);
#pragma unroll
        for (int j = 0; j < 8; ++j) { const float r = bf2f((bf16_t)qf[ks][j]); qn2 += r * r; }
    }
    qn2 = half_sum(qn2);
    const float Mrow = sqrtf(qn2 * kmax2) * 1.02f + 1e-3f;
    const bool fast = __all(Mrow < 50.f) != 0;
    float m_run = -1e30f, l_run = 0.f;
    const int nt = nkeys >> 6;
    auto tile_loop = [&](auto fast_tag) {
    constexpr bool FAST = decltype(fast_tag)::value;
    f32x16 Cinit;
#pragma unroll
    for (int e = 0; e < 16; ++e) Cinit[e] = FAST ? -Mrow : 0.f;
    f32x16 Lacc;
#pragma unroll
    for (int e = 0; e < 16; ++e) Lacc[e] = 0.f;
    const bf16x8 ones = {0x3F80, 0x3F80, 0x3F80, 0x3F80, 0x3F80, 0x3F80, 0x3F80, 0x3F80};
    auto body = [&](auto cur_c, const int kt, const bool more) {
        const int cur = cur_c;
        if (more) { const int key0 = (kt + 1) * 64; ATT_LOAD(key0); }
        __builtin_amdgcn_sched_barrier(0);
        f32x16 S0, S1;
        const bf16_t* kb = Ks + (cur * 64 + l32) * LDK + h * 8;
        bf16x8 kf0[KS], kf1[KS];
#pragma unroll
        for (int ks = 0; ks < KS; ++ks) { kf0[ks] = *(const bf16x8*)(kb + ks * 16); kf1[ks] = *(const bf16x8*)(kb + 32 * LDK + ks * 16); }
        __builtin_amdgcn_sched_barrier(0);
        S0 = MFMA32(kf0[0], qf[0], Cinit); S1 = MFMA32(kf1[0], qf[0], Cinit);
#pragma unroll
        for (int ks = 1; ks < KS; ++ks) { S0 = MFMA32(kf0[ks], qf[ks], S0); S1 = MFMA32(kf1[ks], qf[ks], S1); }
        constexpr int VPF = NDB < 2 ? NDB : 2;
        bf16x8 vf[VPF][4];
#pragma unroll
        for (int d = 0; d < VPF; ++d) {
            const bf16_t* vb = Vs + (cur * DV + d * 32 + l32) * LDT + h * 8;
#pragma unroll
            for (int j = 0; j < 4; ++j) vf[d][j] = *(const bf16x8*)(vb + j * 16);
        }
        __builtin_amdgcn_sched_barrier(0);
        if constexpr (FAST) {
#pragma unroll
            for (int e = 0; e < 16; ++e) { S0[e] = __builtin_amdgcn_exp2f(S0[e]); S1[e] = __builtin_amdgcn_exp2f(S1[e]); }
            if constexpr (!LSUM_MFMA) {
#pragma unroll
                for (int e = 0; e < 16; ++e) { l_run += S0[e]; l_run += S1[e]; }
            }
        } else {
            float mx = fmaxf(S0[0], S1[0]);
#pragma unroll
            for (int e = 1; e < 16; ++e) mx = fmaxf(mx, fmaxf(S0[e], S1[e]));
            mx = half_max(mx);
            const float m_new = fmaxf(m_run, mx);
            const float alpha = __builtin_amdgcn_exp2f(m_run - m_new);
            m_run = m_new;
            float ls = 0.f;
#pragma unroll
            for (int e = 0; e < 16; ++e) { S0[e] = __builtin_amdgcn_exp2f(S0[e] - m_new); S1[e] = __builtin_amdgcn_exp2f(S1[e] - m_new); ls += S0[e] + S1[e]; }
            l_run = l_run * alpha + ls;
#pragma unroll
            for (int d = 0; d < NDB; ++d)
#pragma unroll
                for (int e = 0; e < 16; ++e) O[d][e] *= alpha;
        }
        bf16x8 pf[4];
        {
            uint4 w;
            w.x = pk_bf16(S0[0], S0[1]); w.y = pk_bf16(S0[2], S0[3]); w.z = pk_bf16(S0[4], S0[5]); w.w = pk_bf16(S0[6], S0[7]); pf[0] = __builtin_bit_cast(bf16x8, w);
            w.x = pk_bf16(S0[8], S0[9]); w.y = pk_bf16(S0[10], S0[11]); w.z = pk_bf16(S0[12], S0[13]); w.w = pk_bf16(S0[14], S0[15]); pf[1] = __builtin_bit_cast(bf16x8, w);
            w.x = pk_bf16(S1[0], S1[1]); w.y = pk_bf16(S1[2], S1[3]); w.z = pk_bf16(S1[4], S1[5]); w.w = pk_bf16(S1[6], S1[7]); pf[2] = __builtin_bit_cast(bf16x8, w);
            w.x = pk_bf16(S1[8], S1[9]); w.y = pk_bf16(S1[10], S1[11]); w.z = pk_bf16(S1[12], S1[13]); w.w = pk_bf16(S1[14], S1[15]); pf[3] = __builtin_bit_cast(bf16x8, w);
        }
        if constexpr (FAST && LSUM_MFMA) {
#pragma unroll
            for (int j = 0; j < 4; ++j) Lacc = MFMA32(ones, pf[j], Lacc);
        }
        __builtin_amdgcn_sched_barrier(0);
        if constexpr (NDB > VPF) {
#pragma unroll
            for (int d = 0; d < NDB; ++d) {
#pragma unroll
                for (int j = 0; j < 4; ++j) O[d] = MFMA32(vf[d % VPF][j], pf[j], O[d]);
                if (d + VPF < NDB) {
                    __builtin_amdgcn_sched_barrier(0);
                    const bf16_t* vb = Vs + (cur * DV + (d + VPF) * 32 + l32) * LDT + h * 8;
#pragma unroll
                    for (int j = 0; j < 4; ++j) vf[d % VPF][j] = *(const bf16x8*)(vb + j * 16);
                    __builtin_amdgcn_sched_barrier(0);
                }
            }
        } else {
#pragma unroll
            for (int d = 0; d < VPF; ++d)
#pragma unroll
                for (int j = 0; j < 4; ++j) O[d] = MFMA32(vf[d][j], pf[j], O[d]);
        }
        __builtin_amdgcn_sched_barrier(0);
        if (more) { const int nb = cur ^ 1; ATT_STORE(nb); }
        __syncthreads();
    };
    for (int kt = 0; kt < nt; kt += 2) {
        body(std::integral_constant<int, 0>{}, kt, true);
        body(std::integral_constant<int, 1>{}, kt + 1, kt + 2 < nt);
    }
    if constexpr (FAST && LSUM_MFMA) l_run = 0.5f * Lacc[0];
    };
    if (fast) tile_loop(std::true_type{}); else tile_loop(std::false_type{});
    l_tot = half_sum(l_run);
#undef ATT_LOAD
#undef ATT_BL
#undef ATT_STORE
}

DI float kmax_of(const Params& p, int idx) { return __uint_as_float(__hip_atomic_load(p.kmax + idx, __ATOMIC_RELAXED, __HIP_MEMORY_SCOPE_AGENT)); }
DI void attn0_unit(const Params& p, int u, char* smem) {
    int b, hd, qb;
    if (u < NB * 4 * 64) { b = u / 256; hd = (u >> 6) & 3; qb = 2 + (u & 63); }
    else { const int v = u - NB * 4 * 64; b = v >> 3; hd = (v >> 1) & 3; qb = v & 1; }
    const int nkeys = qb < 2 ? LC : LT;
    const bf16_t* Q = (const bf16_t*)p.x2;
    const bf16_t* K = Q + (size_t)NB * 8 * LT * 64;
    const bf16_t* VT = K + (size_t)NB * 8 * LT * 64;
    float* Otmp = (float*)p.x1;
    bf16_t* CAT = (bf16_t*)p.x4;
    const int lane = tid() & 63, wave = tid() >> 6, l32 = lane & 31, h = lane >> 5;
    const int qpos0 = qb * 128;
    const int row = b * LT + qpos0 + wave * 32 + l32;
    const float c = 0.125f * LOG2E;
    const bf16_t* VTh = VT + (size_t)(b * 4 + hd) * 128 * LT;
    float* ot = Otmp + ((size_t)row * 4 + hd) * 128;
    f32x16 O[4]; float l_tot;
    attn_core<64, 128, false>(Q + (size_t)(b * 8 + hd * 2 + 0) * LT * 64, K + (size_t)(b * 8 + hd * 2 + 0) * LT * 64, VTh, qpos0, nkeys, c, kmax_of(p, b * 8 + hd * 2 + 0), smem, O, l_tot);
    {
        const float inv = 1.f / l_tot;
#pragma unroll
        for (int d = 0; d < 4; ++d)
#pragma unroll
            for (int g = 0; g < 4; ++g) {
                float4 v = {O[d][4 * g] * inv, O[d][4 * g + 1] * inv, O[d][4 * g + 2] * inv, O[d][4 * g + 3] * inv};
                *(float4*)(ot + d * 32 + 8 * g + 4 * h) = v;
            }
    }
    attn_core<64, 128, false>(Q + (size_t)(b * 8 + hd * 2 + 1) * LT * 64, K + (size_t)(b * 8 + hd * 2 + 1) * LT * 64, VTh, qpos0, nkeys, c, kmax_of(p, b * 8 + hd * 2 + 1), smem, O, l_tot);
    {
        const float inv = 1.f / l_tot, lam = p.lamv[0];
        float ss = 0.f;
#pragma unroll
        for (int d = 0; d < 4; ++d)
#pragma unroll
            for (int g = 0; g < 4; ++g) {
                const float4 o1 = *(const float4*)(ot + d * 32 + 8 * g + 4 * h);
                O[d][4 * g] = o1.x - lam * O[d][4 * g] * inv; O[d][4 * g + 1] = o1.y - lam * O[d][4 * g + 1] * inv;
                O[d][4 * g + 2] = o1.z - lam * O[d][4 * g + 2] * inv; O[d][4 * g + 3] = o1.w - lam * O[d][4 * g + 3] * inv;
                ss += O[d][4 * g] * O[d][4 * g] + O[d][4 * g + 1] * O[d][4 * g + 1] + O[d][4 * g + 2] * O[d][4 * g + 2] + O[d][4 * g + 3] * O[d][4 * g + 3];
            }
        ss = half_sum(ss);
        const float rinv = rsqrtf(ss * (1.f / 128.f) + EPSV) * 0.8f;
        const float* sub = p.in[10];
        bf16_t* op = CAT + (size_t)row * DM + hd * 128;
#pragma unroll
        for (int d = 0; d < 4; ++d)
#pragma unroll
            for (int g = 0; g < 4; ++g) {
                const int dv = d * 32 + 8 * g + 4 * h;
                const float4 sb = *(const float4*)(sub + dv);
                uint2 o; o.x = pk_bf16(O[d][4 * g] * rinv * sb.x, O[d][4 * g + 1] * rinv * sb.y); o.y = pk_bf16(O[d][4 * g + 2] * rinv * sb.z, O[d][4 * g + 3] * rinv * sb.w);
                *(uint2*)(op + dv) = o;
            }
    }
}

DI void attn1_unit(const Params& p, int u, char* smem) {
    const bf16_t* Q1 = (const bf16_t*)p.x2;
    const bf16_t* K1 = Q1 + (size_t)NB * 8 * LT * 64;
    const bf16_t* VT1 = K1 + (size_t)NB * 2 * LT * 64;
    const bf16_t* MQ = VT1 + (size_t)NB * 2 * 64 * LT;
    const bf16_t* MK = MQ + (size_t)NB * 8 * LT * 48;
    const bf16_t* MVT = MK + (size_t)NB * 8 * LT * 48;
    bf16_t* CAT = (bf16_t*)p.x4;
    const int lane = tid() & 63, wave = tid() >> 6, l32 = lane & 31, h = lane >> 5;
    const int mla = u >= 2048, v = u & 2047, b = v >> 9, hd = (v >> 6) & 7, qb = 2 + (v & 63);
    const int qpos0 = qb * 128;
    const int row = b * LT + qpos0 + wave * 32 + l32;
    f32x16 O[2]; float l_tot;
    if (!mla) attn_core<64, 64, false>(Q1 + (size_t)(b * 8 + hd) * LT * 64, K1 + (size_t)(b * 2 + (hd >> 2)) * LT * 64, VT1 + (size_t)(b * 2 + (hd >> 2)) * 64 * LT, qpos0, LT, 0.125f * LOG2E, kmax_of(p, 32 + b * 2 + (hd >> 2)), smem, O, l_tot);
    else attn_core<48, 64, false>(MQ + (size_t)(b * 8 + hd) * LT * 48, MK + (size_t)(b * 8 + hd) * LT * 48, MVT + (size_t)(b * 8 + hd) * 64 * LT, qpos0, LT, 0.14433756729740643f * LOG2E, kmax_of(p, 40 + b * 8 + hd), smem, O, l_tot);
    const float inv = 1.f / l_tot;
    bf16_t* op = CAT + (size_t)row * DM + mla * 512 + hd * 64;
#pragma unroll
    for (int d = 0; d < 2; ++d)
#pragma unroll
        for (int g = 0; g < 4; ++g) {
            uint2 o; o.x = pk_bf16(O[d][4 * g] * inv, O[d][4 * g + 1] * inv); o.y = pk_bf16(O[d][4 * g + 2] * inv, O[d][4 * g + 3] * inv);
            *(uint2*)(op + d * 32 + 8 * g + 4 * h) = o;
        }
}

#define ROPE64(x, cr, sr, cc, sc) do { _Pragma("unroll") for (int i_ = 0; i_ < 16; ++i_) { \
    const float a_ = x[i_], b_ = x[i_ + 16]; x[i_] = a_ * (cr)[i_] - b_ * (sr)[i_]; x[i_ + 16] = a_ * (sr)[i_] + b_ * (cr)[i_]; \
    const float c_ = x[32 + i_], d_ = x[48 + i_]; x[32 + i_] = c_ * (cc)[i_] - d_ * (sc)[i_]; x[48 + i_] = c_ * (sc)[i_] + d_ * (cc)[i_]; } } while (0)

constexpr int SEG_LDS_OFF_E = 73728;
struct WEpiInProj0 { static constexpr int MODE = 0; static constexpr bool TILE = true; const Params* pp;
    DI void store(int, int, uint4) const {}
    DI void tile(const bf16_t* cb, int row0, int col0, char* smem) const {
        const Params& p = *pp;
        const int t = tid(), nt = col0 >> 8;
        const int b = row0 / LT, pos0 = row0 - b * LT;
        const bool lat = pos0 >= LC;
        bf16_t* Q = (bf16_t*)p.x2;
        bf16_t* K = Q + (size_t)NB * 8 * LT * 64;
        bf16_t* VT = K + (size_t)NB * 8 * LT * 64;
        if (nt < 4) {
            const bool isk = nt >= 2; const int hj0 = (nt & 1) * 4;
            unsigned* lmax = (unsigned*)(smem + SEG_LDS_OFF_E);
            if (isk) { if (t < 4) lmax[t] = 0u; __syncthreads(); }
#pragma unroll 1
            for (int it = 0; it < 2; ++it) {
                const int item = t + NTHR * it, rr = item >> 2, v = item & 3;
                const bf16_t* src = cb + rr * CBP + v * 64;
                float x[64];
#pragma unroll
                for (int c8 = 0; c8 < 8; ++c8) {
                    const uint4 w = *(const uint4*)(src + c8 * 8);
                    x[c8 * 8 + 0] = bflo(w.x); x[c8 * 8 + 1] = bfhi(w.x); x[c8 * 8 + 2] = bflo(w.y); x[c8 * 8 + 3] = bfhi(w.y);
                    x[c8 * 8 + 4] = bflo(w.z); x[c8 * 8 + 5] = bfhi(w.z); x[c8 * 8 + 6] = bflo(w.w); x[c8 * 8 + 7] = bfhi(w.w);
                }
                if (lat) {
                    const int tpos = pos0 + rr - LC, gr = tpos >> 6, gc = tpos & 63;
                    const float* cr = p.tab + TB_CR + gr * 16; const float* sr = p.tab + TB_SR + gr * 16;
                    const float* cc = p.tab + TB_CC + gc * 16; const float* sc = p.tab + TB_SC + gc * 16;
                    ROPE64(x, cr, sr, cc, sc);
                }
                if (isk) { float ss = 0.f;
#pragma unroll
                    for (int i = 0; i < 64; ++i) ss += x[i] * x[i];
                    atomicMax(&lmax[v], __float_as_uint(ss)); }
                bf16_t* dst = (isk ? K : Q) + ((size_t)(b * 8 + hj0 + v) * LT + pos0 + rr) * 64;
#pragma unroll
                for (int c8 = 0; c8 < 8; ++c8) {
                    uint4 w; w.x = pk_bf16(x[c8 * 8], x[c8 * 8 + 1]); w.y = pk_bf16(x[c8 * 8 + 2], x[c8 * 8 + 3]); w.z = pk_bf16(x[c8 * 8 + 4], x[c8 * 8 + 5]); w.w = pk_bf16(x[c8 * 8 + 6], x[c8 * 8 + 7]);
                    *(uint4*)(dst + c8 * 8) = w;
                }
            }
            if (isk) { __syncthreads(); if (t < 4) atomicMax(&p.kmax[b * 8 + hj0 + t], lmax[t]); }
        } else if (nt < 6) {
#pragma unroll 4
            for (int it = 0; it < 16; ++it) {
                const int idx = t + NTHR * it, col = idx >> 4, q = idx & 15;
                const int kbase = 16 * (q >> 1) + 4 * (q & 1);
                unsigned short e[8];
#pragma unroll
                for (int j = 0; j < 8; ++j) e[j] = cb[(kbase + 8 * (j >> 2) + (j & 3)) * CBP + col];
                uint4 o; o.x = e[0] | ((unsigned)e[1] << 16); o.y = e[2] | ((unsigned)e[3] << 16); o.z = e[4] | ((unsigned)e[5] << 16); o.w = e[6] | ((unsigned)e[7] << 16);
                const int head = (nt - 4) * 2 + (col >> 7), dv = col & 127;
                *(uint4*)(VT + ((size_t)(b * 4 + head) * 128 + dv) * LT + pos0 + q * 8) = o;
            }
        } else {
            bf16_t* UG = (bf16_t*)(p.x1 + (size_t)NT * 1536 * 2);
#pragma unroll 4
            for (int it = 0; it < 16; ++it) {
                const int idx = t + NTHR * it, row = idx >> 5, c8 = (idx & 31) * 8;
                *(uint4*)(UG + (size_t)(row0 + row) * 1024 + (col0 - 1536) + c8) = *(const uint4*)(cb + row * CBP + c8);
            }
        }
    }
};

template <int NC, int LP>
DI void vt_write(const bf16_t* tile, bf16_t* dst, int pos0) {
    const int t = tid();
#pragma unroll
    for (int it = 0; it < NC * 8 / NTHR; ++it) {
        const int idx = t + NTHR * it, col = idx >> 3, q = idx & 7;
        const int kbase = 16 * (q >> 1) + 4 * (q & 1);
        unsigned short e[8];
#pragma unroll
        for (int j = 0; j < 8; ++j) e[j] = tile[(kbase + 8 * (j >> 2) + (j & 3)) * LP + col];
        uint4 o; o.x = e[0] | ((unsigned)e[1] << 16); o.y = e[2] | ((unsigned)e[3] << 16); o.z = e[4] | ((unsigned)e[5] << 16); o.w = e[6] | ((unsigned)e[7] << 16);
        *(uint4*)(dst + (size_t)col * LT + pos0 + q * 8) = o;
    }
}

DI void postproj0_unit(const Params& p, int u, char* smem) {
    const bf16_t* raw = (const bf16_t*)p.x1;
    bf16_t* Q = (bf16_t*)p.x2;
    bf16_t* K = Q + (size_t)NB * 8 * LT * 64;
    bf16_t* VT = K + (size_t)NB * 8 * LT * 64;
    float* tb = (float*)smem;
    bf16_t* tile = (bf16_t*)(smem + 8448);
    const int t = tid();
    const int r0 = u * 64, b = r0 / LT, pos0 = r0 - b * LT;
    const bool lat = pos0 >= LC;
    const int gr = lat ? (pos0 - LC) >> 6 : 0;
    unsigned* lmax = (unsigned*)(smem + 32768);
    if (t < 16) lmax[t] = 0u;
    for (int i = t; i < 1024; i += NTHR) { tb[i] = p.tab[TB_CC + i]; tb[1024 + i] = p.tab[TB_SC + i]; }
    if (t < 16) { tb[2048 + t] = p.tab[TB_CR + gr * 16 + t]; tb[2064 + t] = p.tab[TB_SR + gr * 16 + t]; }
    __syncthreads();
#pragma unroll 1
    for (int it = 0; it < 4; ++it) {
        const int item = t + NTHR * it, rr = item >> 4, vec = item & 15;
        const bf16_t* src = raw + (size_t)(r0 + rr) * 1536 + (vec < 8 ? vec * 64 : 512 + (vec - 8) * 64);
        float x[64];
#pragma unroll
        for (int c8 = 0; c8 < 8; ++c8) {
            const uint4 w = *(const uint4*)(src + c8 * 8);
            x[c8 * 8 + 0] = bflo(w.x); x[c8 * 8 + 1] = bfhi(w.x); x[c8 * 8 + 2] = bflo(w.y); x[c8 * 8 + 3] = bfhi(w.y);
            x[c8 * 8 + 4] = bflo(w.z); x[c8 * 8 + 5] = bfhi(w.z); x[c8 * 8 + 6] = bflo(w.w); x[c8 * 8 + 7] = bfhi(w.w);
        }
        if (lat) { const float* cc = tb + rr * 16; const float* sc = tb + 1024 + rr * 16; ROPE64(x, tb + 2048, tb + 2064, cc, sc); }
        if (vec >= 8) { float ss = 0.f;
#pragma unroll
            for (int i = 0; i < 64; ++i) ss += x[i] * x[i];
            atomicMax(&lmax[vec & 7], __float_as_uint(ss)); }
        bf16_t* dst = (vec < 8 ? Q : K) + ((size_t)(b * 8 + (vec & 7)) * LT + pos0 + rr) * 64;
#pragma unroll
        for (int c8 = 0; c8 < 8; ++c8) {
            uint4 w; w.x = pk_bf16(x[c8 * 8], x[c8 * 8 + 1]); w.y = pk_bf16(x[c8 * 8 + 2], x[c8 * 8 + 3]); w.z = pk_bf16(x[c8 * 8 + 4], x[c8 * 8 + 5]); w.w = pk_bf16(x[c8 * 8 + 6], x[c8 * 8 + 7]);
            *(uint4*)(dst + c8 * 8) = w;
        }
    }
    __syncthreads();
    if (t < 8) atomicMax(&p.kmax[b * 8 + t], lmax[t]);
    for (int hd = 0; hd < 4; ++hd) {
        __syncthreads();
#pragma unroll
        for (int it = 0; it < 4; ++it) {
            const int idx = t + NTHR * it, rr = idx >> 4, c16 = idx & 15;
            *(uint4*)(tile + rr * 136 + c16 * 8) = *(const uint4*)(raw + (size_t)(r0 + rr) * 1536 + 1024 + hd * 128 + c16 * 8);
        }
        __syncthreads();
        vt_write<128, 136>(tile, VT + (size_t)(b * 4 + hd) * 128 * LT, pos0);
    }
    __syncthreads();
}

DI void postproj1a_unit(const Params& p, int u, char* smem) {
    const bf16_t* raw = (const bf16_t*)p.x1;
    bf16_t* CQn = (bf16_t*)(p.x1 + (size_t)NT * CD_INP * 2);
    bf16_t* CKVn = CQn + (size_t)NT * 256;
    bf16_t* KR = CKVn + (size_t)NT * 128;
    bf16_t* Q1 = (bf16_t*)p.x2;
    bf16_t* K1 = Q1 + (size_t)NB * 8 * LT * 64;
    bf16_t* VT1 = K1 + (size_t)NB * 2 * LT * 64;
    float* tb = (float*)smem;
    bf16_t* tile = (bf16_t*)(smem + 8448);
    const int t = tid(), lane = t & 63, wave = t >> 6;
    const int r0 = u * 64, b = r0 / LT, pos0 = r0 - b * LT;
    const bool lat = pos0 >= LC;
    const int gr = lat ? (pos0 - LC) >> 6 : 0;
    unsigned* lmax = (unsigned*)(smem + 32768);
    if (t < 16) lmax[t] = 0u;
    for (int i = t; i < 1024; i += NTHR) { tb[i] = p.tab[TB_CC + i]; tb[1024 + i] = p.tab[TB_SC + i]; }
    if (t < 16) { tb[2048 + t] = p.tab[TB_CR + gr * 16 + t]; tb[2064 + t] = p.tab[TB_SR + gr * 16 + t]; }
    __syncthreads();
    uint4 rw[8];
    {
        const int rr = t / 10, vec = t - rr * 10;
        const bf16_t* src = raw + (size_t)(r0 + rr) * CD_INP + vec * 64;
#pragma unroll
        for (int c8 = 0; c8 < 8; ++c8) rw[c8] = *(const uint4*)(src + c8 * 8);
    }
#pragma unroll 1
    for (int it = 0; it < 3; ++it) {
        const int item = t + NTHR * it;
        uint4 rn[8];
        {
            int itn = item + NTHR; if (itn > 639) itn = 639;
            const int rrn = itn / 10, vecn = itn - rrn * 10;
            const bf16_t* srcn = raw + (size_t)(r0 + rrn) * CD_INP + vecn * 64;
#pragma unroll
            for (int c8 = 0; c8 < 8; ++c8) rn[c8] = *(const uint4*)(srcn + c8 * 8);
        }
        if (item < 640) {
            const int rr = item / 10, vec = item - rr * 10;
            const float* nw = vec < 8 ? p.in[20] : p.in[21];
            float x[64]; float ss = 0.f;
#pragma unroll
            for (int c8 = 0; c8 < 8; ++c8) {
                const uint4 w = rw[c8];
                x[c8 * 8 + 0] = bflo(w.x); x[c8 * 8 + 1] = bfhi(w.x); x[c8 * 8 + 2] = bflo(w.y); x[c8 * 8 + 3] = bfhi(w.y);
                x[c8 * 8 + 4] = bflo(w.z); x[c8 * 8 + 5] = bfhi(w.z); x[c8 * 8 + 6] = bflo(w.w); x[c8 * 8 + 7] = bfhi(w.w);
            }
#pragma unroll
            for (int i = 0; i < 64; ++i) ss += x[i] * x[i];
            const float rinv = rsqrtf(ss * (1.f / 64.f) + EPSV);
#pragma unroll
            for (int i = 0; i < 64; ++i) x[i] = x[i] * rinv * nw[i];
            if (lat) { const float* cc = tb + rr * 16; const float* sc = tb + 1024 + rr * 16; ROPE64(x, tb + 2048, tb + 2064, cc, sc); }
            if (vec >= 8) { float s2 = 0.f;
#pragma unroll
                for (int i = 0; i < 64; ++i) s2 += x[i] * x[i];
                atomicMax(&lmax[vec - 8], __float_as_uint(s2)); }
            bf16_t* dst = vec < 8 ? Q1 + ((size_t)(b * 8 + vec) * LT + pos0 + rr) * 64 : K1 + ((size_t)(b * 2 + (vec - 8)) * LT + pos0 + rr) * 64;
#pragma unroll
            for (int c8 = 0; c8 < 8; ++c8) {
                uint4 w; w.x = pk_bf16(x[c8 * 8], x[c8 * 8 + 1]); w.y = pk_bf16(x[c8 * 8 + 2], x[c8 * 8 + 3]); w.z = pk_bf16(x[c8 * 8 + 4], x[c8 * 8 + 5]); w.w = pk_bf16(x[c8 * 8 + 6], x[c8 * 8 + 7]);
                *(uint4*)(dst + c8 * 8) = w;
            }
        }
#pragma unroll
        for (int c8 = 0; c8 < 8; ++c8) rw[c8] = rn[c8];
    }
    __syncthreads();
    if (t < 2) atomicMax(&p.kmax[32 + b * 2 + t], lmax[t]);
#pragma unroll
    for (int it = 0; it < 4; ++it) {
        const int idx = t + NTHR * it, rr = idx >> 4, c16 = idx & 15;
        *(uint4*)(tile + rr * 136 + c16 * 8) = *(const uint4*)(raw + (size_t)(r0 + rr) * CD_INP + 640 + c16 * 8);
    }
    __syncthreads();
    vt_write<128, 136>(tile, VT1 + (size_t)b * 128 * LT, pos0);
    {
        uint2 wq[16]; unsigned wk[16];
#pragma unroll
        for (int rr = 0; rr < 16; ++rr) {
            const bf16_t* src = raw + (size_t)(r0 + wave * 16 + rr) * CD_INP;
            wq[rr] = *(const uint2*)(src + 768 + lane * 4);
            wk[rr] = *(const unsigned*)(src + 1024 + lane * 2);
        }
        const float4 nwq = *(const float4*)(p.in[22] + lane * 4);
        const float2 nwk = *(const float2*)(p.in[23] + lane * 2);
#pragma unroll
        for (int rr = 0; rr < 16; ++rr) {
            const int r = r0 + wave * 16 + rr;
            {
                const float a = bflo(wq[rr].x), bb = bfhi(wq[rr].x), cc = bflo(wq[rr].y), d = bfhi(wq[rr].y);
                const float ss = wave_sum(a * a + bb * bb + cc * cc + d * d);
                const float rinv = rsqrtf(ss * (1.f / 256.f) + EPSV);
                uint2 o; o.x = pk_bf16(a * rinv * nwq.x, bb * rinv * nwq.y); o.y = pk_bf16(cc * rinv * nwq.z, d * rinv * nwq.w);
                *(uint2*)(CQn + (size_t)r * 256 + lane * 4) = o;
            }
            {
                const float a = bflo(wk[rr]), bb = bfhi(wk[rr]);
                const float ss = wave_sum(a * a + bb * bb);
                const float rinv = rsqrtf(ss * (1.f / 128.f) + EPSV);
                *(unsigned*)(CKVn + (size_t)r * 128 + lane * 2) = pk_bf16(a * rinv * nwk.x, bb * rinv * nwk.y);
            }
        }
    }
    if (t < 64) {
        const int r = r0 + t;
        const bf16_t* src = raw + (size_t)r * CD_INP + 1152;
        const uint4 w0 = *(const uint4*)src, w1 = *(const uint4*)(src + 8);
        float x[16] = {bflo(w0.x), bfhi(w0.x), bflo(w0.y), bfhi(w0.y), bflo(w0.z), bfhi(w0.z), bflo(w0.w), bfhi(w0.w),
                       bflo(w1.x), bfhi(w1.x), bflo(w1.y), bfhi(w1.y), bflo(w1.z), bfhi(w1.z), bflo(w1.w), bfhi(w1.w)};
        if (lat) {
#pragma unroll
            for (int i = 0; i < 4; ++i) {
                const float cr = p.tab[TB_CR4 + gr * 4 + i], sr = p.tab[TB_SR4 + gr * 4 + i], cc = p.tab[TB_CC4 + t * 4 + i], sc = p.tab[TB_SC4 + t * 4 + i];
                const float a = x[i], bb = x[i + 4]; x[i] = a * cr - bb * sr; x[i + 4] = a * sr + bb * cr;
                const float c2 = x[8 + i], d2 = x[12 + i]; x[8 + i] = c2 * cc - d2 * sc; x[12 + i] = c2 * sc + d2 * cc;
            }
        }
        uint4 o0, o1;
        o0.x = pk_bf16(x[0], x[1]); o0.y = pk_bf16(x[2], x[3]); o0.z = pk_bf16(x[4], x[5]); o0.w = pk_bf16(x[6], x[7]);
        o1.x = pk_bf16(x[8], x[9]); o1.y = pk_bf16(x[10], x[11]); o1.z = pk_bf16(x[12], x[13]); o1.w = pk_bf16(x[14], x[15]);
        *(uint4*)(KR + (size_t)r * 16) = o0; *(uint4*)(KR + (size_t)r * 16 + 8) = o1;
    }
    __syncthreads();
}

DI void postproj1c_unit(const Params& p, int u, char* smem) {
    const bf16_t* MQraw = (const bf16_t*)p.x1;
    const bf16_t* MKVraw = MQraw + (size_t)NT * 384;
    const bf16_t* KR = (const bf16_t*)(p.x1 + (size_t)NT * CD_INP * 2) + (size_t)NT * 256 + (size_t)NT * 128;
    bf16_t* MQ = (bf16_t*)p.x2 + (size_t)NB * 8 * LT * 64 + (size_t)NB * 2 * LT * 64 + (size_t)NB * 2 * 64 * LT;
    bf16_t* MK = MQ + (size_t)NB * 8 * LT * 48;
    bf16_t* MVT = MK + (size_t)NB * 8 * LT * 48;
    bf16_t* tile = (bf16_t*)smem;
    unsigned* lmax = (unsigned*)(smem + 32768);
    const int t = tid();
    const int r0 = u * 64, b = r0 / LT, pos0 = r0 - b * LT;
    const bool lat = pos0 >= LC;
    const int gr = lat ? (pos0 - LC) >> 6 : 0;
    if (t < 16) lmax[t] = 0u;
    __syncthreads();
#pragma unroll 1
    for (int it = 0; it < 2; ++it) {
        const int item = t + NTHR * it, rr = item >> 3, hd = item & 7, r = r0 + rr;
        {
            const bf16_t* src = MQraw + (size_t)r * 384 + hd * 48;
            bf16_t* dst = MQ + ((size_t)(b * 8 + hd) * LT + pos0 + rr) * 48;
#pragma unroll
            for (int c8 = 0; c8 < 4; ++c8) *(uint4*)(dst + c8 * 8) = *(const uint4*)(src + c8 * 8);
            const uint4 w0 = *(const uint4*)(src + 32), w1 = *(const uint4*)(src + 40);
            float x[16] = {bflo(w0.x), bfhi(w0.x), bflo(w0.y), bfhi(w0.y), bflo(w0.z), bfhi(w0.z), bflo(w0.w), bfhi(w0.w),
                           bflo(w1.x), bfhi(w1.x), bflo(w1.y), bfhi(w1.y), bflo(w1.z), bfhi(w1.z), bflo(w1.w), bfhi(w1.w)};
            if (lat) {
#pragma unroll
                for (int i = 0; i < 4; ++i) {
                    const float cr = p.tab[TB_CR4 + gr * 4 + i], sr = p.tab[TB_SR4 + gr * 4 + i], cc = p.tab[TB_CC4 + rr * 4 + i], sc = p.tab[TB_SC4 + rr * 4 + i];
                    const float a = x[i], bb = x[i + 4]; x[i] = a * cr - bb * sr; x[i + 4] = a * sr + bb * cr;
                    const float c2 = x[8 + i], d2 = x[12 + i]; x[8 + i] = c2 * cc - d2 * sc; x[12 + i] = c2 * sc + d2 * cc;
                }
            }
            uint4 o0, o1;
            o0.x = pk_bf16(x[0], x[1]); o0.y = pk_bf16(x[2], x[3]); o0.z = pk_bf16(x[4], x[5]); o0.w = pk_bf16(x[6], x[7]);
            o1.x = pk_bf16(x[8], x[9]); o1.y = pk_bf16(x[10], x[11]); o1.z = pk_bf16(x[12], x[13]); o1.w = pk_bf16(x[14], x[15]);
            *(uint4*)(dst + 32) = o0; *(uint4*)(dst + 40) = o1;
        }
        {
            const bf16_t* src = MKVraw + (size_t)r * 768 + hd * 96;
            bf16_t* dst = MK + ((size_t)(b * 8 + hd) * LT + pos0 + rr) * 48;
            float s2 = 0.f;
#pragma unroll
            for (int c8 = 0; c8 < 6; ++c8) {
                const uint4 w = c8 < 4 ? *(const uint4*)(src + c8 * 8) : *(const uint4*)(KR + (size_t)r * 16 + (c8 - 4) * 8);
                *(uint4*)(dst + c8 * 8) = w;
                s2 += bflo(w.x) * bflo(w.x) + bfhi(w.x) * bfhi(w.x) + bflo(w.y) * bflo(w.y) + bfhi(w.y) * bfhi(w.y) + bflo(w.z) * bflo(w.z) + bfhi(w.z) * bfhi(w.z) + bflo(w.w) * bflo(w.w) + bfhi(w.w) * bfhi(w.w);
            }
            atomicMax(&lmax[hd], __float_as_uint(s2));
        }
    }
    __syncthreads();
    if (t < 8) atomicMax(&p.kmax[40 + b * 8 + t], lmax[t]);
    {
        const int rra = t >> 3, c8a = t & 7;
        const bf16_t* va_p = MKVraw + (size_t)(r0 + rra) * 768 + 32 + c8a * 8;
        const bf16_t* vb_p = va_p + (size_t)32 * 768;
        uint4 va = *(const uint4*)va_p, vb = *(const uint4*)vb_p;
        for (int hd = 0; hd < 8; ++hd) {
            __syncthreads();
            *(uint4*)(tile + rra * 72 + c8a * 8) = va;
            *(uint4*)(tile + (rra + 32) * 72 + c8a * 8) = vb;
            const int hn = hd < 7 ? hd + 1 : 7;
            va = *(const uint4*)(va_p + hn * 96); vb = *(const uint4*)(vb_p + hn * 96);
            __syncthreads();
            vt_write<64, 72>(tile, MVT + (size_t)(b * 8 + hd) * 64 * LT, pos0);
        }
    }
    __syncthreads();
}

template <int MODE>
DI void lru_unit(const Params& p, int u, char* smem) {
    const bf16_t* UG = (const bf16_t*)(p.x1 + (size_t)NT * 1536 * 2);
    bf16_t* CAT = (bf16_t*)p.x4;
    bf16_t* ys = (bf16_t*)smem;
    float* AB = (float*)(smem + 64 * 72 * 2);
    const int t = tid(), lane = t & 63, wave = t >> 6, l32 = lane & 31, h = lane >> 5;
    const int n = u & 7, ci = (u >> 3) % NCHUNK_T, b = (u >> 3) / NCHUNK_T;
    const int pos0 = ci * 64, r0 = b * LT + pos0;
    const int seq_lo = ci < 4 ? 0 : LC, seq_hi = ci < 4 ? LC : LT;
    {
        const int c = t & 63, tq = t >> 6, cg = n * 64 + c;
        const float w0 = p.in[11][cg], w1 = p.in[11][512 + cg], w2 = p.in[11][1024 + cg], w3 = p.in[11][1536 + cg], cb = p.in[12][cg];
        const int tp = pos0 + tq * 16;
        float uv[19];
#pragma unroll
        for (int i = 0; i < 19; ++i) { const int pos = tp - 2 + i; const int pc = pos < seq_lo ? seq_lo : (pos >= seq_hi ? seq_hi - 1 : pos);
            const float v = bf2f(UG[(size_t)(b * LT + pc) * 1024 + cg]); uv[i] = (pos >= seq_lo && pos < seq_hi) ? v : 0.f; }
#pragma unroll
        for (int tt = 0; tt < 16; ++tt) {
            const float y = cb + w0 * uv[tt] + w1 * uv[tt + 1] + w2 * uv[tt + 2] + w3 * uv[tt + 3];
            ys[(tq * 16 + tt) * 72 + c] = f2bf(y);
        }
    }
    __syncthreads();
    {
        const int d = wave >> 1, jh = wave & 1;
        f32x16 acc[2][2];
#pragma unroll
        for (int i = 0; i < 2; ++i)
#pragma unroll
            for (int j = 0; j < 2; ++j)
#pragma unroll
                for (int e = 0; e < 16; ++e) acc[i][j][e] = 0.f;
        const bf16_t* ap = ys + l32 * 72 + h * 8;
        const bf16_t* bp = p.lw + ((size_t)(((n * 2 + d) * 2 + jh) * 2) * 32 + l32) * 64 + h * 8;
#pragma unroll
        for (int ks = 0; ks < 4; ++ks) {
            const bf16x8 fa0 = *(const bf16x8*)(ap + ks * 16), fa1 = *(const bf16x8*)(ap + 32 * 72 + ks * 16);
            const bf16x8 fb0 = *(const bf16x8*)(bp + ks * 16), fb1 = *(const bf16x8*)(bp + 32 * 64 + ks * 16);
            acc[0][0] = MFMA32(fa0, fb0, acc[0][0]); acc[0][1] = MFMA32(fa0, fb1, acc[0][1]);
            acc[1][0] = MFMA32(fa1, fb0, acc[1][0]); acc[1][1] = MFMA32(fa1, fb1, acc[1][1]);
        }
        const int ch = jh * 32 + l32, cg = n * 64 + ch;
        const float ba = p.in[14][(d * 8 + n) * 64 + ch], bx = p.in[16][(d * 8 + n) * 64 + ch];
        const float lam = p.in[17][(d * 8 + n) * 64 + ch];
        const float sp = log1pf(expf(-lam));
        (void)cg;
#pragma unroll
        for (int mi = 0; mi < 2; ++mi)
#pragma unroll
            for (int i = 0; i < 16; ++i) {
                const int tm = mi * 32 + acc_row(i, h);
                AB[((d * 2 + 0) * 64 + tm) * 64 + ch] = acc[mi][0][i] + ba;
                AB[((d * 2 + 1) * 64 + tm) * 64 + ch] = acc[mi][1][i] + bx;
            }
#pragma unroll 2
        for (int e = 0; e < 32; ++e) {
            const int tm = (e >> 4) * 32 + acc_row(e & 15, h);
            float* pa = AB + ((d * 2 + 0) * 64 + tm) * 64 + ch;
            float* pb = AB + ((d * 2 + 1) * 64 + tm) * 64 + ch;
            const float r = sigm(*pa), ig = sigm(*pb);
            const float la = -8.f * r * sp;
            const float a = __builtin_amdgcn_exp2f(1.4426950408889634f * la);
            const float bb = __builtin_amdgcn_sqrtf(fmaxf(1.f - a * a, 0.f)) * ig * bf2f(ys[tm * 72 + ch]);
            *pa = a; *pb = bb;
        }
    }
    __syncthreads();
    if (t < 128) {
        const int d = t >> 6, c = t & 63, cg = n * 64 + c;
        const float* Aa = AB + (d * 2 + 0) * 4096 + c;
        float* Bb = AB + (d * 2 + 1) * 4096 + c;
        const size_t aidx = ((size_t)(b * NCHUNK_T + ci) * 2 + d) * 512 + cg;
        if (MODE == 1) {
            float hh = 0.f, P = 1.f;
#pragma unroll 4
            for (int s = 0; s < 64; ++s) { const int tt = d ? 63 - s : s; const float a = Aa[tt * 64]; hh = a * hh + Bb[tt * 64]; P *= a; }
            *(float2*)(p.agg + aidx * 2) = make_float2(P, hh);
        } else {
            float hh = p.carry[aidx];
#pragma unroll 4
            for (int s = 0; s < 64; ++s) { const int tt = d ? 63 - s : s; hh = Aa[tt * 64] * hh + Bb[tt * 64]; Bb[tt * 64] = hh; }
        }
    }
    __syncthreads();
    if (MODE == 3) {
        const int c = t & 63, tq = t >> 6, cg = n * 64 + c;
        float gv[16];
#pragma unroll
        for (int tt = 0; tt < 16; ++tt) gv[tt] = bf2f(UG[(size_t)(r0 + tq * 16 + tt) * 1024 + 512 + cg]);
#pragma unroll
        for (int tt = 0; tt < 16; ++tt) {
            const int tm = tq * 16 + tt;
            const float hs = AB[(1 * 64 + tm) * 64 + c] + AB[(3 * 64 + tm) * 64 + c];
            CAT[(size_t)(r0 + tm) * DM + 512 + cg] = f2bf(hs * gelu_tanh(gv[tt]));
        }
        __syncthreads();
    }
}
DI void lru_carry_unit(const Params& p, int v) {
    const int id = v * NTHR + tid();
    const int cg = id & 511, d = (id >> 9) & 1, b = id >> 10;
    float carry = 0.f;
    for (int s0 = 0; s0 < NCHUNK_T; s0 += 12) {
        float2 ag[12]; size_t ai[12];
#pragma unroll
        for (int j = 0; j < 12; ++j) {
            const int s = s0 + j;
            int ci;
            if (d == 0) ci = s; else ci = s < 4 ? 3 - s : NCHUNK_T - 1 - (s - 4);
            ai[j] = ((size_t)(b * NCHUNK_T + ci) * 2 + d) * 512 + cg;
            ag[j] = *(const float2*)(p.agg + ai[j] * 2);
        }
#pragma unroll
        for (int j = 0; j < 12; ++j) { p.carry[ai[j]] = carry; carry = ag[j].x * carry + ag[j].y; }
    }
}

DI float grp8_max(float v) { v = fmaxf(v, __shfl_xor(v, 1)); v = fmaxf(v, __shfl_xor(v, 2)); v = fmaxf(v, __shfl_xor(v, 4)); return v; }
constexpr int XP = 1032;
typedef float f32x4_t __attribute__((ext_vector_type(4)));
DI void norm2_router_unit(const Params& p, int layer, int r0, char* smem) {
    bf16_t* xh = (bf16_t*)smem;
    bf16_t* xl = xh + 16 * XP;
    float* lg = (float*)(xl + 16 * XP);
    float* ch = lg + 16 * 64;
    int* hist = (int*)(ch + 16 * 64);
    bf16_t* H2 = (bf16_t*)p.x4;
    const int t = tid(), lane = t & 63, wave = t >> 6;
    if (t < NSEGC) hist[t] = 0;
    for (int rr = 0; rr < 4; ++rr) {
        const int lr = wave * 4 + rr, r = r0 + lr;
        const float* src = res_row(p, r);
        const float* md = p.mod + (size_t)(layer * 5 + mod_row(r)) * 6144 + 3072;
        float4 v[4]; float ss = 0.f;
#pragma unroll
        for (int i = 0; i < 4; ++i) { v[i] = *(const float4*)(src + lane * 4 + 256 * i); ss += v[i].x * v[i].x + v[i].y * v[i].y + v[i].z * v[i].z + v[i].w * v[i].w; }
        ss = wave_sum(ss);
        const float rinv = rsqrtf(ss * (1.f / 1024.f) + EPSV);
#pragma unroll
        for (int i = 0; i < 4; ++i) {
            const int c = lane * 4 + 256 * i;
            const float4 sh = *(const float4*)(md + c), sc = *(const float4*)(md + 1024 + c);
            float4 o;
            o.x = v[i].x * rinv * (1.f + sc.x) + sh.x; o.y = v[i].y * rinv * (1.f + sc.y) + sh.y; o.z = v[i].z * rinv * (1.f + sc.z) + sh.z; o.w = v[i].w * rinv * (1.f + sc.w) + sh.w;
            uint2 ob; ob.x = pk_bf16(o.x, o.y); ob.y = pk_bf16(o.z, o.w);
            *(uint2*)(H2 + (size_t)r * DM + c) = ob;
            *(uint2*)(xh + lr * XP + c) = ob;
            uint2 ol; ol.x = pk_bf16(o.x - bflo(ob.x), o.y - bfhi(ob.x)); ol.y = pk_bf16(o.z - bflo(ob.y), o.w - bfhi(ob.y));
            *(uint2*)(xl + lr * XP + c) = ol;
        }
    }
    __syncthreads();
    {
        const int l15 = lane & 15, q = lane >> 4;
        const bf16_t* ah = xh + l15 * XP + q * 8;
        const bf16_t* al = xl + l15 * XP + q * 8;
        const bf16_t* bh = p.rwh + ((size_t)layer * 64 + wave * 16 + l15) * 1024 + q * 8;
        const bf16_t* bl = p.rwl + ((size_t)layer * 64 + wave * 16 + l15) * 1024 + q * 8;
        f32x4_t acc = {0.f, 0.f, 0.f, 0.f};
#pragma unroll 4
        for (int ks = 0; ks < 32; ++ks) {
            const bf16x8 fah = *(const bf16x8*)(ah + ks * 32), fal = *(const bf16x8*)(al + ks * 32);
            const bf16x8 fbh = *(const bf16x8*)(bh + ks * 32), fbl = *(const bf16x8*)(bl + ks * 32);
            acc = __builtin_amdgcn_mfma_f32_16x16x32_bf16(fah, fbh, acc, 0, 0, 0);
            acc = __builtin_amdgcn_mfma_f32_16x16x32_bf16(fah, fbl, acc, 0, 0, 0);
            acc = __builtin_amdgcn_mfma_f32_16x16x32_bf16(fal, fbh, acc, 0, 0, 0);
        }
        const int e = wave * 16 + l15;
        const float bias = p.in[27][layer * 64 + e];
#pragma unroll
        for (int j = 0; j < 4; ++j) { const float s = sigm(acc[j]); lg[(q * 4 + j) * 64 + e] = s; ch[(q * 4 + j) * 64 + e] = s + bias; }
    }
    __syncthreads();
    for (int rr = 0; rr < 4; ++rr) {
        const int lr = wave * 4 + rr, r = r0 + lr;
        const float c = ch[lr * 64 + lane], s = lg[lr * 64 + lane];
        const int g = lane >> 3;
        const float m1 = grp8_max(c);
        const unsigned long long bal = __ballot(c == m1);
        const int first = __ffs((unsigned)((bal >> (8 * g)) & 0xffull)) - 1;
        const float m2 = grp8_max(((lane & 7) == first) ? -3.0e38f : c);
        const float gsc = m1 + m2;
        int grank = 0;
#pragma unroll
        for (int gi = 0; gi < 8; ++gi) { const float o = __shfl(gsc, gi * 8); grank += (o > gsc || (o == gsc && gi < g)) ? 1 : 0; }
        const bool gsel = grank < 4;
        const float cand = gsel ? c : -3.0e38f;
        int erank = 0;
#pragma unroll 8
        for (int e2 = 0; e2 < 64; ++e2) { const float o = __shfl(cand, e2); erank += (o > cand || (o == cand && e2 < lane)) ? 1 : 0; }
        const bool sel = gsel && erank < 8;
        const float wsum = wave_sum(sel ? s : 0.f);
        if (sel) { p.tk_e[(size_t)r * 8 + erank] = lane; p.tk_w[(size_t)r * 8 + erank] = s * 2.5f / wsum; atomicAdd(&hist[lane], 1); }
        if (lane == 0) atomicAdd(&hist[64], 1);
    }
    __syncthreads();
    if (t < NSEGC && hist[t] > 0) atomicAdd(&p.cnt[(layer * 2 + 0) * NSEG + (r0 / p.chrows) * NSEGC + t], hist[t]);
    __syncthreads();
}
DI void phase_norm2_router(const Params& p, int layer, char* smem) {
    if (layer == 0) { for (int u = unit_first(); u < NT / 16; u += gridDim.x) norm2_router_unit(p, 0, u * 16, smem); }
    else { for (int u = unit_first(); u < NB * LX / 16; u += gridDim.x) norm2_router_unit(p, 1, (u / (LX / 16)) * LT + LC + (u % (LX / 16)) * 16, smem); }
}

DI void slots_unit(const Params& p, int layer, int r0, char* smem) {
    int* soff = (int*)smem;
    int* lcnt = soff + 272;
    int* lbase = lcnt + 80;
    const int t = tid();
    const int* cnt = p.cnt + (layer * 2 + 0) * NSEG;
    int* fill = p.cnt + (layer * 2 + 1) * NSEG;
    int* wsum = lbase + 80;
    {
        const int lane = t & 63, wave = t >> 6, sA = 2 * t, sB = 2 * t + 1;
        const int cA = sA < NSEG ? __hip_atomic_load(cnt + sA, __ATOMIC_RELAXED, __HIP_MEMORY_SCOPE_AGENT) : 0;
        const int cB = sB < NSEG ? __hip_atomic_load(cnt + sB, __ATOMIC_RELAXED, __HIP_MEMORY_SCOPE_AGENT) : 0;
        int ic = cA + cB;
#pragma unroll
        for (int o = 1; o < 64; o <<= 1) { const int vc = shfl_up_i(ic, o, lane); if (lane >= o) ic += vc; }
        if (lane == 63) wsum[wave] = ic;
        if (t < NSEGC) lcnt[t] = 0;
        __syncthreads();
        int oc = 0;
#pragma unroll
        for (int w = 0; w < 4; ++w) if (w < wave) oc += wsum[w];
        const int ex = oc + ic - cA - cB;
        if (sA <= NSEG) soff[sA] = ex;
        if (sB <= NSEG) soff[sB] = ex + cA;
    }
    __syncthreads();
    const int r = r0 + t, cbase = (r0 / p.chrows) * NSEGC;
    int e[9], loc[9]; float w[9];
#pragma unroll
    for (int k = 0; k < 8; ++k) { e[k] = p.tk_e[(size_t)r * 8 + k]; w[k] = p.tk_w[(size_t)r * 8 + k]; }
    e[8] = 64; w[8] = 1.f;
#pragma unroll
    for (int k = 0; k < 9; ++k) loc[k] = atomicAdd(&lcnt[e[k]], 1);
    __syncthreads();
    if (t < NSEGC) lbase[t] = lcnt[t] > 0 ? atomicAdd(&fill[cbase + t], lcnt[t]) : 0;
    __syncthreads();
#pragma unroll
    for (int k = 0; k < 9; ++k) {
        const int pos = soff[cbase + e[k]] + lbase[e[k]] + loc[k];
        p.ppos[(size_t)r * 16 + k] = pos; p.stok[pos] = r; p.sw[pos] = w[k];
    }
    __syncthreads();
}
DI void phase_slots(const Params& p, int layer, char* smem) {
    if (layer == 0) { for (int u = unit_first(); u < NT / 256; u += gridDim.x) slots_unit(p, 0, u * 256, smem); }
    else { for (int u = unit_first(); u < NB * LX / 256; u += gridDim.x) slots_unit(p, 1, (u / (LX / 256)) * LT + LC + (u % (LX / 256)) * 256, smem); }
}

constexpr int SEG_LDS_OFF = 68608;
DI void seg_tables(const Params& p, int layer, int s_lo, int s_hi, int* soff, int* toff) {
    const int* cnt = p.cnt + (layer * 2 + 0) * NSEG;
    int* wsum = toff + 272;
    const int t = tid(), lane = t & 63, wave = t >> 6;
    const int sA = 2 * t, sB = 2 * t + 1;
    const int cA = sA < NSEG ? __hip_atomic_load(cnt + sA, __ATOMIC_RELAXED, __HIP_MEMORY_SCOPE_AGENT) : 0;
    const int cB = sB < NSEG ? __hip_atomic_load(cnt + sB, __ATOMIC_RELAXED, __HIP_MEMORY_SCOPE_AGENT) : 0;
    const int tA = (sA >= s_lo && sA < s_hi) ? (cA + 127) >> 7 : 0, tB = (sB >= s_lo && sB < s_hi) ? (cB + 127) >> 7 : 0;
    int ic = cA + cB, it = tA + tB;
#pragma unroll
    for (int o = 1; o < 64; o <<= 1) { const int vc = shfl_up_i(ic, o, lane), vt = shfl_up_i(it, o, lane); if (lane >= o) { ic += vc; it += vt; } }
    if (lane == 63) { wsum[wave * 2] = ic; wsum[wave * 2 + 1] = it; }
    __syncthreads();
    int oc = 0, ot = 0;
#pragma unroll
    for (int w = 0; w < 4; ++w) if (w < wave) { oc += wsum[w * 2]; ot += wsum[w * 2 + 1]; }
    const int exA_c = oc + ic - cA - cB, exA_t = ot + it - tA - tB;
    if (sA >= s_lo && sA < s_hi) { soff[sA - s_lo] = exA_c; toff[sA - s_lo] = exA_t; }
    if (sB >= s_lo && sB < s_hi) { soff[sB - s_lo] = exA_c + cA; toff[sB - s_lo] = exA_t + tA; }
    if (sA + 1 == s_hi) { soff[s_hi - s_lo] = exA_c + cA; toff[s_hi - s_lo] = exA_t + tA; }
    if (sB + 1 == s_hi) { soff[s_hi - s_lo] = exA_c + cA + cB; toff[s_hi - s_lo] = exA_t + tA + tB; }
    __syncthreads();
}
DI int seg_find(const int* toff, int nseg, int tile) {
    int lo = 0, hi = nseg;
    while (hi - lo > 1) { const int mid = (lo + hi) >> 1; if (toff[mid] <= tile) lo = mid; else hi = mid; }
    return lo;
}
struct EpiGateUp {
    bf16_t* HID; const float* sw; int pos_end;
    DI void operator()(const float* ct, int row0, int col0) const {
#pragma unroll 2
        for (int it = 0; it < 4; ++it) {
            const int idx = tid() + NTHR * it, row = idx >> 3, wn = (idx >> 2) & 1, j0 = (idx & 3) * 8, pos = row0 + row;
            if (pos < pos_end) {
                const float* gp = ct + row * CT_LD + wn * 64 + j0;
                const float w = sw[pos];
                float o[8];
#pragma unroll
                for (int j = 0; j < 8; ++j) o[j] = silu_f(gp[j]) * gp[32 + j] * w;
                uint4 ov; ov.x = pk_bf16(o[0], o[1]); ov.y = pk_bf16(o[2], o[3]); ov.z = pk_bf16(o[4], o[5]); ov.w = pk_bf16(o[6], o[7]);
                *(uint4*)(HID + (size_t)pos * FF + ((col0 >> 6) + wn) * 32 + j0) = ov;
            }
        }
    }
};
struct EpiRowsBf16 {
    bf16_t* O; int ld; int rbase; int row_end;
    DI void operator()(const float* ct, int row0, int col0) const {
#pragma unroll 2
        for (int it = 0; it < 8; ++it) {
            const int idx = tid() + NTHR * it, row = idx >> 4, c8 = (idx & 15) * 8;
            if (row0 + row < row_end) *(uint4*)(O + (size_t)(row0 + row - rbase) * ld + col0 + c8) = pack8(ct + row * CT_LD + c8);
        }
    }
};
DI void phase_moe_gemm1(const Params& p, int layer, char* smem) {
    int* soff = (int*)(smem + SEG_LDS_OFF); int* toff = soff + 272;
    seg_tables(p, layer, 0, NSEG, soff, toff);
    const int ntiles = toff[NSEG];
    const bf16_t* H2 = (const bf16_t*)p.x4;
    bf16_t* HID = (bf16_t*)p.x1;
    auto unit_fn = [&](int u, int srow, int wave, int lane) {
        const int tile = u >> 1, nt = u & 1;
        const int s = seg_find(toff, NSEG, tile), e = s % NSEGC;
        const int pos0 = soff[s] + (tile - toff[s]) * 128, pos_end = soff[s + 1];
        int p0 = pos0 + srow, p1 = p0 + 32, p2 = p0 + 64, p3 = p0 + 96;
        if (p0 >= pos_end) p0 = pos_end - 1;
        if (p1 >= pos_end) p1 = pos_end - 1;
        if (p2 >= pos_end) p2 = pos_end - 1;
        if (p3 >= pos_end) p3 = pos_end - 1;
        const int t0 = p.stok[p0], t1 = p.stok[p1], t2 = p.stok[p2], t3 = p.stok[p3];
        const bf16_t* bw = p.ew1 + ((size_t)e * 512 + nt * 256 + wave * 64) * 1024 + lane * 8;
        return GUnit<WEpiGateUp>{H2 + (size_t)t0 * DM, H2 + (size_t)t1 * DM, H2 + (size_t)t2 * DM, H2 + (size_t)t3 * DM, bw, pos0, nt * 256, 1024, WEpiGateUp{HID, p.sw, pos_end}};
    };
    gemm_stream_w<WEpiGateUp>(ntiles * 2, unit_fn, smem, (const char*)p.bar);
}
DI void phase_moe_gemm2(const Params& p, int layer, int chunk, char* smem) {
    int* soff = (int*)(smem + SEG_LDS_OFF); int* toff = soff + 272;
    seg_tables(p, layer, chunk * NSEGC, (chunk + 1) * NSEGC, soff, toff);
    const int ntiles = toff[NSEGC];
    const bf16_t* HID = (const bf16_t*)p.x1;
    unsigned char* YP = (unsigned char*)p.x2;
    const int cbase = soff[0];
    auto unit_fn = [&](int u, int srow, int wave, int lane) {
        const int tile = u >> 2, nt = u & 3;
        const int e = seg_find(toff, NSEGC, tile);
        const int pos0 = soff[e] + (tile - toff[e]) * 128, pos_end = soff[e + 1];
        int p0 = pos0 + srow, p1 = p0 + 32, p2 = p0 + 64, p3 = p0 + 96;
        if (p0 >= pos_end) p0 = pos_end - 1;
        if (p1 >= pos_end) p1 = pos_end - 1;
        if (p2 >= pos_end) p2 = pos_end - 1;
        if (p3 >= pos_end) p3 = pos_end - 1;
        const bf16_t* bw = p.ew2 + ((size_t)e * 1024 + nt * 256 + wave * 64) * 256 + lane * 8;
        return GUnit<WEpiRows8>{HID + (size_t)p0 * FF, HID + (size_t)p1 * FF, HID + (size_t)p2 * FF, HID + (size_t)p3 * FF, bw, pos0, nt * 256, 256, WEpiRows8{YP, cbase, pos_end}};
    };
    gemm_stream_w<WEpiRows8>(ntiles * 4, unit_fn, smem, (const char*)p.bar);
}
DI void phase_moe_combine(const Params& p, int layer, int chunk, char* smem) {
    int* soff = (int*)(smem + SEG_LDS_OFF); int* toff = soff + 272;
    seg_tables(p, layer, chunk * NSEGC, (chunk + 1) * NSEGC, soff, toff);
    const int cbase = soff[0];
    const unsigned char* YP = (const unsigned char*)p.x2;
    const int lane = tid() & 63, wave = tid() >> 6;
    const int rbeg = chunk * p.chrows;
    for (int u = unit_first(); u < p.chrows / 4; u += gridDim.x) {
        const int r = rbeg + u * 4 + wave;
        if (layer == 1 && (r % LT) < LC) continue;
        float* rp = res_row(p, r);
        const float* g2 = p.mod + (size_t)(layer * 5 + mod_row(r)) * 6144 + 5120;
        const int4 pp0 = *(const int4*)(p.ppos + (size_t)r * 16), pp1 = *(const int4*)(p.ppos + (size_t)r * 16 + 4);
        const int pp8 = p.ppos[(size_t)r * 16 + 8];
        const int ppv[9] = {pp0.x, pp0.y, pp0.z, pp0.w, pp1.x, pp1.y, pp1.z, pp1.w, pp8};
        uint4 yw[9];
#pragma unroll
        for (int k = 0; k < 9; ++k) yw[k] = *(const uint4*)(YP + (size_t)(ppv[k] - cbase) * DM + lane * 16);
        const int c0 = lane * 16;
        float4 gv[4], xv[4];
#pragma unroll
        for (int i = 0; i < 4; ++i) { gv[i] = *(const float4*)(g2 + c0 + 4 * i); xv[i] = *(const float4*)(rp + c0 + 4 * i); }
        float a[16];
#pragma unroll
        for (int j = 0; j < 16; ++j) a[j] = 0.f;
#pragma unroll
        for (int k = 0; k < 9; ++k) {
            const int dw[4] = {(int)yw[k].x, (int)yw[k].y, (int)yw[k].z, (int)yw[k].w};
#pragma unroll
            for (int d = 0; d < 4; ++d) {
                const f32x2_t lo = __builtin_amdgcn_cvt_pk_f32_fp8(dw[d], false), hi = __builtin_amdgcn_cvt_pk_f32_fp8(dw[d], true);
                a[4 * d] += lo[0]; a[4 * d + 1] += lo[1]; a[4 * d + 2] += hi[0]; a[4 * d + 3] += hi[1];
            }
        }
        constexpr float UNS = 1.f / YP_SCALE;
        float ss = 0.f;
#pragma unroll
        for (int i = 0; i < 4; ++i) {
            a[4 * i] = xv[i].x + gv[i].x * UNS * a[4 * i]; a[4 * i + 1] = xv[i].y + gv[i].y * UNS * a[4 * i + 1];
            a[4 * i + 2] = xv[i].z + gv[i].z * UNS * a[4 * i + 2]; a[4 * i + 3] = xv[i].w + gv[i].w * UNS * a[4 * i + 3];
            ss += a[4 * i] * a[4 * i] + a[4 * i + 1] * a[4 * i + 1] + a[4 * i + 2] * a[4 * i + 2] + a[4 * i + 3] * a[4 * i + 3];
        }
        ss = wave_sum(ss);
        const float rinv = rsqrtf(ss * (1.f / 1024.f) + EPSV);
        if (layer == 0) {
            const float* md1 = p.mod + (size_t)(5 + mod_row(r)) * 6144;
            unsigned ob[8];
#pragma unroll
            for (int i = 0; i < 4; ++i) {
                *(float4*)(rp + c0 + 4 * i) = make_float4(a[4 * i], a[4 * i + 1], a[4 * i + 2], a[4 * i + 3]);
                const float4 sh = *(const float4*)(md1 + c0 + 4 * i), sc = *(const float4*)(md1 + 1024 + c0 + 4 * i);
                ob[2 * i] = pk_bf16(a[4 * i] * rinv * (1.f + sc.x) + sh.x, a[4 * i + 1] * rinv * (1.f + sc.y) + sh.y);
                ob[2 * i + 1] = pk_bf16(a[4 * i + 2] * rinv * (1.f + sc.z) + sh.z, a[4 * i + 3] * rinv * (1.f + sc.w) + sh.w);
            }
            *(uint4*)(p.h1 + (size_t)r * DM + c0) = make_uint4(ob[0], ob[1], ob[2], ob[3]);
            *(uint4*)(p.h1 + (size_t)r * DM + c0 + 8) = make_uint4(ob[4], ob[5], ob[6], ob[7]);
        } else {
#pragma unroll
            for (int i = 0; i < 4; ++i) {
                const float4 f = *(const float4*)(p.in[34] + c0 + 4 * i);
                *(float4*)(rp + c0 + 4 * i) = make_float4(a[4 * i] * rinv * f.x, a[4 * i + 1] * rinv * f.y, a[4 * i + 2] * rinv * f.z, a[4 * i + 3] * rinv * f.w);
            }
        }
    }
}

DI bool bg_first() { return (((blockIdx.x >> 3) + (blockIdx.x >> 8)) & 1u) == 0u; }
DI void bg_cvt_experts(const Params& p, int layer, char* smem) {
    for (int u = unit_first(); u < CVT_EXP_TILES; u += gridDim.x) cvt_expert(p, layer, u, smem);
    __syncthreads();
}
constexpr int N_PHASES = 22;
template <int PH, int NCHT>
DI void run_phase(const Params& p, char* smem, const XcdBarrier& bar) {
    if constexpr (PH == 0) phase_prologue(p, smem);
    else if constexpr (PH == 1) phase_norm1(p, 0);
    else if constexpr (PH == 2) {
        WEpiInProj0 epi{&p};
        gemm_phase_w((const char*)p.bar, (const bf16_t*)p.x4, DM, p.w_in0, 1024, NT / 128, AB_IN / 256, smem, epi, RowIdent{});
    } else if constexpr (PH == 3) {
        for (int u = unit_first(); u < NB * NCHUNK_T * 8; u += gridDim.x) lru_unit<1>(p, u, smem);
    } else if constexpr (PH == 4) {
        const bool bf = bg_first();
        if (bf) bg_cvt_experts(p, 0, smem);
        for (int u = unit_first(); u < 16 + NB * 4 * 64 + NB * 4 * 2; u += gridDim.x) { if (u < 16) lru_carry_unit(p, u); else attn0_unit(p, u - 16, smem); }
        if (!bf) { __syncthreads(); bg_cvt_experts(p, 0, smem); }
    } else if constexpr (PH == 5) {
        for (int u = unit_first(); u < NB * NCHUNK_T * 8; u += gridDim.x) lru_unit<3>(p, u, smem);
    } else if constexpr (PH == 6) {
        WEpiResidual epi{&p, 0};
        gemm_phase_w((const char*)p.bar, (const bf16_t*)p.x4, DM, p.w_out0, 1024, NT / 128, 4, smem, epi, RowIdent{});
    } else if constexpr (PH == 7) phase_norm2_router(p, 0, smem);
    else if constexpr (PH == 8) phase_slots(p, 0, smem);
    else if constexpr (PH == 9) phase_moe_gemm1(p, 0, smem);
    else if constexpr (PH == 10) {
        phase_moe_gemm2(p, 0, 0, smem); xcd_barrier(bar); phase_moe_combine(p, 0, 0, smem); xcd_barrier(bar);
        phase_moe_gemm2(p, 0, 1, smem); xcd_barrier(bar); phase_moe_combine(p, 0, 1, smem);
        if constexpr (NCHT >= 3) {
            xcd_barrier(bar);
            phase_moe_gemm2(p, 0, 2, smem); xcd_barrier(bar); phase_moe_combine(p, 0, 2, smem);
        }
        if constexpr (NCHT == 4) {
            xcd_barrier(bar);
            phase_moe_gemm2(p, 0, 3, smem); xcd_barrier(bar); phase_moe_combine(p, 0, 3, smem);
        }
    } else if constexpr (PH == 11) {   }
    else if constexpr (PH == 12) {
        WEpiSplit epi{(bf16_t*)p.x1, CD_INP, (bf16_t*)p.x1, CD_INP, 1 << 30, 1 << 30};
        gemm_phase_w((const char*)p.bar, p.h1, DM, p.w_in1, 1024, NT / 128, CD_INP / 256, smem, epi, RowIdent{});
    } else if constexpr (PH == 13) {
        for (int u = unit_first(); u < NT / 64; u += gridDim.x) postproj1a_unit(p, u, smem);
    } else if constexpr (PH == 14) {
        bf16_t* CQn = (bf16_t*)(p.x1 + (size_t)NT * CD_INP * 2);
        bf16_t* CKVn = CQn + (size_t)NT * 256;
        bf16_t* MQraw = (bf16_t*)p.x1;
        bf16_t* MKVraw = MQraw + (size_t)NT * 384;
        auto unit_fn = [&](int u, int srow, int wave, int lane) {
            if (u < (NT / 128) * 2) {
                const int mt = u >> 1, nt = u & 1, row0 = mt * 128;
                const bf16_t* ap = CQn + (size_t)(row0 + srow) * 256;
                const bf16_t* bw = p.w_uq + (size_t)(nt * 256 + wave * 64) * 256 + lane * 8;
                return GUnit<WEpiSplit>{ap, ap + (size_t)32 * 256, ap + (size_t)64 * 256, ap + (size_t)96 * 256, bw, row0, nt * 256, 256, WEpiSplit{MQraw, 384, MQraw, 384, 1 << 30, 384}};
            }
            const int v = u - (NT / 128) * 2, mt = v / 3, nt = v - mt * 3, row0 = mt * 128;
            const bf16_t* ap = CKVn + (size_t)(row0 + srow) * 128;
            const bf16_t* bw = p.w_ukv + (size_t)(nt * 256 + wave * 64) * 128 + lane * 8;
            return GUnit<WEpiSplit>{ap, ap + (size_t)32 * 128, ap + (size_t)64 * 128, ap + (size_t)96 * 128, bw, row0, nt * 256, 128, WEpiSplit{MKVraw, 768, MKVraw, 768, 1 << 30, 768}};
        };
        gemm_stream_w<WEpiSplit>((NT / 128) * 5, unit_fn, smem, (const char*)p.bar);
    } else if constexpr (PH == 15) {
        for (int u = unit_first(); u < NT / 64; u += gridDim.x) postproj1c_unit(p, u, smem);
    } else if constexpr (PH == 16) {
        const bool bf = bg_first();
        if (bf) bg_cvt_experts(p, 1, smem);
        for (int u = unit_first(); u < 4096; u += gridDim.x) attn1_unit(p, u, smem);
        if (!bf) { __syncthreads(); bg_cvt_experts(p, 1, smem); }
    } else if constexpr (PH == 17) {
        WEpiResidual epi{&p, 1};
        gemm_phase_w((const char*)p.bar, (const bf16_t*)p.x4, DM, p.w_out1, 1024, NB * 64, 4, smem, epi, RowLatent{});
    } else if constexpr (PH == 18) phase_norm2_router(p, 1, smem);
    else if constexpr (PH == 19) phase_slots(p, 1, smem);
    else if constexpr (PH == 20) phase_moe_gemm1(p, 1, smem);
    else if constexpr (PH == 21) {
        phase_moe_gemm2(p, 1, 0, smem); xcd_barrier(bar); phase_moe_combine(p, 1, 0, smem); xcd_barrier(bar);
        phase_moe_gemm2(p, 1, 1, smem); xcd_barrier(bar); phase_moe_combine(p, 1, 1, smem);
        if constexpr (NCHT >= 3) {
            xcd_barrier(bar);
            phase_moe_gemm2(p, 1, 2, smem); xcd_barrier(bar); phase_moe_combine(p, 1, 2, smem);
        }
        if constexpr (NCHT == 4) {
            xcd_barrier(bar);
            phase_moe_gemm2(p, 1, 3, smem); xcd_barrier(bar); phase_moe_combine(p, 1, 3, smem);
        }
    }
}

extern __shared__ __attribute__((aligned(16))) char dyn_smem[];

template <int PH, int HI, int NCHT>
DI void run_range(const Params& p, char* smem, const XcdBarrier& bar) {
    if constexpr (PH < HI) {
        run_phase<PH, NCHT>(p, smem, bar);
        if constexpr ((MK_REPEAT_MASK >> PH) & 1ull) { __syncthreads(); run_phase<PH, NCHT>(p, smem, bar); }
        if constexpr (PH + 1 < HI) { if constexpr (PH != 11) xcd_barrier(bar); run_range<PH + 1, HI, NCHT>(p, smem, bar); }
    }
}

template <int LO, int HI, int NCHT>
__global__ void __launch_bounds__(NTHR, 2) __attribute__((amdgpu_waves_per_eu(2, 2))) mk_kernel(Params p) {
    char* smem = dyn_smem + SM_OFF;
    if (threadIdx.x == 0) *(uint4*)dyn_smem = make_uint4(0u, 0u, 0u, 0u);
    __syncthreads();
    XcdBarrier bar = xcd_barrier_post(p.bar, (volatile LAS unsigned*)dyn_smem);
    run_range<LO, HI, NCHT>(p, smem, bar);
}

static size_t align_up(size_t x, size_t a) { return (x + a - 1) / a * a; }

extern "C" void kernel_launch(void* const* d_in, const int* in_sizes, int n_in, void* d_out, int out_size, void* d_ws, size_t ws_size, hipStream_t stream) {
    (void)in_sizes; (void)n_in; (void)out_size; (void)ws_size;
    Params p;
    memset(&p, 0, sizeof(p));
    for (int i = 0; i < 35; ++i) p.in[i] = (const float*)d_in[i];
    p.out = (float*)d_out;
    char* ws = (char*)d_ws;
    size_t off = 0;
    auto take = [&](size_t bytes) { char* r = ws + off; off = align_up(off + bytes, 256); return r; };
    const size_t zero_bytes = 16384 + 8192;
    p.bar = (unsigned*)take(16384);
    p.cnt = (int*)take(8192);
    p.kmax = (unsigned*)(p.cnt + 1536);
    p.mod = (float*)take((size_t)2 * 5 * 6144 * 4);
    p.tab = (float*)take((size_t)TB_TOTAL * 4);
    p.lamv = (float*)take(256);
    p.w_in0 = (bf16_t*)take((size_t)2560 * 1024 * 2);
    p.w_out0 = (bf16_t*)take((size_t)1024 * 1024 * 2);
    p.w_in1 = (bf16_t*)take((size_t)1280 * 1024 * 2);
    p.w_out1 = (bf16_t*)take((size_t)1024 * 1024 * 2);
    p.w_uq = (bf16_t*)take((size_t)512 * 256 * 2);
    p.w_ukv = (bf16_t*)take((size_t)768 * 128 * 2);
    p.lw = (bf16_t*)take((size_t)64 * 32 * 64 * 2);
    p.rwh = (bf16_t*)take((size_t)2 * 64 * 1024 * 2);
    p.rwl = (bf16_t*)take((size_t)2 * 64 * 1024 * 2);
    p.ew1 = (bf16_t*)take((size_t)65 * 512 * 1024 * 2);
    p.ew2 = (bf16_t*)take((size_t)65 * 1024 * 256 * 2);
    p.rc = (float*)take((size_t)NB * LC * DM * 4);
    p.tk_e = (int*)take((size_t)NT * 8 * 4);
    p.tk_w = (float*)take((size_t)NT * 8 * 4);
    p.ppos = (int*)take((size_t)NT * 16 * 4);
    p.stok = (int*)take((size_t)NPAIR * 4);
    p.sw = (float*)take((size_t)NPAIR * 4);
    p.agg = (float*)take((size_t)NB * NCHUNK_T * 2 * 512 * 2 * 4);
    p.carry = (float*)take((size_t)NB * NCHUNK_T * 2 * 512 * 4);
    p.x1 = take((size_t)NT * 2560 * 2);
    p.x2 = take((size_t)NB * LT * 2048 * 2);
    p.x4 = take((size_t)NT * DM * 2);
    p.h1 = (bf16_t*)take((size_t)NT * DM * 2);
    p.nch = 2;
    p.chrows = NT / p.nch;
    static bool warned = false;
    if (off > ws_size && !warned) { fprintf(stderr, "workspace too small: need %zu have %zu\n", off, ws_size); warned = true; }

    (void)hipMemsetAsync(d_ws, 0, zero_bytes, stream);
    static int grid = 0;
    if (!grid) {
        int dev = 0, cus = 0, per_cu = 2;
        (void)hipGetDevice(&dev);
        (void)hipDeviceGetAttribute(&cus, hipDeviceAttributeMultiprocessorCount, dev);
        (void)hipFuncSetAttribute((const void*)mk_kernel<0, N_PHASES, 2>, hipFuncAttributeMaxDynamicSharedMemorySize, SMEM_BYTES);
        int q2 = 0, q4 = 0;
        q2 = 2;
        (void)hipOccupancyMaxActiveBlocksPerMultiprocessor(&q4, (const void*)mk_kernel<0, N_PHASES, 2>, NTHR, SMEM_BYTES);
        per_cu = q2 < q4 ? q2 : q4;
        if (per_cu > 2) per_cu = 2;
        if (per_cu < 1) per_cu = 1;
        grid = cus * per_cu;
    }
    hipLaunchKernelGGL((mk_kernel<0, N_PHASES, 2>), dim3(grid), dim3(NTHR), SMEM_BYTES, stream, p);
}
```

```cpp
#include <hip/hip_runtime.h>
#include <stdint.h>
#include <stdio.h>
#include <string.h>
#include <type_traits>

#ifndef MK_REPEAT_MASK
#define MK_REPEAT_MASK 0ull
#endif
#ifndef MK_FUSED
#define MK_FUSED 1
#endif

#define DI __device__ __forceinline__
typedef unsigned short bf16_t;
typedef short bf16x8 __attribute__((ext_vector_type(8)));
typedef float f32x16 __attribute__((ext_vector_type(16)));
typedef float f32x2_t __attribute__((ext_vector_type(2)));
typedef __bf16 bf16x2_t __attribute__((ext_vector_type(2)));

constexpr int NB = 4, LX = 8192, LC = 256, LT = LX + LC, NT = NB * LT, DM = 1024;
constexpr int AB_IN = 2560, CD_IN = 1168, CD_INP = 1280;
constexpr int NE = 64, FF = 256, NSEGC = 65, NCH = 4, NSEG = NSEGC * NCH;
constexpr int NPAIR = NT * 9;
constexpr int NCHUNK_T = LT / 64;
constexpr int NTHR = 256;
constexpr int SMEM_BYTES = 76800;
constexpr int SM_OFF = 64;
constexpr float EPSV = 1e-6f;
constexpr float LOG2E = 1.4426950408889634f;

#define XB_TMO      128
#define XB_XCNT(j)  (256  + 64 * (j))
#define XB_XSUB(j)  (1280 + 64 * (j))
#define XB_XGEN(j)  (2304 + 64 * (j))
#define XB_TOP      3328
#define XB_TOPGEN   3392
#define XCD_BAR_WORDS 3456
#define XB_SPIN_CAP (1u << 18)
#define LAS __attribute__((address_space(3)))

__device__ __forceinline__ unsigned xb_ld(unsigned* p)              { return __hip_atomic_load(p, __ATOMIC_RELAXED, __HIP_MEMORY_SCOPE_AGENT); }
__device__ __forceinline__ unsigned xb_add(unsigned* p, unsigned v) { return __hip_atomic_fetch_add(p, v, __ATOMIC_RELAXED, __HIP_MEMORY_SCOPE_AGENT); }
__device__ __forceinline__ unsigned xb_xcc_id() { return (unsigned)__builtin_amdgcn_s_getreg((3 << 11) | 20) & 0xFu; }
#define XB_SPIN(cond, bar) do { unsigned _sp = 0; while (cond) { __builtin_amdgcn_s_sleep(1); \
    if ((++_sp & 255u) == 0u) { if (xb_ld(&(bar)[XB_TMO])) break; if (_sp > XB_SPIN_CAP) { atomicAdd(&(bar)[XB_TMO], 1u); break; } } } } while (0)

struct XcdBarrier { unsigned* bar; unsigned x; volatile LAS unsigned* st; };

__device__ __forceinline__ XcdBarrier xcd_barrier_post(unsigned* bar, volatile LAS unsigned* st) {
    XcdBarrier b; b.bar = bar; b.x = xb_xcc_id(); b.st = st;
    if (threadIdx.x == 0) (void)xb_add(&bar[XB_XCNT(b.x)], 1u);
    return b;
}
__device__ __forceinline__ void xcd_barrier_complete(unsigned* bar, unsigned x, unsigned& nloc, unsigned& nx) {
    const unsigned G = gridDim.x * gridDim.y * gridDim.z;
    unsigned sum, cnt, mine, sp = 0u;
    for (;;) {
        sum = 0u; cnt = 0u; mine = 0u;
#pragma unroll
        for (unsigned j = 0; j < 16; ++j) { const unsigned c = xb_ld(&bar[XB_XCNT(j)]); sum += c; cnt += (c > 0u) ? 1u : 0u; mine = (j == x) ? c : mine; }
        if (sum == G) break;
        __builtin_amdgcn_s_sleep(1);
        if ((++sp & 255u) == 0u) { if (xb_ld(&bar[XB_TMO])) break; if (sp > XB_SPIN_CAP) { atomicAdd(&bar[XB_TMO], 1u); break; } }
    }
    nloc = mine > 0u ? mine : 1u; nx = cnt > 0u ? cnt : 1u;
}
__device__ __forceinline__ void xcd_barrier(const XcdBarrier& b) {
    asm volatile("s_waitcnt vmcnt(0)" ::: "memory");
    __syncthreads();
    if (threadIdx.x == 0) {
        unsigned* bar = b.bar;
        __builtin_amdgcn_s_waitcnt(0);
        unsigned nloc = b.st[0], nx = b.st[1];
        if (nloc == 0u) { xcd_barrier_complete(bar, b.x, nloc, nx); b.st[0] = nloc; b.st[1] = nx; }
        const unsigned old = xb_add(&bar[XB_XSUB(b.x)], 1u);
        const unsigned gen = old / nloc;
        if (old + 1u == (gen + 1u) * nloc) {
            __builtin_amdgcn_fence(__ATOMIC_RELEASE, "agent");
            asm volatile("s_waitcnt vmcnt(0)" ::: "memory");
            const unsigned og = xb_add(&bar[XB_TOP], 1u);
            const unsigned tg = og / nx;
            if (og + 1u == (tg + 1u) * nx) xb_add(&bar[XB_TOPGEN], 1u);
            else XB_SPIN(xb_ld(&bar[XB_TOPGEN]) == tg, bar);
            __builtin_amdgcn_fence(__ATOMIC_ACQUIRE, "agent");
            xb_add(&bar[XB_XGEN(b.x)], 1u);
            asm volatile("s_waitcnt vmcnt(0)" ::: "memory");
        } else {
            XB_SPIN(xb_ld(&bar[XB_XGEN(b.x)]) == gen, bar);
            __builtin_amdgcn_fence(__ATOMIC_ACQUIRE, "agent");
            asm volatile("s_waitcnt vmcnt(0)" ::: "memory");
        }
    }
    __syncthreads();
}

struct Params {
    const float* in[35];
    float* out;
    unsigned* bar;
    int* cnt;
    unsigned* kmax;
    float* mod;
    float* tab;
    float* lamv;
    bf16_t* w_in0;
    bf16_t* w_out0;
    bf16_t* w_in1;
    bf16_t* w_out1;
    bf16_t* w_uq;
    bf16_t* w_ukv;
    bf16_t* lw;
    bf16_t* rwh;
    bf16_t* rwl;
    bf16_t* ew1;
    bf16_t* ew2;
    float* rc;
    int* tk_e;
    float* tk_w;
    int* ppos;
    int* stok;
    float* sw;
    float* agg;
    float* carry;
    char* x1;
    char* x2;
    char* x4;
    bf16_t* h1;
    int nch;
    int chrows;
};

constexpr int TB_CR = 0, TB_SR = 2048, TB_CC = 4096, TB_SC = 5120, TB_CR4 = 6144, TB_SR4 = 6656, TB_CC4 = 7168, TB_SC4 = 7424, TB_TOTAL = 7680;

DI int unit_first() { return (int)((blockIdx.x & 7u) * (gridDim.x >> 3) + (blockIdx.x >> 3)); }
DI int tid() { int t = threadIdx.x; asm volatile("" : "+v"(t)); return t; }
DI unsigned pk_bf16(float a, float b) { f32x2_t v = {a, b}; bf16x2_t r = __builtin_convertvector(v, bf16x2_t); return __builtin_bit_cast(unsigned, r); }
DI bf16_t f2bf(float a) { return (bf16_t)(pk_bf16(a, 0.f) & 0xffffu); }
DI float bf2f(bf16_t v) { return __uint_as_float(((unsigned)v) << 16); }
DI float bflo(unsigned u) { return __uint_as_float(u << 16); }
DI float bfhi(unsigned u) { return __uint_as_float(u & 0xffff0000u); }
DI float sigm(float x) { return __builtin_amdgcn_rcpf(1.f + __builtin_amdgcn_exp2f(-1.4426950408889634f * x)); }
DI float silu_f(float x) { return x * sigm(x); }
DI float gelu_tanh(float x) { const float u = 0.7978845608028654f * (x + 0.044715f * x * x * x); return x * sigm(2.f * u); }
DI float wave_sum(float v) {
    const int l = tid() & 63;
#pragma unroll
    for (int o = 32; o > 0; o >>= 1) v += __int_as_float(__builtin_amdgcn_ds_bpermute((l ^ o) << 2, __float_as_int(v)));
    return v;
}
DI int shfl_up_i(int v, int o, int l) { return __builtin_amdgcn_ds_bpermute((l >= o ? l - o : l) << 2, v); }
DI float half_max(float x) { auto r = __builtin_amdgcn_permlane32_swap(__float_as_uint(x), __float_as_uint(x), false, false); return fmaxf(__uint_as_float(r[0]), __uint_as_float(r[1])); }
DI float half_sum(float x) { auto r = __builtin_amdgcn_permlane32_swap(__float_as_uint(x), __float_as_uint(x), false, false); return __uint_as_float(r[0]) + __uint_as_float(r[1]); }
#define MFMA32(a, b, c) __builtin_amdgcn_mfma_f32_32x32x16_bf16((a), (b), (c), 0, 0, 0)
DI int acc_row(int i, int h) { return (i & 3) + 8 * (i >> 2) + 4 * h; }

DI float* res_row(const Params& p, int r) {
    const int b = r / LT, pos = r - b * LT;
    return pos < LC ? p.rc + (size_t)(b * LC + pos) * DM : p.out + (size_t)(b * LX + pos - LC) * DM;
}
DI const float* in_row(const Params& p, int r) {
    const int b = r / LT, pos = r - b * LT;
    return pos < LC ? p.in[2] + (size_t)(b * LC + pos) * DM : p.in[0] + (size_t)(b * LX + pos - LC) * DM;
}
DI int mod_row(int r) { const int b = r / LT, pos = r - b * LT; return pos < LC ? 4 : b; }

DI void mod_gemv_unit(const Params& p, int u, char* smem) {
    float* s = (float*)smem;
    float* red = s + 5 * 1024;
    const int t = tid();
    for (int i = t; i < 5 * 1024; i += NTHR) { const int m = i >> 10, k = i & 1023; const float v = (m < 4) ? p.in[1][m * 1024 + k] : p.in[3][k]; s[i] = silu_f(v); }
    __syncthreads();
    const int layer = u / 96, n0 = (u % 96) * 64, col = t & 63, kg = t >> 6;
    const float* w = p.in[4] + (size_t)layer * 1024 * 6144 + n0 + col;
    float a0 = 0.f, a1 = 0.f, a2 = 0.f, a3 = 0.f, a4 = 0.f;
    for (int k0 = kg * 256; k0 < kg * 256 + 256; k0 += 16) {
        float wv[16];
#pragma unroll
        for (int j = 0; j < 16; ++j) wv[j] = w[(size_t)(k0 + j) * 6144];
#pragma unroll
        for (int j = 0; j < 16; ++j) { const int k = k0 + j;
            a0 += s[k] * wv[j]; a1 += s[1024 + k] * wv[j]; a2 += s[2048 + k] * wv[j]; a3 += s[3072 + k] * wv[j]; a4 += s[4096 + k] * wv[j]; }
    }
    red[(kg * 5 + 0) * 64 + col] = a0; red[(kg * 5 + 1) * 64 + col] = a1; red[(kg * 5 + 2) * 64 + col] = a2; red[(kg * 5 + 3) * 64 + col] = a3; red[(kg * 5 + 4) * 64 + col] = a4;
    __syncthreads();
    if (t < 64) {
        const float bias = p.in[5][layer * 6144 + n0 + t];
#pragma unroll
        for (int m = 0; m < 5; ++m) {
            const float v = red[(0 * 5 + m) * 64 + t] + red[(1 * 5 + m) * 64 + t] + red[(2 * 5 + m) * 64 + t] + red[(3 * 5 + m) * 64 + t] + bias;
            p.mod[(size_t)(layer * 5 + m) * 6144 + n0 + t] = v;
        }
    }
    __syncthreads();
}

DI void cvt_tile(const float* src, int ld_src, int k0, int n0, int nvalid, bf16_t* dst, int ld_dst, char* smem, bf16_t* dst_lo = nullptr, bool tiled = false) {
    float* s = (float*)smem;
    const int t = tid();
#pragma unroll
    for (int it = 0; it < 2; ++it) {
        const int idx = t + NTHR * it, k = idx >> 3, n4 = (idx & 7) * 4;
        const float* sp = src + (size_t)(k0 + k) * ld_src + n0 + n4;
        float v0 = 0.f, v1 = 0.f, v2 = 0.f, v3 = 0.f;
        if (n0 + n4 + 3 < nvalid) { const float4 v = *(const float4*)sp; v0 = v.x; v1 = v.y; v2 = v.z; v3 = v.w; }
        else { if (n0 + n4 + 0 < nvalid) v0 = sp[0]; if (n0 + n4 + 1 < nvalid) v1 = sp[1]; if (n0 + n4 + 2 < nvalid) v2 = sp[2]; if (n0 + n4 + 3 < nvalid) v3 = sp[3]; }
        s[k * 33 + n4 + 0] = v0; s[k * 33 + n4 + 1] = v1; s[k * 33 + n4 + 2] = v2; s[k * 33 + n4 + 3] = v3;
    }
    __syncthreads();
    {
        const int n = t >> 3, c = t & 7;
        uint4 o;
        o.x = pk_bf16(s[(c * 8 + 0) * 33 + n], s[(c * 8 + 1) * 33 + n]);
        o.y = pk_bf16(s[(c * 8 + 2) * 33 + n], s[(c * 8 + 3) * 33 + n]);
        o.z = pk_bf16(s[(c * 8 + 4) * 33 + n], s[(c * 8 + 5) * 33 + n]);
        o.w = pk_bf16(s[(c * 8 + 6) * 33 + n], s[(c * 8 + 7) * 33 + n]);
        if (tiled) *(uint4*)(dst + (size_t)((((k0 >> 4) + (c >> 1)) * 64 + (c & 1) * 32 + n) * 8)) = o;
        else *(uint4*)(dst + (size_t)n * ld_dst + k0 + c * 8) = o;
        if (dst_lo) {
            float r[8];
#pragma unroll
            for (int j = 0; j < 8; ++j) { const float w = s[(c * 8 + j) * 33 + n]; r[j] = w - bf2f(f2bf(w)); }
            uint4 o2; o2.x = pk_bf16(r[0], r[1]); o2.y = pk_bf16(r[2], r[3]); o2.z = pk_bf16(r[4], r[5]); o2.w = pk_bf16(r[6], r[7]);
            *(uint4*)(dst_lo + (size_t)n * ld_dst + k0 + c * 8) = o2;
        }
    }
    __syncthreads();
}

constexpr int CS0 = 1280, CS1 = CS0 + 512, CS2 = CS1 + 640, CS3 = CS2 + 512, CS4 = CS3 + 64, CS5 = CS4 + 48, CS6 = CS5 + 64, CS7 = CS6 + 64;
constexpr int CVT_SMALL_TILES = CS7;
DI void cvt_small(const Params& p, int u, char* smem) {
    if (u < CS0) { const int kt = u / 80, nt = u % 80; cvt_tile(p.in[6], AB_IN, kt * 64, nt * 32, AB_IN, p.w_in0 + (size_t)nt * 32 * 1024, 1024, smem, nullptr, true); }
    else if (u < CS1) { const int v = u - CS0, kt = v / 32, nt = v % 32; cvt_tile(p.in[7], 1024, kt * 64, nt * 32, 1024, p.w_out0 + (size_t)nt * 32 * 1024, 1024, smem, nullptr, true); }
    else if (u < CS2) { const int v = u - CS1, kt = v / 40, nt = v % 40; cvt_tile(p.in[18], CD_IN, kt * 64, nt * 32, CD_IN, p.w_in1 + (size_t)nt * 32 * 1024, 1024, smem, nullptr, true); }
    else if (u < CS3) { const int v = u - CS2, kt = v / 32, nt = v % 32; cvt_tile(p.in[19], 1024, kt * 64, nt * 32, 1024, p.w_out1 + (size_t)nt * 32 * 1024, 1024, smem, nullptr, true); }
    else if (u < CS4) { const int v = u - CS3, kt = v / 16, nt = v % 16; cvt_tile(p.in[24], 384, kt * 64, nt * 32, 384, p.w_uq + (size_t)nt * 32 * 256, 256, smem, nullptr, true); }
    else if (u < CS5) { const int v = u - CS4, kt = v / 24, nt = v % 24; cvt_tile(p.in[25], 768, kt * 64, nt * 32, 768, p.w_ukv + (size_t)nt * 32 * 128, 128, smem, nullptr, true); }
    else if (u < CS6) {
        const int v = u - CS5, gate = v & 1, jh = (v >> 1) & 1, d = (v >> 2) & 1, n = v >> 3;
        const float* src = (gate ? p.in[15] : p.in[13]) + (size_t)(d * 8 + n) * 64 * 64;
        cvt_tile(src, 64, 0, jh * 32, 64, p.lw + (size_t)v * 32 * 64, 64, smem);
    } else {
        const int v = u - CS6, layer = v >> 5, kt = (v >> 1) & 15, nt = v & 1;
        cvt_tile(p.in[26] + (size_t)layer * 1024 * 64, 64, kt * 64, nt * 32, 64, p.rwh + ((size_t)layer * 64 + nt * 32) * 1024, 1024, smem, p.rwl + ((size_t)layer * 64 + nt * 32) * 1024);
    }
}
constexpr int CVT_EXP_TILES = 3 * 8192 + 3 * 128;
DI void cvt_expert(const Params& p, int layer, int u, char* smem) {
    if (u < 16384) {
        const int up = u >= 8192, v = u & 8191, e = v >> 7, kt = (v >> 3) & 15, nt = v & 7;
        const float* src = (up ? p.in[29] : p.in[28]) + (size_t)(layer * NE + e) * 1024 * 256;
        cvt_tile(src, 256, kt * 64, nt * 32, 256, p.ew1 + ((size_t)e * 512 + nt * 64 + up * 32) * 1024, 1024, smem, nullptr, true);
    } else if (u < 24576) {
        const int v = u - 16384, e = v >> 7, kt = (v >> 5) & 3, nt = v & 31;
        const float* src = p.in[30] + (size_t)(layer * NE + e) * 256 * 1024;
        cvt_tile(src, 1024, kt * 64, nt * 32, 1024, p.ew2 + ((size_t)e * 1024 + nt * 32) * 256, 256, smem, nullptr, true);
    } else {
        const int v = u - 24576;
        if (v < 256) { const int up = v >= 128, w = v & 127, kt = w >> 3, nt = w & 7;
            const float* src = (up ? p.in[32] : p.in[31]) + (size_t)layer * 1024 * 256;
            cvt_tile(src, 256, kt * 64, nt * 32, 256, p.ew1 + ((size_t)NE * 512 + nt * 64 + up * 32) * 1024, 1024, smem, nullptr, true);
        } else { const int w = v - 256, kt = w >> 5, nt = w & 31;
            const float* src = p.in[33] + (size_t)layer * 256 * 1024;
            cvt_tile(src, 1024, kt * 64, nt * 32, 1024, p.ew2 + ((size_t)NE * 1024 + nt * 32) * 256, 256, smem, nullptr, true);
        }
    }
}
DI void tables_unit(const Params& p) {
    const int t = tid();
    for (int i = t; i < 128 * 16; i += NTHR) { const int pos = i >> 4, f = i & 15; const float ang = (float)pos * powf(10000.f, -(float)f / 16.f); float s, c; sincosf(ang, &s, &c); p.tab[TB_CR + i] = c; p.tab[TB_SR + i] = s; }
    for (int i = t; i < 64 * 16; i += NTHR) { const int pos = i >> 4, f = i & 15; const float ang = (float)pos * powf(10000.f, -(float)f / 16.f); float s, c; sincosf(ang, &s, &c); p.tab[TB_CC + i] = c; p.tab[TB_SC + i] = s; }
    for (int i = t; i < 128 * 4; i += NTHR) { const int pos = i >> 2, f = i & 3; const float ang = (float)pos * powf(10000.f, -(float)f / 4.f); float s, c; sincosf(ang, &s, &c); p.tab[TB_CR4 + i] = c; p.tab[TB_SR4 + i] = s; }
    for (int i = t; i < 64 * 4; i += NTHR) { const int pos = i >> 2, f = i & 3; const float ang = (float)pos * powf(10000.f, -(float)f / 4.f); float s, c; sincosf(ang, &s, &c); p.tab[TB_CC4 + i] = c; p.tab[TB_SC4 + i] = s; }
    if (t < 64) {
        const float s0 = wave_sum(p.in[8][t] * p.in[9][t]), s1 = wave_sum(p.in[8][64 + t] * p.in[9][64 + t]);
        if (t == 0) p.lamv[0] = expf(s0) - expf(s1) + 0.2f;
    }
}
DI void phase_prologue(const Params& p, char* smem) {
    const int n_units = 192 + 1 + CVT_SMALL_TILES;
    for (int u = unit_first(); u < n_units; u += gridDim.x) {
        if (u < 192) mod_gemv_unit(p, u, smem);
        else if (u == 192) tables_unit(p);
        else cvt_small(p, u - 193, smem);
    }
}

DI void phase_norm1(const Params& p, int layer) {
    const int lane = tid() & 63, wave = tid() >> 6;
    bf16_t* H = (bf16_t*)p.x4;
    for (int u = unit_first(); u < NT / 64; u += gridDim.x) {
        for (int rr = 0; rr < 16; rr += 4) {
            float4 v[4][4]; float ss[4];
#pragma unroll
            for (int q = 0; q < 4; ++q) {
                const int r = u * 64 + wave * 16 + rr + q;
                const float* src = layer == 0 ? in_row(p, r) : res_row(p, r);
#pragma unroll
                for (int i = 0; i < 4; ++i) v[q][i] = *(const float4*)(src + lane * 4 + 256 * i);
            }
#pragma unroll
            for (int q = 0; q < 4; ++q) {
                float s = 0.f;
#pragma unroll
                for (int i = 0; i < 4; ++i) s += v[q][i].x * v[q][i].x + v[q][i].y * v[q][i].y + v[q][i].z * v[q][i].z + v[q][i].w * v[q][i].w;
                ss[q] = wave_sum(s);
            }
#pragma unroll
            for (int q = 0; q < 4; ++q) {
                const int r = u * 64 + wave * 16 + rr + q;
                const float* md = p.mod + (size_t)(layer * 5 + mod_row(r)) * 6144;
                const float rinv = rsqrtf(ss[q] * (1.f / 1024.f) + EPSV);
#pragma unroll
                for (int i = 0; i < 4; ++i) {
                    const int c = lane * 4 + 256 * i;
                    const float4 sh = *(const float4*)(md + c), sc = *(const float4*)(md + 1024 + c);
                    uint2 o;
                    o.x = pk_bf16(v[q][i].x * rinv * (1.f + sc.x) + sh.x, v[q][i].y * rinv * (1.f + sc.y) + sh.y);
                    o.y = pk_bf16(v[q][i].z * rinv * (1.f + sc.z) + sh.z, v[q][i].w * rinv * (1.f + sc.w) + sh.w);
                    *(uint2*)(H + (size_t)r * DM + c) = o;
                }
            }
        }
    }
}

constexpr int LDT = 72;
constexpr int CT_LD = 132;
template <class Epi>
DI void gemm_tile(const bf16_t* a0, const bf16_t* a1, const bf16_t* a2, const bf16_t* a3,
                  const bf16_t* b0, const bf16_t* b1, const bf16_t* b2, const bf16_t* b3,
                  int K, char* smem, const Epi& epi, int row0, int col0) {
    bf16_t* As = (bf16_t*)smem;
    bf16_t* Bs = As + 2 * 128 * LDT;
    const int t = tid(), lane = t & 63, wave = t >> 6, wm = wave >> 1, wn = wave & 1, l32 = lane & 31, h = lane >> 5;
    const int srow = t >> 3, scol = (t & 7) * 8;
    uint4 ra0, ra1, ra2, ra3, rb0, rb1, rb2, rb3;
    ra0 = *(const uint4*)(a0 + scol); ra1 = *(const uint4*)(a1 + scol); ra2 = *(const uint4*)(a2 + scol); ra3 = *(const uint4*)(a3 + scol);
    rb0 = *(const uint4*)(b0 + scol); rb1 = *(const uint4*)(b1 + scol); rb2 = *(const uint4*)(b2 + scol); rb3 = *(const uint4*)(b3 + scol);
    {
        bf16_t* ad = As + srow * LDT + scol; bf16_t* bd = Bs + srow * LDT + scol;
        *(uint4*)(ad) = ra0; *(uint4*)(ad + 32 * LDT) = ra1; *(uint4*)(ad + 64 * LDT) = ra2; *(uint4*)(ad + 96 * LDT) = ra3;
        *(uint4*)(bd) = rb0; *(uint4*)(bd + 32 * LDT) = rb1; *(uint4*)(bd + 64 * LDT) = rb2; *(uint4*)(bd + 96 * LDT) = rb3;
    }
    __syncthreads();
    f32x16 acc[2][2];
#pragma unroll
    for (int i = 0; i < 2; ++i)
#pragma unroll
        for (int j = 0; j < 2; ++j)
#pragma unroll
            for (int e = 0; e < 16; ++e) acc[i][j][e] = 0.f;
    const int nk = K >> 6;
    for (int kt = 0; kt < nk; ++kt) {
        const int cur = kt & 1;
        const bool more = (kt + 1 < nk);
        if (more) {
            const int ko = (kt + 1) * 64 + scol;
            ra0 = *(const uint4*)(a0 + ko); ra1 = *(const uint4*)(a1 + ko); ra2 = *(const uint4*)(a2 + ko); ra3 = *(const uint4*)(a3 + ko);
            rb0 = *(const uint4*)(b0 + ko); rb1 = *(const uint4*)(b1 + ko); rb2 = *(const uint4*)(b2 + ko); rb3 = *(const uint4*)(b3 + ko);
        }
        __builtin_amdgcn_sched_barrier(0);
        const bf16_t* Ac = As + cur * 128 * LDT + (wm * 64 + l32) * LDT + h * 8;
        const bf16_t* Bc = Bs + cur * 128 * LDT + (wn * 64 + l32) * LDT + h * 8;
        bf16x8 fa0[4], fa1[4], fb0[4], fb1[4];
#pragma unroll
        for (int ks = 0; ks < 4; ++ks) {
            fa0[ks] = *(const bf16x8*)(Ac + ks * 16); fb0[ks] = *(const bf16x8*)(Bc + ks * 16);
            fa1[ks] = *(const bf16x8*)(Ac + 32 * LDT + ks * 16); fb1[ks] = *(const bf16x8*)(Bc + 32 * LDT + ks * 16);
        }
        __builtin_amdgcn_sched_barrier(0);
#pragma unroll
        for (int ks = 0; ks < 4; ++ks) {
            acc[0][0] = MFMA32(fa0[ks], fb0[ks], acc[0][0]); acc[0][1] = MFMA32(fa0[ks], fb1[ks], acc[0][1]);
            acc[1][0] = MFMA32(fa1[ks], fb0[ks], acc[1][0]); acc[1][1] = MFMA32(fa1[ks], fb1[ks], acc[1][1]);
        }
        __builtin_amdgcn_sched_barrier(0);
        if (more) {
            bf16_t* ad = As + (cur ^ 1) * 128 * LDT + srow * LDT + scol; bf16_t* bd = Bs + (cur ^ 1) * 128 * LDT + srow * LDT + scol;
            *(uint4*)(ad) = ra0; *(uint4*)(ad + 32 * LDT) = ra1; *(uint4*)(ad + 64 * LDT) = ra2; *(uint4*)(ad + 96 * LDT) = ra3;
            *(uint4*)(bd) = rb0; *(uint4*)(bd + 32 * LDT) = rb1; *(uint4*)(bd + 64 * LDT) = rb2; *(uint4*)(bd + 96 * LDT) = rb3;
        }
        __syncthreads();
    }
    {
        float* ct = (float*)smem;
#pragma unroll
        for (int mi = 0; mi < 2; ++mi)
#pragma unroll
            for (int ni = 0; ni < 2; ++ni)
#pragma unroll
                for (int i = 0; i < 16; ++i) ct[(wm * 64 + mi * 32 + acc_row(i, h)) * CT_LD + wn * 64 + ni * 32 + l32] = acc[mi][ni][i];
        __syncthreads();
        epi(ct, row0, col0);
        __syncthreads();
    }
}

template <class Epi, class RowOf>
DI void gemm_phase(const bf16_t* A, int lda, const bf16_t* Bt, int K, int n_mt, int ntn, char* smem, const Epi& epi, const RowOf& row_of) {
    const int srow = tid() >> 3;
    for (int u = unit_first(); u < n_mt * ntn; u += gridDim.x) {
        const int mt = u / ntn, nt = u - mt * ntn;
        const int row0 = row_of(mt), col0 = nt * 128;
        const bf16_t* ap = A + (size_t)(row0 + srow) * lda;
        const bf16_t* bp = Bt + (size_t)(col0 + srow) * K;
        gemm_tile(ap, ap + (size_t)32 * lda, ap + (size_t)64 * lda, ap + (size_t)96 * lda,
                  bp, bp + (size_t)32 * K, bp + (size_t)64 * K, bp + (size_t)96 * K, K, smem, epi, row0, col0);
    }
}

struct WEpiSplit { static constexpr int MODE = 0; static constexpr bool TILE = false; bf16_t* O0; int ld0; bf16_t* O1; int ld1; int split; int ncol;
    DI void store(int row, int col, uint4 v) const { if (col < split) { if (col < ncol) *(uint4*)(O0 + (size_t)row * ld0 + col) = v; } else *(uint4*)(O1 + (size_t)row * ld1 + (col - split)) = v; } };
struct WEpiResidual { static constexpr int MODE = 0; static constexpr bool TILE = false; const Params* pp; int layer;
    DI void store(int row, int col, uint4 v) const {
        const Params& p = *pp;
        const float* md = p.mod + (size_t)(layer * 5 + mod_row(row)) * 6144 + 2048 + col;
        float* dst = res_row(p, row) + col;
        const float* srcp = layer == 0 ? in_row(p, row) + col : dst;
        const float4 x0 = *(const float4*)srcp, x1 = *(const float4*)(srcp + 4), g0 = *(const float4*)md, g1 = *(const float4*)(md + 4);
        float4 o0 = {x0.x + g0.x * bflo(v.x), x0.y + g0.y * bfhi(v.x), x0.z + g0.z * bflo(v.y), x0.w + g0.w * bfhi(v.y)};
        float4 o1 = {x1.x + g1.x * bflo(v.z), x1.y + g1.y * bfhi(v.z), x1.z + g1.z * bflo(v.w), x1.w + g1.w * bfhi(v.w)};
        *(float4*)dst = o0; *(float4*)(dst + 4) = o1;
    } };
struct WEpiRows { static constexpr int MODE = 0; static constexpr bool TILE = false; bf16_t* O; int ld; int rbase; int row_end;
    DI void store(int row, int col, uint4 v) const { if (row < row_end) *(uint4*)(O + (size_t)(row - rbase) * ld + col) = v; } };
constexpr float YP_SCALE = 4.f;
struct WEpiRows8 { static constexpr int MODE = 2; static constexpr bool TILE = false; unsigned char* O; int rbase; int row_end;
    DI void store8(int row, int col, uint4 v) const { if (row < row_end) *(uint4*)(O + (size_t)(row - rbase) * DM + col) = v; } };
struct WEpiGateUp { static constexpr int MODE = 1; bf16_t* HID; const float* sw; int pos_end;
    DI float row_w(int pos) const { return pos < pos_end ? sw[pos] * YP_SCALE : 0.f; }
    DI void store(int pos, int f, uint4 v) const { if (pos < pos_end) *(uint4*)(HID + (size_t)pos * FF + f) = v; } };
constexpr int LDA = 72;
constexpr int CBP = 264;
template <class Epi> struct GUnit { const bf16_t *a0, *a1, *a2, *a3, *bw; int row0, col0, K; Epi epi; };
struct GOff { unsigned a0, a1, a2, a3, bw; };
template <class Epi, class UnitFn>
DI void gemm_stream_w(int n_units, const UnitFn& unit_fn, char* smem, const char* base) {
    bf16_t* As = (bf16_t*)smem;
    const int t = tid(), lane = t & 63, wave = t >> 6, l32 = lane & 31, h = lane >> 5;
    const int srow = t >> 3, scol = (t & 7) * 8;
    int u = unit_first();
    if (u >= n_units) return;
    uint4 ra0, ra1, ra2, ra3;
    bf16x8 fbA[2][2], fbB[2][2];
#define GW_OFF(g) GOff{(unsigned)((const char*)(g).a0 - base) + (unsigned)scol * 2u, (unsigned)((const char*)(g).a1 - base) + (unsigned)scol * 2u, \
                       (unsigned)((const char*)(g).a2 - base) + (unsigned)scol * 2u, (unsigned)((const char*)(g).a3 - base) + (unsigned)scol * 2u, (unsigned)((const char*)(g).bw - base)}
    const __amdgpu_buffer_rsrc_t wrs = __builtin_amdgcn_make_buffer_rsrc((void*)base, 0, 0x7FFFFFFF, 0x00020000);
#define GW_LD(vo, so) __builtin_bit_cast(uint4, __builtin_amdgcn_raw_buffer_load_b128(wrs, (int)(vo), (int)(so), 0))
#define GW_LDF(vo, so) __builtin_bit_cast(bf16x8, __builtin_amdgcn_raw_buffer_load_b128(wrs, (int)(vo), (int)(so), 0))
#define GW_LOADA(o, ko) do { ra0 = GW_LD((o).a0, ko); ra1 = GW_LD((o).a1, ko); ra2 = GW_LD((o).a2, ko); ra3 = GW_LD((o).a3, ko); } while (0)
#define GW_STOREA(buf) do { bf16_t* ad = As + (buf) * 128 * LDA + srow * LDA + scol; *(uint4*)(ad) = ra0; *(uint4*)(ad + 32 * LDA) = ra1; \
        *(uint4*)(ad + 64 * LDA) = ra2; *(uint4*)(ad + 96 * LDA) = ra3; } while (0)
#define GW_LOADB(fb, bv, bs, K) do { fb[0][0] = GW_LDF(bv, bs); fb[1][0] = GW_LDF(bv, (bs) + 1024u); \
        fb[0][1] = GW_LDF(bv, (bs) + 64u * (unsigned)(K)); fb[1][1] = GW_LDF(bv, (bs) + 64u * (unsigned)(K) + 1024u); } while (0)
#define GW_COMPUTE(Ac, fb) do { \
        bf16x8 fa[2][4]; \
        _Pragma("unroll") for (int ks = 0; ks < 2; ++ks) \
            _Pragma("unroll") for (int mi = 0; mi < 4; ++mi) fa[ks][mi] = *(const bf16x8*)((Ac) + mi * 32 * LDA + ks * 16); \
        __builtin_amdgcn_sched_barrier(0); \
        _Pragma("unroll") for (int ks = 0; ks < 2; ++ks) \
            _Pragma("unroll") for (int mi = 0; mi < 4; ++mi) { acc[mi][0] = MFMA32(fb[ks][0], fa[ks][mi], acc[mi][0]); acc[mi][1] = MFMA32(fb[ks][1], fa[ks][mi], acc[mi][1]); } \
        __builtin_amdgcn_sched_barrier(0); } while (0)
    GUnit<Epi> cur = unit_fn(u, srow, wave, lane);
    GOff co = GW_OFF(cur);
    GW_LOADA(co, 0u);
    GW_LOADB(fbA, co.bw, 0u, cur.K);
    for (;;) {
        const int ns = cur.K >> 6;
        GW_STOREA(0);
        __syncthreads();
        const int un = u + (int)gridDim.x;
        const bool has_next = un < n_units;
        GUnit<Epi> nxt = cur;
        if (has_next) nxt = unit_fn(un, srow, wave, lane);
        const GOff no = GW_OFF(nxt);
        f32x16 acc[4][2];
#pragma unroll
        for (int i = 0; i < 4; ++i)
#pragma unroll
            for (int j = 0; j < 2; ++j)
#pragma unroll
                for (int e = 0; e < 16; ++e) acc[i][j][e] = 0.f;
        for (int st = 0; st < ns; ++st) {
            const bool more = (st + 1 < ns);
            const bf16_t* Ac = As + (st & 1) * 128 * LDA + l32 * LDA + h * 8;
            {
                const unsigned ko = more ? (unsigned)(st + 1) * 128u : 0u;
                ra0 = GW_LD(more ? co.a0 : no.a0, ko); ra1 = GW_LD(more ? co.a1 : no.a1, ko);
                ra2 = GW_LD(more ? co.a2 : no.a2, ko); ra3 = GW_LD(more ? co.a3 : no.a3, ko);
            }
            GW_LOADB(fbB, co.bw, (unsigned)(2 * st + 1) * 2048u, cur.K);
            __builtin_amdgcn_sched_barrier(0);
            GW_COMPUTE(Ac, fbA);
            {
                const unsigned pbv = more ? co.bw : no.bw, pbs = more ? (unsigned)(2 * st + 2) * 2048u : 0u;
                const int K = more ? cur.K : nxt.K;
                GW_LOADB(fbA, pbv, pbs, K);
            }
            __builtin_amdgcn_sched_barrier(0);
            GW_COMPUTE(Ac + 32, fbB);
            if (more) GW_STOREA((st + 1) & 1);
            __syncthreads();
        }
        {
            bf16_t* cb = (bf16_t*)smem;
            if constexpr (Epi::MODE == 0) {
#pragma unroll
                for (int mi = 0; mi < 4; ++mi)
#pragma unroll
                    for (int ni = 0; ni < 2; ++ni)
#pragma unroll
                        for (int q = 0; q < 4; ++q) {
                            uint2 w; w.x = pk_bf16(acc[mi][ni][4 * q], acc[mi][ni][4 * q + 1]); w.y = pk_bf16(acc[mi][ni][4 * q + 2], acc[mi][ni][4 * q + 3]);
                            *(uint2*)(cb + (mi * 32 + l32) * CBP + wave * 64 + ni * 32 + 8 * q + 4 * h) = w;
                        }
                __syncthreads();
                if constexpr (Epi::TILE) cur.epi.tile(cb, cur.row0, cur.col0, smem);
                else {
#pragma unroll 4
                    for (int it = 0; it < 16; ++it) {
                        const int idx = t + NTHR * it, row = idx >> 5, c8 = (idx & 31) * 8;
                        cur.epi.store(cur.row0 + row, cur.col0 + c8, *(const uint4*)(cb + row * CBP + c8));
                    }
                }
            } else if constexpr (Epi::MODE == 2) {
                unsigned char* c8 = (unsigned char*)smem;
                constexpr int C8P = 272;
#pragma unroll
                for (int mi = 0; mi < 4; ++mi)
#pragma unroll
                    for (int ni = 0; ni < 2; ++ni)
#pragma unroll
                        for (int q = 0; q < 4; ++q) {
                            int w = __builtin_amdgcn_cvt_pk_fp8_f32(acc[mi][ni][4 * q], acc[mi][ni][4 * q + 1], 0, false);
                            w = __builtin_amdgcn_cvt_pk_fp8_f32(acc[mi][ni][4 * q + 2], acc[mi][ni][4 * q + 3], w, true);
                            *(int*)(c8 + (mi * 32 + l32) * C8P + wave * 64 + ni * 32 + 8 * q + 4 * h) = w;
                        }
                __syncthreads();
#pragma unroll 4
                for (int it = 0; it < 8; ++it) {
                    const int idx = t + NTHR * it, row = idx >> 4, c16 = (idx & 15) * 16;
                    cur.epi.store8(cur.row0 + row, cur.col0 + c16, *(const uint4*)(c8 + row * C8P + c16));
                }
            } else {
#pragma unroll
                for (int mi = 0; mi < 4; ++mi) {
                    const float wr = cur.epi.row_w(cur.row0 + mi * 32 + l32);
#pragma unroll
                    for (int q = 0; q < 4; ++q) {
                        float o[4];
#pragma unroll
                        for (int j = 0; j < 4; ++j) o[j] = silu_f(acc[mi][0][4 * q + j]) * acc[mi][1][4 * q + j] * wr;
                        uint2 w; w.x = pk_bf16(o[0], o[1]); w.y = pk_bf16(o[2], o[3]);
                        *(uint2*)(cb + (mi * 32 + l32) * CBP + wave * 32 + 8 * q + 4 * h) = w;
                    }
                }
                __syncthreads();
#pragma unroll 4
                for (int it = 0; it < 8; ++it) {
                    const int idx = t + NTHR * it, row = idx >> 4, c8 = (idx & 15) * 8;
                    cur.epi.store(cur.row0 + row, (cur.col0 >> 1) + c8, *(const uint4*)(cb + row * CBP + c8));
                }
            }
            __syncthreads();
        }
        if (!has_next) break;
        cur = nxt; co = no; u = un;
    }
#undef GW_OFF
#undef GW_LD
#undef GW_LDF
#undef GW_LOADA
#undef GW_STOREA
#undef GW_LOADB
#undef GW_COMPUTE
}
template <class Epi, class RowOf>
DI void gemm_phase_w(const char* base, const bf16_t* A, int lda, const bf16_t* Bt, int K, int n_mt, int ntn, char* smem, const Epi& epi, const RowOf& row_of) {
    auto unit_fn = [&](int u, int srow, int wave, int lane) {
        const int mt = u / ntn, nt = u - mt * ntn;
        const int row0 = row_of(mt), col0 = nt * 256;
        const bf16_t* ap = A + (size_t)(row0 + srow) * lda;
        const bf16_t* bw = Bt + (size_t)(col0 + wave * 64) * K + lane * 8;
        return GUnit<Epi>{ap, ap + (size_t)32 * lda, ap + (size_t)64 * lda, ap + (size_t)96 * lda, bw, row0, col0, K, epi};
    };
    gemm_stream_w<Epi>(n_mt * ntn, unit_fn, smem, base);
}
struct RowIdent { DI int operator()(int mt) const { return mt * 128; } };
struct RowLatent { DI int operator()(int mt) const { return (mt >> 6) * LT + LC + (mt & 63) * 128; } };

DI uint4 pack8(const float* s) {
    const float4 a = *(const float4*)s, b = *(const float4*)(s + 4);
    uint4 o; o.x = pk_bf16(a.x, a.y); o.y = pk_bf16(a.z, a.w); o.z = pk_bf16(b.x, b.y); o.w = pk_bf16(b.z, b.w); return o;
}
struct EpiSplitBf16 {
    bf16_t* O0; int ld0; bf16_t* O1; int ld1; int split;
    DI void operator()(const float* ct, int row0, int col0) const {
        bf16_t* base; int ld;
        if (col0 < split) { base = O0 + col0; ld = ld0; } else { base = O1 + (col0 - split); ld = ld1; }
#pragma unroll 2
        for (int it = 0; it < 8; ++it) {
            const int idx = tid() + NTHR * it, row = idx >> 4, c8 = (idx & 15) * 8;
            *(uint4*)(base + (size_t)(row0 + row) * ld + c8) = pack8(ct + row * CT_LD + c8);
        }
    }
};
struct EpiResidual {
    Params p; int layer;
    DI void operator()(const float* ct, int row0, int col0) const {
        const float* md = p.mod + (size_t)(layer * 5 + mod_row(row0)) * 6144 + 2048 + col0;
#pragma unroll 2
        for (int it = 0; it < 16; ++it) {
            const int idx = tid() + NTHR * it, row = idx >> 5, c4 = (idx & 31) * 4, r = row0 + row;
            const float4 a = *(const float4*)(ct + row * CT_LD + c4), g = *(const float4*)(md + c4);
            float* dst = res_row(p, r) + col0 + c4;
            const float4 x = layer == 0 ? *(const float4*)(in_row(p, r) + col0 + c4) : *(const float4*)dst;
            float4 o = {x.x + g.x * a.x, x.y + g.y * a.y, x.z + g.z * a.z, x.w + g.w * a.w};
            *(float4*)dst = o;
        }
    }
};

template <int DK, int DV, bool LSUM_MFMA>
DI void attn_core(const bf16_t* Qh, const bf16_t* Kh, const bf16_t* VTh, int qpos0, int nkeys, float c, float kmax2, char* smem,
                  f32x16 (&O)[DV / 32], float& l_tot) {
    constexpr int KS = DK / 16, NDB = DV / 32, LDK = DK + 8, KCH = DK / 8, NKCH = 64 * KCH, NKC = (NKCH + NTHR - 1) / NTHR, NVC = DV * 8 / NTHR;
    bf16_t* Ks = (bf16_t*)smem;
    bf16_t* Vs = Ks + 2 * 64 * LDK;
    const int t = tid(), lane = t & 63, wave = t >> 6, l32 = lane & 31, h = lane >> 5;
    bf16x8 qf[KS];
    {
        const bf16_t* qp = Qh + (size_t)(qpos0 + wave * 32 + l32) * DK + h * 8;
#pragma unroll
        for (int ks = 0; ks < KS; ++ks) qf[ks] = *(const bf16x8*)(qp + ks * 16);
    }
    static_assert(NKC == 2 && (NVC == 2 || NVC == 4), "staging shape");
    uint4 rk0, rk1, rv0, rv1, rv2 = {0u, 0u, 0u, 0u}, rv3 = {0u, 0u, 0u, 0u};
    const int kidx1 = (NKCH % NTHR == 0 || t + NTHR < NKCH) ? t + NTHR : NKCH - 1;
    const bool k1ok = (NKCH % NTHR == 0) || (t + NTHR < NKCH);
    const __amdgpu_buffer_rsrc_t krs = __builtin_amdgcn_make_buffer_rsrc((void*)Kh, 0, 0x7FFFFFFF, 0x00020000);
    const __amdgpu_buffer_rsrc_t vrs = __builtin_amdgcn_make_buffer_rsrc((void*)VTh, 0, 0x7FFFFFFF, 0x00020000);
    const int ko0 = t * 16, ko1 = kidx1 * 16;
    const int vo0 = ((t >> 3) * LT + (t & 7) * 8) * 2;
    const int ks0 = (t / KCH) * LDK + (t % KCH) * 8, ks1 = ((t + NTHR) / KCH) * LDK + ((t + NTHR) % KCH) * 8;
    const int vs0 = (t >> 3) * LDT + (t & 7) * 8;
#define ATT_BL(rs, vo, so) __builtin_bit_cast(uint4, __builtin_amdgcn_raw_buffer_load_b128(rs, vo, so, 0))
#define ATT_LOAD(key0) do { const int kso_ = (key0) * (DK * 2), vso_ = (key0) * 2; \
        rk0 = ATT_BL(krs, ko0, kso_); rk1 = ATT_BL(krs, ko1, kso_); \
        rv0 = ATT_BL(vrs, vo0, vso_); rv1 = ATT_BL(vrs, vo0, vso_ + 32 * LT * 2); \
        if constexpr (NVC == 4) { rv2 = ATT_BL(vrs, vo0, vso_ + 64 * LT * 2); rv3 = ATT_BL(vrs, vo0, vso_ + 96 * LT * 2); } } while (0)
#define ATT_STORE(buf) do { *(uint4*)(Ks + (buf) * 64 * LDK + ks0) = rk0; if (k1ok) *(uint4*)(Ks + (buf) * 64 * LDK + ks1) = rk1; \
        *(uint4*)(Vs + (buf) * DV * LDT + vs0) = rv0; *(uint4*)(Vs + (buf) * DV * LDT + 32 * LDT + vs0) = rv1; \
        if constexpr (NVC == 4) { *(uint4*)(Vs + (buf) * DV * LDT + 64 * LDT + vs0) = rv2; *(uint4*)(Vs + (buf) * DV * LDT + 96 * LDT + vs0) = rv3; } } while (0)
    ATT_LOAD(0);
    ATT_STORE(0);
    __syncthreads();
#pragma unroll
    for (int d = 0; d < NDB; ++d)
#pragma unroll
        for (int e = 0; e < 16; ++e) O[d][e] = 0.f;
    float qn2 = 0.f;
#pragma unroll
    for (int ks = 0; ks < KS; ++ks) {
        float qv[8];
#pragma unroll
        for (int j = 0; j < 8; ++j) qv[j] = bf2f((bf16_t)qf[ks][j]) * c;
        uint4 w; w.x = pk_bf16(qv[0], qv[1]); w.y = pk_bf16(qv[2], qv[3]); w.z = pk_bf16(qv[4], qv[5]); w.w = pk_bf16(qv[6], qv[7]);
        qf[ks] = __builtin_bit_cast(bf16x8, w);
#pragma unroll
        for (int j = 0; j < 8; ++j) { const float r = bf2f((bf16_t)qf[ks][j]); qn2 += r * r; }
    }
    qn2 = half_sum(qn2);
    const float Mrow = sqrtf(qn2 * kmax2) * 1.02f + 1e-3f;
    const bool fast = __all(Mrow < 50.f) != 0;
    float m_run = -1e30f, l_run = 0.f;
    const int nt = nkeys >> 6;
    auto tile_loop = [&](auto fast_tag) {
    constexpr bool FAST = decltype(fast_tag)::value;
    f32x16 Cinit;
#pragma unroll
    for (int e = 0; e < 16; ++e) Cinit[e] = FAST ? -Mrow : 0.f;
    f32x16 Lacc;
#pragma unroll
    for (int e = 0; e < 16; ++e) Lacc[e] = 0.f;
    const bf16x8 ones = {0x3F80, 0x3F80, 0x3F80, 0x3F80, 0x3F80, 0x3F80, 0x3F80, 0x3F80};
    auto body = [&](auto cur_c, const int kt, const bool more) {
        const int cur = cur_c;
        if (more) { const int key0 = (kt + 1) * 64; ATT_LOAD(key0); }
        __builtin_amdgcn_sched_barrier(0);
        f32x16 S0, S1;
        const bf16_t* kb = Ks + (cur * 64 + l32) * LDK + h * 8;
        bf16x8 kf0[KS], kf1[KS];
#pragma unroll
        for (int ks = 0; ks < KS; ++ks) { kf0[ks] = *(const bf16x8*)(kb + ks * 16); kf1[ks] = *(const bf16x8*)(kb + 32 * LDK + ks * 16); }
        __builtin_amdgcn_sched_barrier(0);
        S0 = MFMA32(kf0[0], qf[0], Cinit); S1 = MFMA32(kf1[0], qf[0], Cinit);
#pragma unroll
        for (int ks = 1; ks < KS; ++ks) { S0 = MFMA32(kf0[ks], qf[ks], S0); S1 = MFMA32(kf1[ks], qf[ks], S1); }
        constexpr int VPF = NDB < 2 ? NDB : 2;
        bf16x8 vf[VPF][4];
#pragma unroll
        for (int d = 0; d < VPF; ++d) {
            const bf16_t* vb = Vs + (cur * DV + d * 32 + l32) * LDT + h * 8;
#pragma unroll
            for (int j = 0; j < 4; ++j) vf[d][j] = *(const bf16x8*)(vb + j * 16);
        }
        __builtin_amdgcn_sched_barrier(0);
        if constexpr (FAST) {
#pragma unroll
            for (int e = 0; e < 16; ++e) { S0[e] = __builtin_amdgcn_exp2f(S0[e]); S1[e] = __builtin_amdgcn_exp2f(S1[e]); }
            if constexpr (!LSUM_MFMA) {
#pragma unroll
                for (int e = 0; e < 16; ++e) { l_run += S0[e]; l_run += S1[e]; }
            }
        } else {
            float mx = fmaxf(S0[0], S1[0]);
#pragma unroll
            for (int e = 1; e < 16; ++e) mx = fmaxf(mx, fmaxf(S0[e], S1[e]));
            mx = half_max(mx);
            const float m_new = fmaxf(m_run, mx);
            const float alpha = __builtin_amdgcn_exp2f(m_run - m_new);
            m_run = m_new;
            float ls = 0.f;
#pragma unroll
            for (int e = 0; e < 16; ++e) { S0[e] = __builtin_amdgcn_exp2f(S0[e] - m_new); S1[e] = __builtin_amdgcn_exp2f(S1[e] - m_new); ls += S0[e] + S1[e]; }
            l_run = l_run * alpha + ls;
#pragma unroll
            for (int d = 0; d < NDB; ++d)
#pragma unroll
                for (int e = 0; e < 16; ++e) O[d][e] *= alpha;
        }
        bf16x8 pf[4];
        {
            uint4 w;
            w.x = pk_bf16(S0[0], S0[1]); w.y = pk_bf16(S0[2], S0[3]); w.z = pk_bf16(S0[4], S0[5]); w.w = pk_bf16(S0[6], S0[7]); pf[0] = __builtin_bit_cast(bf16x8, w);
            w.x = pk_bf16(S0[8], S0[9]); w.y = pk_bf16(S0[10], S0[11]); w.z = pk_bf16(S0[12], S0[13]); w.w = pk_bf16(S0[14], S0[15]); pf[1] = __builtin_bit_cast(bf16x8, w);
            w.x = pk_bf16(S1[0], S1[1]); w.y = pk_bf16(S1[2], S1[3]); w.z = pk_bf16(S1[4], S1[5]); w.w = pk_bf16(S1[6], S1[7]); pf[2] = __builtin_bit_cast(bf16x8, w);
            w.x = pk_bf16(S1[8], S1[9]); w.y = pk_bf16(S1[10], S1[11]); w.z = pk_bf16(S1[12], S1[13]); w.w = pk_bf16(S1[14], S1[15]); pf[3] = __builtin_bit_cast(bf16x8, w);
        }
        if constexpr (FAST && LSUM_MFMA) {
#pragma unroll
            for (int j = 0; j < 4; ++j) Lacc = MFMA32(ones, pf[j], Lacc);
        }
        __builtin_amdgcn_sched_barrier(0);
        if constexpr (NDB > VPF) {
#pragma unroll
            for (int d = 0; d < NDB; ++d) {
#pragma unroll
                for (int j = 0; j < 4; ++j) O[d] = MFMA32(vf[d % VPF][j], pf[j], O[d]);
                if (d + VPF < NDB) {
                    __builtin_amdgcn_sched_barrier(0);
                    const bf16_t* vb = Vs + (cur * DV + (d + VPF) * 32 + l32) * LDT + h * 8;
#pragma unroll
                    for (int j = 0; j < 4; ++j) vf[d % VPF][j] = *(const bf16x8*)(vb + j * 16);
                    __builtin_amdgcn_sched_barrier(0);
                }
            }
        } else {
#pragma unroll
            for (int d = 0; d < VPF; ++d)
#pragma unroll
                for (int j = 0; j < 4; ++j) O[d] = MFMA32(vf[d][j], pf[j], O[d]);
        }
        __builtin_amdgcn_sched_barrier(0);
        if (more) { const int nb = cur ^ 1; ATT_STORE(nb); }
        __syncthreads();
    };
    for (int kt = 0; kt < nt; kt += 2) {
        body(std::integral_constant<int, 0>{}, kt, true);
        body(std::integral_constant<int, 1>{}, kt + 1, kt + 2 < nt);
    }
    if constexpr (FAST && LSUM_MFMA) l_run = 0.5f * Lacc[0];
    };
    if (fast) tile_loop(std::true_type{}); else tile_loop(std::false_type{});
    l_tot = half_sum(l_run);
#undef ATT_LOAD
#undef ATT_BL
#undef ATT_STORE
}

DI float kmax_of(const Params& p, int idx) { return __uint_as_float(__hip_atomic_load(p.kmax + idx, __ATOMIC_RELAXED, __HIP_MEMORY_SCOPE_AGENT)); }
DI void attn0_unit(const Params& p, int u, char* smem) {
    int b, hd, qb;
    if (u < NB * 4 * 64) { b = u / 256; hd = (u >> 6) & 3; qb = 2 + (u & 63); }
    else { const int v = u - NB * 4 * 64; b = v >> 3; hd = (v >> 1) & 3; qb = v & 1; }
    const int nkeys = qb < 2 ? LC : LT;
    const bf16_t* Q = (const bf16_t*)p.x2;
    const bf16_t* K = Q + (size_t)NB * 8 * LT * 64;
    const bf16_t* VT = K + (size_t)NB * 8 * LT * 64;
    float* Otmp = (float*)p.x1;
    bf16_t* CAT = (bf16_t*)p.x4;
    const int lane = tid() & 63, wave = tid() >> 6, l32 = lane & 31, h = lane >> 5;
    const int qpos0 = qb * 128;
    const int row = b * LT + qpos0 + wave * 32 + l32;
    const float c = 0.125f * LOG2E;
    const bf16_t* VTh = VT + (size_t)(b * 4 + hd) * 128 * LT;
    float* ot = Otmp + ((size_t)row * 4 + hd) * 128;
    f32x16 O[4]; float l_tot;
    attn_core<64, 128, false>(Q + (size_t)(b * 8 + hd * 2 + 0) * LT * 64, K + (size_t)(b * 8 + hd * 2 + 0) * LT * 64, VTh, qpos0, nkeys, c, kmax_of(p, b * 8 + hd * 2 + 0), smem, O, l_tot);
    {
        const float inv = 1.f / l_tot;
#pragma unroll
        for (int d = 0; d < 4; ++d)
#pragma unroll
            for (int g = 0; g < 4; ++g) {
                float4 v = {O[d][4 * g] * inv, O[d][4 * g + 1] * inv, O[d][4 * g + 2] * inv, O[d][4 * g + 3] * inv};
                *(float4*)(ot + d * 32 + 8 * g + 4 * h) = v;
            }
    }
    attn_core<64, 128, false>(Q + (size_t)(b * 8 + hd * 2 + 1) * LT * 64, K + (size_t)(b * 8 + hd * 2 + 1) * LT * 64, VTh, qpos0, nkeys, c, kmax_of(p, b * 8 + hd * 2 + 1), smem, O, l_tot);
    {
        const float inv = 1.f / l_tot, lam = p.lamv[0];
        float ss = 0.f;
#pragma unroll
        for (int d = 0; d < 4; ++d)
#pragma unroll
            for (int g = 0; g < 4; ++g) {
                const float4 o1 = *(const float4*)(ot + d * 32 + 8 * g + 4 * h);
                O[d][4 * g] = o1.x - lam * O[d][4 * g] * inv; O[d][4 * g + 1] = o1.y - lam * O[d][4 * g + 1] * inv;
                O[d][4 * g + 2] = o1.z - lam * O[d][4 * g + 2] * inv; O[d][4 * g + 3] = o1.w - lam * O[d][4 * g + 3] * inv;
                ss += O[d][4 * g] * O[d][4 * g] + O[d][4 * g + 1] * O[d][4 * g + 1] + O[d][4 * g + 2] * O[d][4 * g + 2] + O[d][4 * g + 3] * O[d][4 * g + 3];
            }
        ss = half_sum(ss);
        const float rinv = rsqrtf(ss * (1.f / 128.f) + EPSV) * 0.8f;
        const float* sub = p.in[10];
        bf16_t* op = CAT + (size_t)row * DM + hd * 128;
#pragma unroll
        for (int d = 0; d < 4; ++d)
#pragma unroll
            for (int g = 0; g < 4; ++g) {
                const int dv = d * 32 + 8 * g + 4 * h;
                const float4 sb = *(const float4*)(sub + dv);
                uint2 o; o.x = pk_bf16(O[d][4 * g] * rinv * sb.x, O[d][4 * g + 1] * rinv * sb.y); o.y = pk_bf16(O[d][4 * g + 2] * rinv * sb.z, O[d][4 * g + 3] * rinv * sb.w);
                *(uint2*)(op + dv) = o;
            }
    }
}

DI void attn1_unit(const Params& p, int u, char* smem) {
    const bf16_t* Q1 = (const bf16_t*)p.x2;
    const bf16_t* K1 = Q1 + (size_t)NB * 8 * LT * 64;
    const bf16_t* VT1 = K1 + (size_t)NB * 2 * LT * 64;
    const bf16_t* MQ = VT1 + (size_t)NB * 2 * 64 * LT;
    const bf16_t* MK = MQ + (size_t)NB * 8 * LT * 48;
    const bf16_t* MVT = MK + (size_t)NB * 8 * LT * 48;
    bf16_t* CAT = (bf16_t*)p.x4;
    const int lane = tid() & 63, wave = tid() >> 6, l32 = lane & 31, h = lane >> 5;
    const int mla = u >= 2048, v = u & 2047, b = v >> 9, hd = (v >> 6) & 7, qb = 2 + (v & 63);
    const int qpos0 = qb * 128;
    const int row = b * LT + qpos0 + wave * 32 + l32;
    f32x16 O[2]; float l_tot;
    if (!mla) attn_core<64, 64, false>(Q1 + (size_t)(b * 8 + hd) * LT * 64, K1 + (size_t)(b * 2 + (hd >> 2)) * LT * 64, VT1 + (size_t)(b * 2 + (hd >> 2)) * 64 * LT, qpos0, LT, 0.125f * LOG2E, kmax_of(p, 32 + b * 2 + (hd >> 2)), smem, O, l_tot);
    else attn_core<48, 64, false>(MQ + (size_t)(b * 8 + hd) * LT * 48, MK + (size_t)(b * 8 + hd) * LT * 48, MVT + (size_t)(b * 8 + hd) * 64 * LT, qpos0, LT, 0.14433756729740643f * LOG2E, kmax_of(p, 40 + b * 8 + hd), smem, O, l_tot);
    const float inv = 1.f / l_tot;
    bf16_t* op = CAT + (size_t)row * DM + mla * 512 + hd * 64;
#pragma unroll
    for (int d = 0; d < 2; ++d)
#pragma unroll
        for (int g = 0; g < 4; ++g) {
            uint2 o; o.x = pk_bf16(O[d][4 * g] * inv, O[d][4 * g + 1] * inv); o.y = pk_bf16(O[d][4 * g + 2] * inv, O[d][4 * g + 3] * inv);
            *(uint2*)(op + d * 32 + 8 * g + 4 * h) = o;
        }
}

#define ROPE64(x, cr, sr, cc, sc) do { _Pragma("unroll") for (int i_ = 0; i_ < 16; ++i_) { \
    const float a_ = x[i_], b_ = x[i_ + 16]; x[i_] = a_ * (cr)[i_] - b_ * (sr)[i_]; x[i_ + 16] = a_ * (sr)[i_] + b_ * (cr)[i_]; \
    const float c_ = x[32 + i_], d_ = x[48 + i_]; x[32 + i_] = c_ * (cc)[i_] - d_ * (sc)[i_]; x[48 + i_] = c_ * (sc)[i_] + d_ * (cc)[i_]; } } while (0)

constexpr int SEG_LDS_OFF_E = 73728;
struct WEpiInProj0 { static constexpr int MODE = 0; static constexpr bool TILE = true; const Params* pp;
    DI void store(int, int, uint4) const {}
    DI void tile(const bf16_t* cb, int row0, int col0, char* smem) const {
        const Params& p = *pp;
        const int t = tid(), nt = col0 >> 8;
        const int b = row0 / LT, pos0 = row0 - b * LT;
        const bool lat = pos0 >= LC;
        bf16_t* Q = (bf16_t*)p.x2;
        bf16_t* K = Q + (size_t)NB * 8 * LT * 64;
        bf16_t* VT = K + (size_t)NB * 8 * LT * 64;
        if (nt < 4) {
            const bool isk = nt >= 2; const int hj0 = (nt & 1) * 4;
            unsigned* lmax = (unsigned*)(smem + SEG_LDS_OFF_E);
            if (isk) { if (t < 4) lmax[t] = 0u; __syncthreads(); }
#pragma unroll 1
            for (int it = 0; it < 2; ++it) {
                const int item = t + NTHR * it, rr = item >> 2, v = item & 3;
                const bf16_t* src = cb + rr * CBP + v * 64;
                float x[64];
#pragma unroll
                for (int c8 = 0; c8 < 8; ++c8) {
                    const uint4 w = *(const uint4*)(src + c8 * 8);
                    x[c8 * 8 + 0] = bflo(w.x); x[c8 * 8 + 1] = bfhi(w.x); x[c8 * 8 + 2] = bflo(w.y); x[c8 * 8 + 3] = bfhi(w.y);
                    x[c8 * 8 + 4] = bflo(w.z); x[c8 * 8 + 5] = bfhi(w.z); x[c8 * 8 + 6] = bflo(w.w); x[c8 * 8 + 7] = bfhi(w.w);
                }
                if (lat) {
                    const int tpos = pos0 + rr - LC, gr = tpos >> 6, gc = tpos & 63;
                    const float* cr = p.tab + TB_CR + gr * 16; const float* sr = p.tab + TB_SR + gr * 16;
                    const float* cc = p.tab + TB_CC + gc * 16; const float* sc = p.tab + TB_SC + gc * 16;
                    ROPE64(x, cr, sr, cc, sc);
                }
                if (isk) { float ss = 0.f;
#pragma unroll
                    for (int i = 0; i < 64; ++i) ss += x[i] * x[i];
                    atomicMax(&lmax[v], __float_as_uint(ss)); }
                bf16_t* dst = (isk ? K : Q) + ((size_t)(b * 8 + hj0 + v) * LT + pos0 + rr) * 64;
#pragma unroll
                for (int c8 = 0; c8 < 8; ++c8) {
                    uint4 w; w.x = pk_bf16(x[c8 * 8], x[c8 * 8 + 1]); w.y = pk_bf16(x[c8 * 8 + 2], x[c8 * 8 + 3]); w.z = pk_bf16(x[c8 * 8 + 4], x[c8 * 8 + 5]); w.w = pk_bf16(x[c8 * 8 + 6], x[c8 * 8 + 7]);
                    *(uint4*)(dst + c8 * 8) = w;
                }
            }
            if (isk) { __syncthreads(); if (t < 4) atomicMax(&p.kmax[b * 8 + hj0 + t], lmax[t]); }
        } else if (nt < 6) {
#pragma unroll 4
            for (int it = 0; it < 16; ++it) {
                const int idx = t + NTHR * it, col = idx >> 4, q = idx & 15;
                const int kbase = 16 * (q >> 1) + 4 * (q & 1);
                unsigned short e[8];
#pragma unroll
                for (int j = 0; j < 8; ++j) e[j] = cb[(kbase + 8 * (j >> 2) + (j & 3)) * CBP + col];
                uint4 o; o.x = e[0] | ((unsigned)e[1] << 16); o.y = e[2] | ((unsigned)e[3] << 16); o.z = e[4] | ((unsigned)e[5] << 16); o.w = e[6] | ((unsigned)e[7] << 16);
                const int head = (nt - 4) * 2 + (col >> 7), dv = col & 127;
                *(uint4*)(VT + ((size_t)(b * 4 + head) * 128 + dv) * LT + pos0 + q * 8) = o;
            }
        } else {
            bf16_t* UG = (bf16_t*)(p.x1 + (size_t)NT * 1536 * 2);
#pragma unroll 4
            for (int it = 0; it < 16; ++it) {
                const int idx = t + NTHR * it, row = idx >> 5, c8 = (idx & 31) * 8;
                *(uint4*)(UG + (size_t)(row0 + row) * 1024 + (col0 - 1536) + c8) = *(const uint4*)(cb + row * CBP + c8);
            }
        }
    }
};

template <int NC, int LP>
DI void vt_write(const bf16_t* tile, bf16_t* dst, int pos0) {
    const int t = tid();
#pragma unroll
    for (int it = 0; it < NC * 8 / NTHR; ++it) {
        const int idx = t + NTHR * it, col = idx >> 3, q = idx & 7;
        const int kbase = 16 * (q >> 1) + 4 * (q & 1);
        unsigned short e[8];
#pragma unroll
        for (int j = 0; j < 8; ++j) e[j] = tile[(kbase + 8 * (j >> 2) + (j & 3)) * LP + col];
        uint4 o; o.x = e[0] | ((unsigned)e[1] << 16); o.y = e[2] | ((unsigned)e[3] << 16); o.z = e[4] | ((unsigned)e[5] << 16); o.w = e[6] | ((unsigned)e[7] << 16);
        *(uint4*)(dst + (size_t)col * LT + pos0 + q * 8) = o;
    }
}

DI void postproj0_unit(const Params& p, int u, char* smem) {
    const bf16_t* raw = (const bf16_t*)p.x1;
    bf16_t* Q = (bf16_t*)p.x2;
    bf16_t* K = Q + (size_t)NB * 8 * LT * 64;
    bf16_t* VT = K + (size_t)NB * 8 * LT * 64;
    float* tb = (float*)smem;
    bf16_t* tile = (bf16_t*)(smem + 8448);
    const int t = tid();
    const int r0 = u * 64, b = r0 / LT, pos0 = r0 - b * LT;
    const bool lat = pos0 >= LC;
    const int gr = lat ? (pos0 - LC) >> 6 : 0;
    unsigned* lmax = (unsigned*)(smem + 32768);
    if (t < 16) lmax[t] = 0u;
    for (int i = t; i < 1024; i += NTHR) { tb[i] = p.tab[TB_CC + i]; tb[1024 + i] = p.tab[TB_SC + i]; }
    if (t < 16) { tb[2048 + t] = p.tab[TB_CR + gr * 16 + t]; tb[2064 + t] = p.tab[TB_SR + gr * 16 + t]; }
    __syncthreads();
#pragma unroll 1
    for (int it = 0; it < 4; ++it) {
        const int item = t + NTHR * it, rr = item >> 4, vec = item & 15;
        const bf16_t* src = raw + (size_t)(r0 + rr) * 1536 + (vec < 8 ? vec * 64 : 512 + (vec - 8) * 64);
        float x[64];
#pragma unroll
        for (int c8 = 0; c8 < 8; ++c8) {
            const uint4 w = *(const uint4*)(src + c8 * 8);
            x[c8 * 8 + 0] = bflo(w.x); x[c8 * 8 + 1] = bfhi(w.x); x[c8 * 8 + 2] = bflo(w.y); x[c8 * 8 + 3] = bfhi(w.y);
            x[c8 * 8 + 4] = bflo(w.z); x[c8 * 8 + 5] = bfhi(w.z); x[c8 * 8 + 6] = bflo(w.w); x[c8 * 8 + 7] = bfhi(w.w);
        }
        if (lat) { const float* cc = tb + rr * 16; const float* sc = tb + 1024 + rr * 16; ROPE64(x, tb + 2048, tb + 2064, cc, sc); }
        if (vec >= 8) { float ss = 0.f;
#pragma unroll
            for (int i = 0; i < 64; ++i) ss += x[i] * x[i];
            atomicMax(&lmax[vec & 7], __float_as_uint(ss)); }
        bf16_t* dst = (vec < 8 ? Q : K) + ((size_t)(b * 8 + (vec & 7)) * LT + pos0 + rr) * 64;
#pragma unroll
        for (int c8 = 0; c8 < 8; ++c8) {
            uint4 w; w.x = pk_bf16(x[c8 * 8], x[c8 * 8 + 1]); w.y = pk_bf16(x[c8 * 8 + 2], x[c8 * 8 + 3]); w.z = pk_bf16(x[c8 * 8 + 4], x[c8 * 8 + 5]); w.w = pk_bf16(x[c8 * 8 + 6], x[c8 * 8 + 7]);
            *(uint4*)(dst + c8 * 8) = w;
        }
    }
    __syncthreads();
    if (t < 8) atomicMax(&p.kmax[b * 8 + t], lmax[t]);
    for (int hd = 0; hd < 4; ++hd) {
        __syncthreads();
#pragma unroll
        for (int it = 0; it < 4; ++it) {
            const int idx = t + NTHR * it, rr = idx >> 4, c16 = idx & 15;
            *(uint4*)(tile + rr * 136 + c16 * 8) = *(const uint4*)(raw + (size_t)(r0 + rr) * 1536 + 1024 + hd * 128 + c16 * 8);
        }
        __syncthreads();
        vt_write<128, 136>(tile, VT + (size_t)(b * 4 + hd) * 128 * LT, pos0);
    }
    __syncthreads();
}

DI void postproj1a_unit(const Params& p, int u, char* smem) {
    const bf16_t* raw = (const bf16_t*)p.x1;
    bf16_t* CQn = (bf16_t*)(p.x1 + (size_t)NT * CD_INP * 2);
    bf16_t* CKVn = CQn + (size_t)NT * 256;
    bf16_t* KR = CKVn + (size_t)NT * 128;
    bf16_t* Q1 = (bf16_t*)p.x2;
    bf16_t* K1 = Q1 + (size_t)NB * 8 * LT * 64;
    bf16_t* VT1 = K1 + (size_t)NB * 2 * LT * 64;
    float* tb = (float*)smem;
    bf16_t* tile = (bf16_t*)(smem + 8448);
    const int t = tid(), lane = t & 63, wave = t >> 6;
    const int r0 = u * 64, b = r0 / LT, pos0 = r0 - b * LT;
    const bool lat = pos0 >= LC;
    const int gr = lat ? (pos0 - LC) >> 6 : 0;
    unsigned* lmax = (unsigned*)(smem + 32768);
    if (t < 16) lmax[t] = 0u;
    for (int i = t; i < 1024; i += NTHR) { tb[i] = p.tab[TB_CC + i]; tb[1024 + i] = p.tab[TB_SC + i]; }
    if (t < 16) { tb[2048 + t] = p.tab[TB_CR + gr * 16 + t]; tb[2064 + t] = p.tab[TB_SR + gr * 16 + t]; }
    __syncthreads();
    uint4 rw[8];
    {
        const int rr = t / 10, vec = t - rr * 10;
        const bf16_t* src = raw + (size_t)(r0 + rr) * CD_INP + vec * 64;
#pragma unroll
        for (int c8 = 0; c8 < 8; ++c8) rw[c8] = *(const uint4*)(src + c8 * 8);
    }
#pragma unroll 1
    for (int it = 0; it < 3; ++it) {
        const int item = t + NTHR * it;
        uint4 rn[8];
        {
            int itn = item + NTHR; if (itn > 639) itn = 639;
            const int rrn = itn / 10, vecn = itn - rrn * 10;
            const bf16_t* srcn = raw + (size_t)(r0 + rrn) * CD_INP + vecn * 64;
#pragma unroll
            for (int c8 = 0; c8 < 8; ++c8) rn[c8] = *(const uint4*)(srcn + c8 * 8);
        }
        if (item < 640) {
            const int rr = item / 10, vec = item - rr * 10;
            const float* nw = vec < 8 ? p.in[20] : p.in[21];
            float x[64]; float ss = 0.f;
#pragma unroll
            for (int c8 = 0; c8 < 8; ++c8) {
                const uint4 w = rw[c8];
                x[c8 * 8 + 0] = bflo(w.x); x[c8 * 8 + 1] = bfhi(w.x); x[c8 * 8 + 2] = bflo(w.y); x[c8 * 8 + 3] = bfhi(w.y);
                x[c8 * 8 + 4] = bflo(w.z); x[c8 * 8 + 5] = bfhi(w.z); x[c8 * 8 + 6] = bflo(w.w); x[c8 * 8 + 7] = bfhi(w.w);
            }
#pragma unroll
            for (int i = 0; i < 64; ++i) ss += x[i] * x[i];
            const float rinv = rsqrtf(ss * (1.f / 64.f) + EPSV);
#pragma unroll
            for (int i = 0; i < 64; ++i) x[i] = x[i] * rinv * nw[i];
            if (lat) { const float* cc = tb + rr * 16; const float* sc = tb + 1024 + rr * 16; ROPE64(x, tb + 2048, tb + 2064, cc, sc); }
            if (vec >= 8) { float s2 = 0.f;
#pragma unroll
                for (int i = 0; i < 64; ++i) s2 += x[i] * x[i];
                atomicMax(&lmax[vec - 8], __float_as_uint(s2)); }
            bf16_t* dst = vec < 8 ? Q1 + ((size_t)(b * 8 + vec) * LT + pos0 + rr) * 64 : K1 + ((size_t)(b * 2 + (vec - 8)) * LT + pos0 + rr) * 64;
#pragma unroll
            for (int c8 = 0; c8 < 8; ++c8) {
                uint4 w; w.x = pk_bf16(x[c8 * 8], x[c8 * 8 + 1]); w.y = pk_bf16(x[c8 * 8 + 2], x[c8 * 8 + 3]); w.z = pk_bf16(x[c8 * 8 + 4], x[c8 * 8 + 5]); w.w = pk_bf16(x[c8 * 8 + 6], x[c8 * 8 + 7]);
                *(uint4*)(dst + c8 * 8) = w;
            }
        }
#pragma unroll
        for (int c8 = 0; c8 < 8; ++c8) rw[c8] = rn[c8];
    }
    __syncthreads();
    if (t < 2) atomicMax(&p.kmax[32 + b * 2 + t], lmax[t]);
#pragma unroll
    for (int it = 0; it < 4; ++it) {
        const int idx = t + NTHR * it, rr = idx >> 4, c16 = idx & 15;
        *(uint4*)(tile + rr * 136 + c16 * 8) = *(const uint4*)(raw + (size_t)(r0 + rr) * CD_INP + 640 + c16 * 8);
    }
    __syncthreads();
    vt_write<128, 136>(tile, VT1 + (size_t)b * 128 * LT, pos0);
    {
        uint2 wq[16]; unsigned wk[16];
#pragma unroll
        for (int rr = 0; rr < 16; ++rr) {
            const bf16_t* src = raw + (size_t)(r0 + wave * 16 + rr) * CD_INP;
            wq[rr] = *(const uint2*)(src + 768 + lane * 4);
            wk[rr] = *(const unsigned*)(src + 1024 + lane * 2);
        }
        const float4 nwq = *(const float4*)(p.in[22] + lane * 4);
        const float2 nwk = *(const float2*)(p.in[23] + lane * 2);
#pragma unroll
        for (int rr = 0; rr < 16; ++rr) {
            const int r = r0 + wave * 16 + rr;
            {
                const float a = bflo(wq[rr].x), bb = bfhi(wq[rr].x), cc = bflo(wq[rr].y), d = bfhi(wq[rr].y);
                const float ss = wave_sum(a * a + bb * bb + cc * cc + d * d);
                const float rinv = rsqrtf(ss * (1.f / 256.f) + EPSV);
                uint2 o; o.x = pk_bf16(a * rinv * nwq.x, bb * rinv * nwq.y); o.y = pk_bf16(cc * rinv * nwq.z, d * rinv * nwq.w);
                *(uint2*)(CQn + (size_t)r * 256 + lane * 4) = o;
            }
            {
                const float a = bflo(wk[rr]), bb = bfhi(wk[rr]);
                const float ss = wave_sum(a * a + bb * bb);
                const float rinv = rsqrtf(ss * (1.f / 128.f) + EPSV);
                *(unsigned*)(CKVn + (size_t)r * 128 + lane * 2) = pk_bf16(a * rinv * nwk.x, bb * rinv * nwk.y);
            }
        }
    }
    if (t < 64) {
        const int r = r0 + t;
        const bf16_t* src = raw + (size_t)r * CD_INP + 1152;
        const uint4 w0 = *(const uint4*)src, w1 = *(const uint4*)(src + 8);
        float x[16] = {bflo(w0.x), bfhi(w0.x), bflo(w0.y), bfhi(w0.y), bflo(w0.z), bfhi(w0.z), bflo(w0.w), bfhi(w0.w),
                       bflo(w1.x), bfhi(w1.x), bflo(w1.y), bfhi(w1.y), bflo(w1.z), bfhi(w1.z), bflo(w1.w), bfhi(w1.w)};
        if (lat) {
#pragma unroll
            for (int i = 0; i < 4; ++i) {
                const float cr = p.tab[TB_CR4 + gr * 4 + i], sr = p.tab[TB_SR4 + gr * 4 + i], cc = p.tab[TB_CC4 + t * 4 + i], sc = p.tab[TB_SC4 + t * 4 + i];
                const float a = x[i], bb = x[i + 4]; x[i] = a * cr - bb * sr; x[i + 4] = a * sr + bb * cr;
                const float c2 = x[8 + i], d2 = x[12 + i]; x[8 + i] = c2 * cc - d2 * sc; x[12 + i] = c2 * sc + d2 * cc;
            }
        }
        uint4 o0, o1;
        o0.x = pk_bf16(x[0], x[1]); o0.y = pk_bf16(x[2], x[3]); o0.z = pk_bf16(x[4], x[5]); o0.w = pk_bf16(x[6], x[7]);
        o1.x = pk_bf16(x[8], x[9]); o1.y = pk_bf16(x[10], x[11]); o1.z = pk_bf16(x[12], x[13]); o1.w = pk_bf16(x[14], x[15]);
        *(uint4*)(KR + (size_t)r * 16) = o0; *(uint4*)(KR + (size_t)r * 16 + 8) = o1;
    }
    __syncthreads();
}

DI void postproj1c_unit(const Params& p, int u, char* smem) {
    const bf16_t* MQraw = (const bf16_t*)p.x1;
    const bf16_t* MKVraw = MQraw + (size_t)NT * 384;
    const bf16_t* KR = (const bf16_t*)(p.x1 + (size_t)NT * CD_INP * 2) + (size_t)NT * 256 + (size_t)NT * 128;
    bf16_t* MQ = (bf16_t*)p.x2 + (size_t)NB * 8 * LT * 64 + (size_t)NB * 2 * LT * 64 + (size_t)NB * 2 * 64 * LT;
    bf16_t* MK = MQ + (size_t)NB * 8 * LT * 48;
    bf16_t* MVT = MK + (size_t)NB * 8 * LT * 48;
    bf16_t* tile = (bf16_t*)smem;
    unsigned* lmax = (unsigned*)(smem + 32768);
    const int t = tid();
    const int r0 = u * 64, b = r0 / LT, pos0 = r0 - b * LT;
    const bool lat = pos0 >= LC;
    const int gr = lat ? (pos0 - LC) >> 6 : 0;
    if (t < 16) lmax[t] = 0u;
    __syncthreads();
#pragma unroll 1
    for (int it = 0; it < 2; ++it) {
        const int item = t + NTHR * it, rr = item >> 3, hd = item & 7, r = r0 + rr;
        {
            const bf16_t* src = MQraw + (size_t)r * 384 + hd * 48;
            bf16_t* dst = MQ + ((size_t)(b * 8 + hd) * LT + pos0 + rr) * 48;
#pragma unroll
            for (int c8 = 0; c8 < 4; ++c8) *(uint4*)(dst + c8 * 8) = *(const uint4*)(src + c8 * 8);
            const uint4 w0 = *(const uint4*)(src + 32), w1 = *(const uint4*)(src + 40);
            float x[16] = {bflo(w0.x), bfhi(w0.x), bflo(w0.y), bfhi(w0.y), bflo(w0.z), bfhi(w0.z), bflo(w0.w), bfhi(w0.w),
                           bflo(w1.x), bfhi(w1.x), bflo(w1.y), bfhi(w1.y), bflo(w1.z), bfhi(w1.z), bflo(w1.w), bfhi(w1.w)};
            if (lat) {
#pragma unroll
                for (int i = 0; i < 4; ++i) {
                    const float cr = p.tab[TB_CR4 + gr * 4 + i], sr = p.tab[TB_SR4 + gr * 4 + i], cc = p.tab[TB_CC4 + rr * 4 + i], sc = p.tab[TB_SC4 + rr * 4 + i];
                    const float a = x[i], bb = x[i + 4]; x[i] = a * cr - bb * sr; x[i + 4] = a * sr + bb * cr;
                    const float c2 = x[8 + i], d2 = x[12 + i]; x[8 + i] = c2 * cc - d2 * sc; x[12 + i] = c2 * sc + d2 * cc;
                }
            }
            uint4 o0, o1;
            o0.x = pk_bf16(x[0], x[1]); o0.y = pk_bf16(x[2], x[3]); o0.z = pk_bf16(x[4], x[5]); o0.w = pk_bf16(x[6], x[7]);
            o1.x = pk_bf16(x[8], x[9]); o1.y = pk_bf16(x[10], x[11]); o1.z = pk_bf16(x[12], x[13]); o1.w = pk_bf16(x[14], x[15]);
            *(uint4*)(dst + 32) = o0; *(uint4*)(dst + 40) = o1;
        }
        {
            const bf16_t* src = MKVraw + (size_t)r * 768 + hd * 96;
            bf16_t* dst = MK + ((size_t)(b * 8 + hd) * LT + pos0 + rr) * 48;
            float s2 = 0.f;
#pragma unroll
            for (int c8 = 0; c8 < 6; ++c8) {
                const uint4 w = c8 < 4 ? *(const uint4*)(src + c8 * 8) : *(const uint4*)(KR + (size_t)r * 16 + (c8 - 4) * 8);
                *(uint4*)(dst + c8 * 8) = w;
                s2 += bflo(w.x) * bflo(w.x) + bfhi(w.x) * bfhi(w.x) + bflo(w.y) * bflo(w.y) + bfhi(w.y) * bfhi(w.y) + bflo(w.z) * bflo(w.z) + bfhi(w.z) * bfhi(w.z) + bflo(w.w) * bflo(w.w) + bfhi(w.w) * bfhi(w.w);
            }
            atomicMax(&lmax[hd], __float_as_uint(s2));
        }
    }
    __syncthreads();
    if (t < 8) atomicMax(&p.kmax[40 + b * 8 + t], lmax[t]);
    {
        const int rra = t >> 3, c8a = t & 7;
        const bf16_t* va_p = MKVraw + (size_t)(r0 + rra) * 768 + 32 + c8a * 8;
        const bf16_t* vb_p = va_p + (size_t)32 * 768;
        uint4 va = *(const uint4*)va_p, vb = *(const uint4*)vb_p;
        for (int hd = 0; hd < 8; ++hd) {
            __syncthreads();
            *(uint4*)(tile + rra * 72 + c8a * 8) = va;
            *(uint4*)(tile + (rra + 32) * 72 + c8a * 8) = vb;
            const int hn = hd < 7 ? hd + 1 : 7;
            va = *(const uint4*)(va_p + hn * 96); vb = *(const uint4*)(vb_p + hn * 96);
            __syncthreads();
            vt_write<64, 72>(tile, MVT + (size_t)(b * 8 + hd) * 64 * LT, pos0);
        }
    }
    __syncthreads();
}

template <int MODE>
DI void lru_unit(const Params& p, int u, char* smem) {
    const bf16_t* UG = (const bf16_t*)(p.x1 + (size_t)NT * 1536 * 2);
    bf16_t* CAT = (bf16_t*)p.x4;
    bf16_t* ys = (bf16_t*)smem;
    float* AB = (float*)(smem + 64 * 72 * 2);
    const int t = tid(), lane = t & 63, wave = t >> 6, l32 = lane & 31, h = lane >> 5;
    const int n = u & 7, ci = (u >> 3) % NCHUNK_T, b = (u >> 3) / NCHUNK_T;
    const int pos0 = ci * 64, r0 = b * LT + pos0;
    const int seq_lo = ci < 4 ? 0 : LC, seq_hi = ci < 4 ? LC : LT;
    {
        const int c = t & 63, tq = t >> 6, cg = n * 64 + c;
        const float w0 = p.in[11][cg], w1 = p.in[11][512 + cg], w2 = p.in[11][1024 + cg], w3 = p.in[11][1536 + cg], cb = p.in[12][cg];
        const int tp = pos0 + tq * 16;
        float uv[19];
#pragma unroll
        for (int i = 0; i < 19; ++i) { const int pos = tp - 2 + i; const int pc = pos < seq_lo ? seq_lo : (pos >= seq_hi ? seq_hi - 1 : pos);
            const float v = bf2f(UG[(size_t)(b * LT + pc) * 1024 + cg]); uv[i] = (pos >= seq_lo && pos < seq_hi) ? v : 0.f; }
#pragma unroll
        for (int tt = 0; tt < 16; ++tt) {
            const float y = cb + w0 * uv[tt] + w1 * uv[tt + 1] + w2 * uv[tt + 2] + w3 * uv[tt + 3];
            ys[(tq * 16 + tt) * 72 + c] = f2bf(y);
        }
    }
    __syncthreads();
    {
        const int d = wave >> 1, jh = wave & 1;
        f32x16 acc[2][2];
#pragma unroll
        for (int i = 0; i < 2; ++i)
#pragma unroll
            for (int j = 0; j < 2; ++j)
#pragma unroll
                for (int e = 0; e < 16; ++e) acc[i][j][e] = 0.f;
        const bf16_t* ap = ys + l32 * 72 + h * 8;
        const bf16_t* bp = p.lw + ((size_t)(((n * 2 + d) * 2 + jh) * 2) * 32 + l32) * 64 + h * 8;
#pragma unroll
        for (int ks = 0; ks < 4; ++ks) {
            const bf16x8 fa0 = *(const bf16x8*)(ap + ks * 16), fa1 = *(const bf16x8*)(ap + 32 * 72 + ks * 16);
            const bf16x8 fb0 = *(const bf16x8*)(bp + ks * 16), fb1 = *(const bf16x8*)(bp + 32 * 64 + ks * 16);
            acc[0][0] = MFMA32(fa0, fb0, acc[0][0]); acc[0][1] = MFMA32(fa0, fb1, acc[0][1]);
            acc[1][0] = MFMA32(fa1, fb0, acc[1][0]); acc[1][1] = MFMA32(fa1, fb1, acc[1][1]);
        }
        const int ch = jh * 32 + l32, cg = n * 64 + ch;
        const float ba = p.in[14][(d * 8 + n) * 64 + ch], bx = p.in[16][(d * 8 + n) * 64 + ch];
        const float lam = p.in[17][(d * 8 + n) * 64 + ch];
        const float sp = log1pf(expf(-lam));
        (void)cg;
#pragma unroll
        for (int mi = 0; mi < 2; ++mi)
#pragma unroll
            for (int i = 0; i < 16; ++i) {
                const int tm = mi * 32 + acc_row(i, h);
                AB[((d * 2 + 0) * 64 + tm) * 64 + ch] = acc[mi][0][i] + ba;
                AB[((d * 2 + 1) * 64 + tm) * 64 + ch] = acc[mi][1][i] + bx;
            }
#pragma unroll 2
        for (int e = 0; e < 32; ++e) {
            const int tm = (e >> 4) * 32 + acc_row(e & 15, h);
            float* pa = AB + ((d * 2 + 0) * 64 + tm) * 64 + ch;
            float* pb = AB + ((d * 2 + 1) * 64 + tm) * 64 + ch;
            const float r = sigm(*pa), ig = sigm(*pb);
            const float la = -8.f * r * sp;
            const float a = __builtin_amdgcn_exp2f(1.4426950408889634f * la);
            const float bb = __builtin_amdgcn_sqrtf(fmaxf(1.f - a * a, 0.f)) * ig * bf2f(ys[tm * 72 + ch]);
            *pa = a; *pb = bb;
        }
    }
    __syncthreads();
    if (t < 128) {
        const int d = t >> 6, c = t & 63, cg = n * 64 + c;
        const float* Aa = AB + (d * 2 + 0) * 4096 + c;
        float* Bb = AB + (d * 2 + 1) * 4096 + c;
        const size_t aidx = ((size_t)(b * NCHUNK_T + ci) * 2 + d) * 512 + cg;
        if (MODE == 1) {
            float hh = 0.f, P = 1.f;
#pragma unroll 4
            for (int s = 0; s < 64; ++s) { const int tt = d ? 63 - s : s; const float a = Aa[tt * 64]; hh = a * hh + Bb[tt * 64]; P *= a; }
            *(float2*)(p.agg + aidx * 2) = make_float2(P, hh);
        } else {
            float hh = p.carry[aidx];
#pragma unroll 4
            for (int s = 0; s < 64; ++s) { const int tt = d ? 63 - s : s; hh = Aa[tt * 64] * hh + Bb[tt * 64]; Bb[tt * 64] = hh; }
        }
    }
    __syncthreads();
    if (MODE == 3) {
        const int c = t & 63, tq = t >> 6, cg = n * 64 + c;
        float gv[16];
#pragma unroll
        for (int tt = 0; tt < 16; ++tt) gv[tt] = bf2f(UG[(size_t)(r0 + tq * 16 + tt) * 1024 + 512 + cg]);
#pragma unroll
        for (int tt = 0; tt < 16; ++tt) {
            const int tm = tq * 16 + tt;
            const float hs = AB[(1 * 64 + tm) * 64 + c] + AB[(3 * 64 + tm) * 64 + c];
            CAT[(size_t)(r0 + tm) * DM + 512 + cg] = f2bf(hs * gelu_tanh(gv[tt]));
        }
        __syncthreads();
    }
}
DI void lru_carry_unit(const Params& p, int v) {
    const int id = v * NTHR + tid();
    const int cg = id & 511, d = (id >> 9) & 1, b = id >> 10;
    float carry = 0.f;
    for (int s0 = 0; s0 < NCHUNK_T; s0 += 12) {
        float2 ag[12]; size_t ai[12];
#pragma unroll
        for (int j = 0; j < 12; ++j) {
            const int s = s0 + j;
            int ci;
            if (d == 0) ci = s; else ci = s < 4 ? 3 - s : NCHUNK_T - 1 - (s - 4);
            ai[j] = ((size_t)(b * NCHUNK_T + ci) * 2 + d) * 512 + cg;
            ag[j] = *(const float2*)(p.agg + ai[j] * 2);
        }
#pragma unroll
        for (int j = 0; j < 12; ++j) { p.carry[ai[j]] = carry; carry = ag[j].x * carry + ag[j].y; }
    }
}

DI float grp8_max(float v) { v = fmaxf(v, __shfl_xor(v, 1)); v = fmaxf(v, __shfl_xor(v, 2)); v = fmaxf(v, __shfl_xor(v, 4)); return v; }
constexpr int XP = 1032;
typedef float f32x4_t __attribute__((ext_vector_type(4)));
DI void norm2_router_unit(const Params& p, int layer, int r0, char* smem) {
    bf16_t* xh = (bf16_t*)smem;
    bf16_t* xl = xh + 16 * XP;
    float* lg = (float*)(xl + 16 * XP);
    float* ch = lg + 16 * 64;
    int* hist = (int*)(ch + 16 * 64);
    bf16_t* H2 = (bf16_t*)p.x4;
    const int t = tid(), lane = t & 63, wave = t >> 6;
    if (t < NSEGC) hist[t] = 0;
    const int l15 = lane & 15, q = lane >> 4;
    const bf16_t* bh = p.rwh + ((size_t)layer * 64 + wave * 16 + l15) * 1024 + q * 8;
    const bf16_t* bl = p.rwl + ((size_t)layer * 64 + wave * 16 + l15) * 1024 + q * 8;
    bf16x8 wA[8][2], wB[8][2];
#define RT_LOADW(w, k0) do { _Pragma("unroll") for (int i_ = 0; i_ < 8; ++i_) { w[i_][0] = *(const bf16x8*)(bh + ((k0) + i_) * 32); w[i_][1] = *(const bf16x8*)(bl + ((k0) + i_) * 32); } } while (0)
    RT_LOADW(wA, 0);
    {
        float4 v[4][4]; float ssv[4];
#pragma unroll
        for (int rr = 0; rr < 4; ++rr) {
            const float* src = res_row(p, r0 + wave * 4 + rr);
#pragma unroll
            for (int i = 0; i < 4; ++i) v[rr][i] = *(const float4*)(src + lane * 4 + 256 * i);
        }
#pragma unroll
        for (int rr = 0; rr < 4; ++rr) {
            float ss = 0.f;
#pragma unroll
            for (int i = 0; i < 4; ++i) ss += v[rr][i].x * v[rr][i].x + v[rr][i].y * v[rr][i].y + v[rr][i].z * v[rr][i].z + v[rr][i].w * v[rr][i].w;
            ssv[rr] = wave_sum(ss);
        }
#pragma unroll
        for (int rr = 0; rr < 4; ++rr) {
            const int lr = wave * 4 + rr, r = r0 + lr;
            const float* md = p.mod + (size_t)(layer * 5 + mod_row(r)) * 6144 + 3072;
            const float rinv = rsqrtf(ssv[rr] * (1.f / 1024.f) + EPSV);
#pragma unroll
            for (int i = 0; i < 4; ++i) {
                const int c = lane * 4 + 256 * i;
                const float4 sh = *(const float4*)(md + c), sc = *(const float4*)(md + 1024 + c);
                float4 o;
                o.x = v[rr][i].x * rinv * (1.f + sc.x) + sh.x; o.y = v[rr][i].y * rinv * (1.f + sc.y) + sh.y; o.z = v[rr][i].z * rinv * (1.f + sc.z) + sh.z; o.w = v[rr][i].w * rinv * (1.f + sc.w) + sh.w;
                uint2 ob; ob.x = pk_bf16(o.x, o.y); ob.y = pk_bf16(o.z, o.w);
                *(uint2*)(H2 + (size_t)r * DM + c) = ob;
                *(uint2*)(xh + lr * XP + c) = ob;
                uint2 ol; ol.x = pk_bf16(o.x - bflo(ob.x), o.y - bfhi(ob.x)); ol.y = pk_bf16(o.z - bflo(ob.y), o.w - bfhi(ob.y));
                *(uint2*)(xl + lr * XP + c) = ol;
            }
        }
    }
    __syncthreads();
    {
        const bf16_t* ah = xh + l15 * XP + q * 8;
        const bf16_t* al = xl + l15 * XP + q * 8;
        f32x4_t acc = {0.f, 0.f, 0.f, 0.f};
#define RT_MMA(w, k0) do { _Pragma("unroll") for (int i_ = 0; i_ < 8; ++i_) { \
            const bf16x8 fah = *(const bf16x8*)(ah + ((k0) + i_) * 32), fal = *(const bf16x8*)(al + ((k0) + i_) * 32); \
            acc = __builtin_amdgcn_mfma_f32_16x16x32_bf16(fah, w[i_][0], acc, 0, 0, 0); \
            acc = __builtin_amdgcn_mfma_f32_16x16x32_bf16(fah, w[i_][1], acc, 0, 0, 0); \
            acc = __builtin_amdgcn_mfma_f32_16x16x32_bf16(fal, w[i_][0], acc, 0, 0, 0); } } while (0)
        RT_LOADW(wB, 8);  RT_MMA(wA, 0);
        RT_LOADW(wA, 16); RT_MMA(wB, 8);
        RT_LOADW(wB, 24); RT_MMA(wA, 16);
        RT_MMA(wB, 24);
#undef RT_LOADW
#undef RT_MMA
        const int e = wave * 16 + l15;
        const float bias = p.in[27][layer * 64 + e];
#pragma unroll
        for (int j = 0; j < 4; ++j) { const float s = sigm(acc[j]); lg[(q * 4 + j) * 64 + e] = s; ch[(q * 4 + j) * 64 + e] = s + bias; }
    }
    __syncthreads();
    for (int rr = 0; rr < 4; ++rr) {
        const int lr = wave * 4 + rr, r = r0 + lr;
        const float c = ch[lr * 64 + lane], s = lg[lr * 64 + lane];
        const int g = lane >> 3;
        const float m1 = grp8_max(c);
        const unsigned long long bal = __ballot(c == m1);
        const int first = __ffs((unsigned)((bal >> (8 * g)) & 0xffull)) - 1;
        const float m2 = grp8_max(((lane & 7) == first) ? -3.0e38f : c);
        const float gsc = m1 + m2;
        int grank = 0;
#pragma unroll
        for (int gi = 0; gi < 8; ++gi) { const float o = __shfl(gsc, gi * 8); grank += (o > gsc || (o == gsc && gi < g)) ? 1 : 0; }
        const bool gsel = grank < 4;
        const float cand = gsel ? c : -3.0e38f;
        int erank = 0;
#pragma unroll 8
        for (int e2 = 0; e2 < 64; ++e2) { const float o = __shfl(cand, e2); erank += (o > cand || (o == cand && e2 < lane)) ? 1 : 0; }
        const bool sel = gsel && erank < 8;
        const float wsum = wave_sum(sel ? s : 0.f);
        if (sel) { p.tk_e[(size_t)r * 8 + erank] = lane; p.tk_w[(size_t)r * 8 + erank] = s * 2.5f / wsum; atomicAdd(&hist[lane], 1); }
        if (lane == 0) atomicAdd(&hist[64], 1);
    }
    __syncthreads();
    if (t < NSEGC && hist[t] > 0) atomicAdd(&p.cnt[(layer * 2 + 0) * NSEG + (r0 / p.chrows) * NSEGC + t], hist[t]);
    __syncthreads();
}
DI void phase_norm2_router(const Params& p, int layer, char* smem) {
    if (layer == 0) { for (int u = unit_first(); u < NT / 16; u += gridDim.x) norm2_router_unit(p, 0, u * 16, smem); }
    else { for (int u = unit_first(); u < NB * LX / 16; u += gridDim.x) norm2_router_unit(p, 1, (u / (LX / 16)) * LT + LC + (u % (LX / 16)) * 16, smem); }
}

DI void slots_unit(const Params& p, int layer, int r0, char* smem) {
    int* soff = (int*)smem;
    int* lcnt = soff + 272;
    int* lbase = lcnt + 80;
    const int t = tid();
    const int* cnt = p.cnt + (layer * 2 + 0) * NSEG;
    int* fill = p.cnt + (layer * 2 + 1) * NSEG;
    int* wsum = lbase + 80;
    {
        const int lane = t & 63, wave = t >> 6, sA = 2 * t, sB = 2 * t + 1;
        const int cA = sA < NSEG ? __hip_atomic_load(cnt + sA, __ATOMIC_RELAXED, __HIP_MEMORY_SCOPE_AGENT) : 0;
        const int cB = sB < NSEG ? __hip_atomic_load(cnt + sB, __ATOMIC_RELAXED, __HIP_MEMORY_SCOPE_AGENT) : 0;
        int ic = cA + cB;
#pragma unroll
        for (int o = 1; o < 64; o <<= 1) { const int vc = shfl_up_i(ic, o, lane); if (lane >= o) ic += vc; }
        if (lane == 63) wsum[wave] = ic;
        if (t < NSEGC) lcnt[t] = 0;
        __syncthreads();
        int oc = 0;
#pragma unroll
        for (int w = 0; w < 4; ++w) if (w < wave) oc += wsum[w];
        const int ex = oc + ic - cA - cB;
        if (sA <= NSEG) soff[sA] = ex;
        if (sB <= NSEG) soff[sB] = ex + cA;
    }
    __syncthreads();
    const int r = r0 + t, cbase = (r0 / p.chrows) * NSEGC;
    int e[9], loc[9]; float w[9];
#pragma unroll
    for (int k = 0; k < 8; ++k) { e[k] = p.tk_e[(size_t)r * 8 + k]; w[k] = p.tk_w[(size_t)r * 8 + k]; }
    e[8] = 64; w[8] = 1.f;
#pragma unroll
    for (int k = 0; k < 9; ++k) loc[k] = atomicAdd(&lcnt[e[k]], 1);
    __syncthreads();
    if (t < NSEGC) lbase[t] = lcnt[t] > 0 ? atomicAdd(&fill[cbase + t], lcnt[t]) : 0;
    __syncthreads();
#pragma unroll
    for (int k = 0; k < 9; ++k) {
        const int pos = soff[cbase + e[k]] + lbase[e[k]] + loc[k];
        p.ppos[(size_t)r * 16 + k] = pos; p.stok[pos] = r; p.sw[pos] = w[k];
    }
    __syncthreads();
}
DI void phase_slots(const Params& p, int layer, char* smem) {
    if (layer == 0) { for (int u = unit_first(); u < NT / 256; u += gridDim.x) slots_unit(p, 0, u * 256, smem); }
    else { for (int u = unit_first(); u < NB * LX / 256; u += gridDim.x) slots_unit(p, 1, (u / (LX / 256)) * LT + LC + (u % (LX / 256)) * 256, smem); }
}

constexpr int SEG_LDS_OFF = 68608;
DI void seg_tables(const Params& p, int layer, int s_lo, int s_hi, int* soff, int* toff) {
    const int* cnt = p.cnt + (layer * 2 + 0) * NSEG;
    int* wsum = toff + 272;
    const int t = tid(), lane = t & 63, wave = t >> 6;
    const int sA = 2 * t, sB = 2 * t + 1;
    const int cA = sA < NSEG ? __hip_atomic_load(cnt + sA, __ATOMIC_RELAXED, __HIP_MEMORY_SCOPE_AGENT) : 0;
    const int cB = sB < NSEG ? __hip_atomic_load(cnt + sB, __ATOMIC_RELAXED, __HIP_MEMORY_SCOPE_AGENT) : 0;
    const int tA = (sA >= s_lo && sA < s_hi) ? (cA + 127) >> 7 : 0, tB = (sB >= s_lo && sB < s_hi) ? (cB + 127) >> 7 : 0;
    int ic = cA + cB, it = tA + tB;
#pragma unroll
    for (int o = 1; o < 64; o <<= 1) { const int vc = shfl_up_i(ic, o, lane), vt = shfl_up_i(it, o, lane); if (lane >= o) { ic += vc; it += vt; } }
    if (lane == 63) { wsum[wave * 2] = ic; wsum[wave * 2 + 1] = it; }
    __syncthreads();
    int oc = 0, ot = 0;
#pragma unroll
    for (int w = 0; w < 4; ++w) if (w < wave) { oc += wsum[w * 2]; ot += wsum[w * 2 + 1]; }
    const int exA_c = oc + ic - cA - cB, exA_t = ot + it - tA - tB;
    if (sA >= s_lo && sA < s_hi) { soff[sA - s_lo] = exA_c; toff[sA - s_lo] = exA_t; }
    if (sB >= s_lo && sB < s_hi) { soff[sB - s_lo] = exA_c + cA; toff[sB - s_lo] = exA_t + tA; }
    if (sA + 1 == s_hi) { soff[s_hi - s_lo] = exA_c + cA; toff[s_hi - s_lo] = exA_t + tA; }
    if (sB + 1 == s_hi) { soff[s_hi - s_lo] = exA_c + cA + cB; toff[s_hi - s_lo] = exA_t + tA + tB; }
    __syncthreads();
}
DI int seg_find(const int* toff, int nseg, int tile) {
    int lo = 0, hi = nseg;
    while (hi - lo > 1) { const int mid = (lo + hi) >> 1; if (toff[mid] <= tile) lo = mid; else hi = mid; }
    return lo;
}
struct EpiGateUp {
    bf16_t* HID; const float* sw; int pos_end;
    DI void operator()(const float* ct, int row0, int col0) const {
#pragma unroll 2
        for (int it = 0; it < 4; ++it) {
            const int idx = tid() + NTHR * it, row = idx >> 3, wn = (idx >> 2) & 1, j0 = (idx & 3) * 8, pos = row0 + row;
            if (pos < pos_end) {
                const float* gp = ct + row * CT_LD + wn * 64 + j0;
                const float w = sw[pos];
                float o[8];
#pragma unroll
                for (int j = 0; j < 8; ++j) o[j] = silu_f(gp[j]) * gp[32 + j] * w;
                uint4 ov; ov.x = pk_bf16(o[0], o[1]); ov.y = pk_bf16(o[2], o[3]); ov.z = pk_bf16(o[4], o[5]); ov.w = pk_bf16(o[6], o[7]);
                *(uint4*)(HID + (size_t)pos * FF + ((col0 >> 6) + wn) * 32 + j0) = ov;
            }
        }
    }
};
struct EpiRowsBf16 {
    bf16_t* O; int ld; int rbase; int row_end;
    DI void operator()(const float* ct, int row0, int col0) const {
#pragma unroll 2
        for (int it = 0; it < 8; ++it) {
            const int idx = tid() + NTHR * it, row = idx >> 4, c8 = (idx & 15) * 8;
            if (row0 + row < row_end) *(uint4*)(O + (size_t)(row0 + row - rbase) * ld + col0 + c8) = pack8(ct + row * CT_LD + c8);
        }
    }
};
DI void phase_moe_gemm1(const Params& p, int layer, char* smem) {
    int* soff = (int*)(smem + SEG_LDS_OFF); int* toff = soff + 272;
    seg_tables(p, layer, 0, NSEG, soff, toff);
    const int ntiles = toff[NSEG];
    const bf16_t* H2 = (const bf16_t*)p.x4;
    bf16_t* HID = (bf16_t*)p.x1;
    auto unit_fn = [&](int u, int srow, int wave, int lane) {
        const int tile = u >> 1, nt = u & 1;
        const int s = seg_find(toff, NSEG, tile), e = s % NSEGC;
        const int pos0 = soff[s] + (tile - toff[s]) * 128, pos_end = soff[s + 1];
        int p0 = pos0 + srow, p1 = p0 + 32, p2 = p0 + 64, p3 = p0 + 96;
        if (p0 >= pos_end) p0 = pos_end - 1;
        if (p1 >= pos_end) p1 = pos_end - 1;
        if (p2 >= pos_end) p2 = pos_end - 1;
        if (p3 >= pos_end) p3 = pos_end - 1;
        const int t0 = p.stok[p0], t1 = p.stok[p1], t2 = p.stok[p2], t3 = p.stok[p3];
        const bf16_t* bw = p.ew1 + ((size_t)e * 512 + nt * 256 + wave * 64) * 1024 + lane * 8;
        return GUnit<WEpiGateUp>{H2 + (size_t)t0 * DM, H2 + (size_t)t1 * DM, H2 + (size_t)t2 * DM, H2 + (size_t)t3 * DM, bw, pos0, nt * 256, 1024, WEpiGateUp{HID, p.sw, pos_end}};
    };
    gemm_stream_w<WEpiGateUp>(ntiles * 2, unit_fn, smem, (const char*)p.bar);
}
DI void phase_moe_gemm2(const Params& p, int layer, int chunk, char* smem) {
    int* soff = (int*)(smem + SEG_LDS_OFF); int* toff = soff + 272;
    seg_tables(p, layer, chunk * NSEGC, (chunk + 1) * NSEGC, soff, toff);
    const int ntiles = toff[NSEGC];
    const bf16_t* HID = (const bf16_t*)p.x1;
    unsigned char* YP = (unsigned char*)p.x2;
    const int cbase = soff[0];
    auto unit_fn = [&](int u, int srow, int wave, int lane) {
        const int tile = u >> 2, nt = u & 3;
        const int e = seg_find(toff, NSEGC, tile);
        const int pos0 = soff[e] + (tile - toff[e]) * 128, pos_end = soff[e + 1];
        int p0 = pos0 + srow, p1 = p0 + 32, p2 = p0 + 64, p3 = p0 + 96;
        if (p0 >= pos_end) p0 = pos_end - 1;
        if (p1 >= pos_end) p1 = pos_end - 1;
        if (p2 >= pos_end) p2 = pos_end - 1;
        if (p3 >= pos_end) p3 = pos_end - 1;
        const bf16_t* bw = p.ew2 + ((size_t)e * 1024 + nt * 256 + wave * 64) * 256 + lane * 8;
        return GUnit<WEpiRows8>{HID + (size_t)p0 * FF, HID + (size_t)p1 * FF, HID + (size_t)p2 * FF, HID + (size_t)p3 * FF, bw, pos0, nt * 256, 256, WEpiRows8{YP, cbase, pos_end}};
    };
    gemm_stream_w<WEpiRows8>(ntiles * 4, unit_fn, smem, (const char*)p.bar);
}
DI void phase_moe_combine(const Params& p, int layer, int chunk, char* smem) {
    int* soff = (int*)(smem + SEG_LDS_OFF); int* toff = soff + 272;
    seg_tables(p, layer, chunk * NSEGC, (chunk + 1) * NSEGC, soff, toff);
    const int cbase = soff[0];
    const unsigned char* YP = (const unsigned char*)p.x2;
    const int lane = tid() & 63, wave = tid() >> 6;
    const int rbeg = chunk * p.chrows;
    for (int u = unit_first(); u < p.chrows / 4; u += gridDim.x) {
        const int r = rbeg + u * 4 + wave;
        if (layer == 1 && (r % LT) < LC) continue;
        float* rp = res_row(p, r);
        const float* g2 = p.mod + (size_t)(layer * 5 + mod_row(r)) * 6144 + 5120;
        const int4 pp0 = *(const int4*)(p.ppos + (size_t)r * 16), pp1 = *(const int4*)(p.ppos + (size_t)r * 16 + 4);
        const int pp8 = p.ppos[(size_t)r * 16 + 8];
        const int ppv[9] = {pp0.x, pp0.y, pp0.z, pp0.w, pp1.x, pp1.y, pp1.z, pp1.w, pp8};
        uint4 yw[9];
#pragma unroll
        for (int k = 0; k < 9; ++k) yw[k] = *(const uint4*)(YP + (size_t)(ppv[k] - cbase) * DM + lane * 16);
        const int c0 = lane * 16;
        float4 gv[4], xv[4];
#pragma unroll
        for (int i = 0; i < 4; ++i) { gv[i] = *(const float4*)(g2 + c0 + 4 * i); xv[i] = *(const float4*)(rp + c0 + 4 * i); }
        float a[16];
#pragma unroll
        for (int j = 0; j < 16; ++j) a[j] = 0.f;
#pragma unroll
        for (int k = 0; k < 9; ++k) {
            const int dw[4] = {(int)yw[k].x, (int)yw[k].y, (int)yw[k].z, (int)yw[k].w};
#pragma unroll
            for (int d = 0; d < 4; ++d) {
                const f32x2_t lo = __builtin_amdgcn_cvt_pk_f32_fp8(dw[d], false), hi = __builtin_amdgcn_cvt_pk_f32_fp8(dw[d], true);
                a[4 * d] += lo[0]; a[4 * d + 1] += lo[1]; a[4 * d + 2] += hi[0]; a[4 * d + 3] += hi[1];
            }
        }
        constexpr float UNS = 1.f / YP_SCALE;
        float ss = 0.f;
#pragma unroll
        for (int i = 0; i < 4; ++i) {
            a[4 * i] = xv[i].x + gv[i].x * UNS * a[4 * i]; a[4 * i + 1] = xv[i].y + gv[i].y * UNS * a[4 * i + 1];
            a[4 * i + 2] = xv[i].z + gv[i].z * UNS * a[4 * i + 2]; a[4 * i + 3] = xv[i].w + gv[i].w * UNS * a[4 * i + 3];
            ss += a[4 * i] * a[4 * i] + a[4 * i + 1] * a[4 * i + 1] + a[4 * i + 2] * a[4 * i + 2] + a[4 * i + 3] * a[4 * i + 3];
        }
        ss = wave_sum(ss);
        const float rinv = rsqrtf(ss * (1.f / 1024.f) + EPSV);
        if (layer == 0) {
            const float* md1 = p.mod + (size_t)(5 + mod_row(r)) * 6144;
            unsigned ob[8];
#pragma unroll
            for (int i = 0; i < 4; ++i) {
                *(float4*)(rp + c0 + 4 * i) = make_float4(a[4 * i], a[4 * i + 1], a[4 * i + 2], a[4 * i + 3]);
                const float4 sh = *(const float4*)(md1 + c0 + 4 * i), sc = *(const float4*)(md1 + 1024 + c0 + 4 * i);
                ob[2 * i] = pk_bf16(a[4 * i] * rinv * (1.f + sc.x) + sh.x, a[4 * i + 1] * rinv * (1.f + sc.y) + sh.y);
                ob[2 * i + 1] = pk_bf16(a[4 * i + 2] * rinv * (1.f + sc.z) + sh.z, a[4 * i + 3] * rinv * (1.f + sc.w) + sh.w);
            }
            *(uint4*)(p.h1 + (size_t)r * DM + c0) = make_uint4(ob[0], ob[1], ob[2], ob[3]);
            *(uint4*)(p.h1 + (size_t)r * DM + c0 + 8) = make_uint4(ob[4], ob[5], ob[6], ob[7]);
        } else {
#pragma unroll
            for (int i = 0; i < 4; ++i) {
                const float4 f = *(const float4*)(p.in[34] + c0 + 4 * i);
                *(float4*)(rp + c0 + 4 * i) = make_float4(a[4 * i] * rinv * f.x, a[4 * i + 1] * rinv * f.y, a[4 * i + 2] * rinv * f.z, a[4 * i + 3] * rinv * f.w);
            }
        }
    }
}

DI bool bg_first() { return (((blockIdx.x >> 3) + (blockIdx.x >> 8)) & 1u) == 0u; }
DI void bg_cvt_experts(const Params& p, int layer, char* smem) {
    for (int u = unit_first(); u < CVT_EXP_TILES; u += gridDim.x) cvt_expert(p, layer, u, smem);
    __syncthreads();
}
constexpr int N_PHASES = 22;
template <int PH, int NCHT>
DI void run_phase(const Params& p, char* smem, const XcdBarrier& bar) {
    if constexpr (PH == 0) phase_prologue(p, smem);
    else if constexpr (PH == 1) phase_norm1(p, 0);
    else if constexpr (PH == 2) {
        WEpiInProj0 epi{&p};
        gemm_phase_w((const char*)p.bar, (const bf16_t*)p.x4, DM, p.w_in0, 1024, NT / 128, AB_IN / 256, smem, epi, RowIdent{});
    } else if constexpr (PH == 3) {
        for (int u = unit_first(); u < NB * NCHUNK_T * 8; u += gridDim.x) lru_unit<1>(p, u, smem);
    } else if constexpr (PH == 4) {
        const bool bf = bg_first();
        if (bf) bg_cvt_experts(p, 0, smem);
        for (int u = unit_first(); u < 16 + NB * 4 * 64 + NB * 4 * 2; u += gridDim.x) { if (u < 16) lru_carry_unit(p, u); else attn0_unit(p, u - 16, smem); }
        if (!bf) { __syncthreads(); bg_cvt_experts(p, 0, smem); }
    } else if constexpr (PH == 5) {
        for (int u = unit_first(); u < NB * NCHUNK_T * 8; u += gridDim.x) lru_unit<3>(p, u, smem);
    } else if constexpr (PH == 6) {
        WEpiResidual epi{&p, 0};
        gemm_phase_w((const char*)p.bar, (const bf16_t*)p.x4, DM, p.w_out0, 1024, NT / 128, 4, smem, epi, RowIdent{});
    } else if constexpr (PH == 7) phase_norm2_router(p, 0, smem);
    else if constexpr (PH == 8) phase_slots(p, 0, smem);
    else if constexpr (PH == 9) phase_moe_gemm1(p, 0, smem);
    else if constexpr (PH == 10) {
        phase_moe_gemm2(p, 0, 0, smem); xcd_barrier(bar); phase_moe_combine(p, 0, 0, smem); xcd_barrier(bar);
        phase_moe_gemm2(p, 0, 1, smem); xcd_barrier(bar); phase_moe_combine(p, 0, 1, smem);
        if constexpr (NCHT >= 3) {
            xcd_barrier(bar);
            phase_moe_gemm2(p, 0, 2, smem); xcd_barrier(bar); phase_moe_combine(p, 0, 2, smem);
        }
        if constexpr (NCHT == 4) {
            xcd_barrier(bar);
            phase_moe_gemm2(p, 0, 3, smem); xcd_barrier(bar); phase_moe_combine(p, 0, 3, smem);
        }
    } else if constexpr (PH == 11) {   }
    else if constexpr (PH == 12) {
        WEpiSplit epi{(bf16_t*)p.x1, CD_INP, (bf16_t*)p.x1, CD_INP, 1 << 30, 1 << 30};
        gemm_phase_w((const char*)p.bar, p.h1, DM, p.w_in1, 1024, NT / 128, CD_INP / 256, smem, epi, RowIdent{});
    } else if constexpr (PH == 13) {
        for (int u = unit_first(); u < NT / 64; u += gridDim.x) postproj1a_unit(p, u, smem);
    } else if constexpr (PH == 14) {
        bf16_t* CQn = (bf16_t*)(p.x1 + (size_t)NT * CD_INP * 2);
        bf16_t* CKVn = CQn + (size_t)NT * 256;
        bf16_t* MQraw = (bf16_t*)p.x1;
        bf16_t* MKVraw = MQraw + (size_t)NT * 384;
        auto unit_fn = [&](int u, int srow, int wave, int lane) {
            if (u < (NT / 128) * 2) {
                const int mt = u >> 1, nt = u & 1, row0 = mt * 128;
                const bf16_t* ap = CQn + (size_t)(row0 + srow) * 256;
                const bf16_t* bw = p.w_uq + (size_t)(nt * 256 + wave * 64) * 256 + lane * 8;
                return GUnit<WEpiSplit>{ap, ap + (size_t)32 * 256, ap + (size_t)64 * 256, ap + (size_t)96 * 256, bw, row0, nt * 256, 256, WEpiSplit{MQraw, 384, MQraw, 384, 1 << 30, 384}};
            }
            const int v = u - (NT / 128) * 2, mt = v / 3, nt = v - mt * 3, row0 = mt * 128;
            const bf16_t* ap = CKVn + (size_t)(row0 + srow) * 128;
            const bf16_t* bw = p.w_ukv + (size_t)(nt * 256 + wave * 64) * 128 + lane * 8;
            return GUnit<WEpiSplit>{ap, ap + (size_t)32 * 128, ap + (size_t)64 * 128, ap + (size_t)96 * 128, bw, row0, nt * 256, 128, WEpiSplit{MKVraw, 768, MKVraw, 768, 1 << 30, 768}};
        };
        gemm_stream_w<WEpiSplit>((NT / 128) * 5, unit_fn, smem, (const char*)p.bar);
    } else if constexpr (PH == 15) {
        for (int u = unit_first(); u < NT / 64; u += gridDim.x) postproj1c_unit(p, u, smem);
    } else if constexpr (PH == 16) {
        const bool bf = bg_first();
        if (bf) bg_cvt_experts(p, 1, smem);
        for (int u = unit_first(); u < 4096; u += gridDim.x) attn1_unit(p, u, smem);
        if (!bf) { __syncthreads(); bg_cvt_experts(p, 1, smem); }
    } else if constexpr (PH == 17) {
        WEpiResidual epi{&p, 1};
        gemm_phase_w((const char*)p.bar, (const bf16_t*)p.x4, DM, p.w_out1, 1024, NB * 64, 4, smem, epi, RowLatent{});
    } else if constexpr (PH == 18) phase_norm2_router(p, 1, smem);
    else if constexpr (PH == 19) phase_slots(p, 1, smem);
    else if constexpr (PH == 20) phase_moe_gemm1(p, 1, smem);
    else if constexpr (PH == 21) {
        phase_moe_gemm2(p, 1, 0, smem); xcd_barrier(bar); phase_moe_combine(p, 1, 0, smem); xcd_barrier(bar);
        phase_moe_gemm2(p, 1, 1, smem); xcd_barrier(bar); phase_moe_combine(p, 1, 1, smem);
        if constexpr (NCHT >= 3) {
            xcd_barrier(bar);
            phase_moe_gemm2(p, 1, 2, smem); xcd_barrier(bar); phase_moe_combine(p, 1, 2, smem);
        }
        if constexpr (NCHT == 4) {
            xcd_barrier(bar);
            phase_moe_gemm2(p, 1, 3, smem); xcd_barrier(bar); phase_moe_combine(p, 1, 3, smem);
        }
    }
}

extern __shared__ __attribute__((aligned(16))) char dyn_smem[];

template <int PH, int HI, int NCHT>
DI void run_range(const Params& p, char* smem, const XcdBarrier& bar) {
    if constexpr (PH < HI) {
        run_phase<PH, NCHT>(p, smem, bar);
        if constexpr ((MK_REPEAT_MASK >> PH) & 1ull) { __syncthreads(); run_phase<PH, NCHT>(p, smem, bar); }
        if constexpr (PH + 1 < HI) { if constexpr (PH != 11) xcd_barrier(bar); run_range<PH + 1, HI, NCHT>(p, smem, bar); }
    }
}

template <int LO, int HI, int NCHT>
__global__ void __launch_bounds__(NTHR, 2) __attribute__((amdgpu_waves_per_eu(2, 2))) mk_kernel(Params p) {
    char* smem = dyn_smem + SM_OFF;
    if (threadIdx.x == 0) *(uint4*)dyn_smem = make_uint4(0u, 0u, 0u, 0u);
    __syncthreads();
    XcdBarrier bar = xcd_barrier_post(p.bar, (volatile LAS unsigned*)dyn_smem);
    run_range<LO, HI, NCHT>(p, smem, bar);
}

static size_t align_up(size_t x, size_t a) { return (x + a - 1) / a * a; }

extern "C" void kernel_launch(void* const* d_in, const int* in_sizes, int n_in, void* d_out, int out_size, void* d_ws, size_t ws_size, hipStream_t stream) {
    (void)in_sizes; (void)n_in; (void)out_size; (void)ws_size;
    Params p;
    memset(&p, 0, sizeof(p));
    for (int i = 0; i < 35; ++i) p.in[i] = (const float*)d_in[i];
    p.out = (float*)d_out;
    char* ws = (char*)d_ws;
    size_t off = 0;
    auto take = [&](size_t bytes) { char* r = ws + off; off = align_up(off + bytes, 256); return r; };
    const size_t zero_bytes = 16384 + 8192;
    p.bar = (unsigned*)take(16384);
    p.cnt = (int*)take(8192);
    p.kmax = (unsigned*)(p.cnt + 1536);
    p.mod = (float*)take((size_t)2 * 5 * 6144 * 4);
    p.tab = (float*)take((size_t)TB_TOTAL * 4);
    p.lamv = (float*)take(256);
    p.w_in0 = (bf16_t*)take((size_t)2560 * 1024 * 2);
    p.w_out0 = (bf16_t*)take((size_t)1024 * 1024 * 2);
    p.w_in1 = (bf16_t*)take((size_t)1280 * 1024 * 2);
    p.w_out1 = (bf16_t*)take((size_t)1024 * 1024 * 2);
    p.w_uq = (bf16_t*)take((size_t)512 * 256 * 2);
    p.w_ukv = (bf16_t*)take((size_t)768 * 128 * 2);
    p.lw = (bf16_t*)take((size_t)64 * 32 * 64 * 2);
    p.rwh = (bf16_t*)take((size_t)2 * 64 * 1024 * 2);
    p.rwl = (bf16_t*)take((size_t)2 * 64 * 1024 * 2);
    p.ew1 = (bf16_t*)take((size_t)65 * 512 * 1024 * 2);
    p.ew2 = (bf16_t*)take((size_t)65 * 1024 * 256 * 2);
    p.rc = (float*)take((size_t)NB * LC * DM * 4);
    p.tk_e = (int*)take((size_t)NT * 8 * 4);
    p.tk_w = (float*)take((size_t)NT * 8 * 4);
    p.ppos = (int*)take((size_t)NT * 16 * 4);
    p.stok = (int*)take((size_t)NPAIR * 4);
    p.sw = (float*)take((size_t)NPAIR * 4);
    p.agg = (float*)take((size_t)NB * NCHUNK_T * 2 * 512 * 2 * 4);
    p.carry = (float*)take((size_t)NB * NCHUNK_T * 2 * 512 * 4);
    p.x1 = take((size_t)NT * 2560 * 2);
    p.x2 = take((size_t)NB * LT * 2048 * 2);
    p.x4 = take((size_t)NT * DM * 2);
    p.h1 = (bf16_t*)take((size_t)NT * DM * 2);
    p.nch = 2;
    p.chrows = NT / p.nch;
    static bool warned = false;
    if (off > ws_size && !warned) { fprintf(stderr, "workspace too small: need %zu have %zu\n", off, ws_size); warned = true; }

    (void)hipMemsetAsync(d_ws, 0, zero_bytes, stream);
    static int grid = 0;
    if (!grid) {
        int dev = 0, cus = 0, per_cu = 2;
        (void)hipGetDevice(&dev);
        (void)hipDeviceGetAttribute(&cus, hipDeviceAttributeMultiprocessorCount, dev);
        (void)hipFuncSetAttribute((const void*)mk_kernel<0, N_PHASES, 2>, hipFuncAttributeMaxDynamicSharedMemorySize, SMEM_BYTES);
        int q2 = 0, q4 = 0;
        q2 = 2;
        (void)hipOccupancyMaxActiveBlocksPerMultiprocessor(&q4, (const void*)mk_kernel<0, N_PHASES, 2>, NTHR, SMEM_BYTES);
        per_cu = q2 < q4 ? q2 : q4;
        if (per_cu > 2) per_cu = 2;
        if (per_cu < 1) per_cu = 1;
        grid = cus * per_cu;
    }
    hipLaunchKernelGGL((mk_kernel<0, N_PHASES, 2>), dim3(grid), dim3(NTHR), SMEM_BYTES, stream, p);
}
```

```cpp
#include <hip/hip_runtime.h>
#include <stdint.h>
#include <stdio.h>
#include <string.h>
#include <type_traits>

#ifndef MK_REPEAT_MASK
#define MK_REPEAT_MASK 0ull
#endif
#ifndef MK_FUSED
#define MK_FUSED 1
#endif

#define DI __device__ __forceinline__
typedef unsigned short bf16_t;
typedef short bf16x8 __attribute__((ext_vector_type(8)));
typedef float f32x16 __attribute__((ext_vector_type(16)));
typedef float f32x2_t __attribute__((ext_vector_type(2)));
typedef __bf16 bf16x2_t __attribute__((ext_vector_type(2)));

constexpr int NB = 4, LX = 8192, LC = 256, LT = LX + LC, NT = NB * LT, DM = 1024;
constexpr int AB_IN = 2560, CD_IN = 1168, CD_INP = 1280;
constexpr int NE = 64, FF = 256, NSEGC = 65, NCH = 4, NSEG = NSEGC * NCH;
constexpr int NPAIR = NT * 9;
constexpr int NCHUNK_T = LT / 64;
constexpr int NTHR = 256;
constexpr int SMEM_BYTES = 76800;
constexpr int SM_OFF = 64;
constexpr float EPSV = 1e-6f;
constexpr float LOG2E = 1.4426950408889634f;

#define XB_TMO      128
#define XB_XCNT(j)  (256  + 64 * (j))
#define XB_XSUB(j)  (1280 + 64 * (j))
#define XB_XGEN(j)  (2304 + 64 * (j))
#define XB_TOP      3328
#define XB_TOPGEN   3392
#define XCD_BAR_WORDS 3456
#define XB_SPIN_CAP (1u << 18)
#define LAS __attribute__((address_space(3)))

__device__ __forceinline__ unsigned xb_ld(unsigned* p)              { return __hip_atomic_load(p, __ATOMIC_RELAXED, __HIP_MEMORY_SCOPE_AGENT); }
__device__ __forceinline__ unsigned xb_add(unsigned* p, unsigned v) { return __hip_atomic_fetch_add(p, v, __ATOMIC_RELAXED, __HIP_MEMORY_SCOPE_AGENT); }
__device__ __forceinline__ unsigned xb_xcc_id() { return (unsigned)__builtin_amdgcn_s_getreg((3 << 11) | 20) & 0xFu; }
#define XB_SPIN(cond, bar) do { unsigned _sp = 0; while (cond) { __builtin_amdgcn_s_sleep(1); \
    if ((++_sp & 255u) == 0u) { if (xb_ld(&(bar)[XB_TMO])) break; if (_sp > XB_SPIN_CAP) { atomicAdd(&(bar)[XB_TMO], 1u); break; } } } } while (0)

struct XcdBarrier { unsigned* bar; unsigned x; volatile LAS unsigned* st; };

__device__ __forceinline__ XcdBarrier xcd_barrier_post(unsigned* bar, volatile LAS unsigned* st) {
    XcdBarrier b; b.bar = bar; b.x = xb_xcc_id(); b.st = st;
    if (threadIdx.x == 0) (void)xb_add(&bar[XB_XCNT(b.x)], 1u);
    return b;
}
__device__ __forceinline__ void xcd_barrier_complete(unsigned* bar, unsigned x, unsigned& nloc, unsigned& nx) {
    const unsigned G = gridDim.x * gridDim.y * gridDim.z;
    unsigned sum, cnt, mine, sp = 0u;
    for (;;) {
        sum = 0u; cnt = 0u; mine = 0u;
#pragma unroll
        for (unsigned j = 0; j < 16; ++j) { const unsigned c = xb_ld(&bar[XB_XCNT(j)]); sum += c; cnt += (c > 0u) ? 1u : 0u; mine = (j == x) ? c : mine; }
        if (sum == G) break;
        __builtin_amdgcn_s_sleep(1);
        if ((++sp & 255u) == 0u) { if (xb_ld(&bar[XB_TMO])) break; if (sp > XB_SPIN_CAP) { atomicAdd(&bar[XB_TMO], 1u); break; } }
    }
    nloc = mine > 0u ? mine : 1u; nx = cnt > 0u ? cnt : 1u;
}
__device__ __forceinline__ void xcd_barrier(const XcdBarrier& b) {
    asm volatile("s_waitcnt vmcnt(0)" ::: "memory");
    __syncthreads();
    if (threadIdx.x == 0) {
        unsigned* bar = b.bar;
        __builtin_amdgcn_s_waitcnt(0);
        unsigned nloc = b.st[0], nx = b.st[1];
        if (nloc == 0u) { xcd_barrier_complete(bar, b.x, nloc, nx); b.st[0] = nloc; b.st[1] = nx; }
        const unsigned old = xb_add(&bar[XB_XSUB(b.x)], 1u);
        const unsigned gen = old / nloc;
        if (old + 1u == (gen + 1u) * nloc) {
            __builtin_amdgcn_fence(__ATOMIC_RELEASE, "agent");
            asm volatile("s_waitcnt vmcnt(0)" ::: "memory");
            const unsigned og = xb_add(&bar[XB_TOP], 1u);
            const unsigned tg = og / nx;
            if (og + 1u == (tg + 1u) * nx) xb_add(&bar[XB_TOPGEN], 1u);
            else XB_SPIN(xb_ld(&bar[XB_TOPGEN]) == tg, bar);
            __builtin_amdgcn_fence(__ATOMIC_ACQUIRE, "agent");
            xb_add(&bar[XB_XGEN(b.x)], 1u);
            asm volatile("s_waitcnt vmcnt(0)" ::: "memory");
        } else {
            XB_SPIN(xb_ld(&bar[XB_XGEN(b.x)]) == gen, bar);
            __builtin_amdgcn_fence(__ATOMIC_ACQUIRE, "agent");
            asm volatile("s_waitcnt vmcnt(0)" ::: "memory");
        }
    }
    __syncthreads();
}

struct Params {
    const float* in[35];
    float* out;
    unsigned* bar;
    int* cnt;
    unsigned* kmax;
    float* mod;
    float* tab;
    float* lamv;
    bf16_t* w_in0;
    bf16_t* w_out0;
    bf16_t* w_in1;
    bf16_t* w_out1;
    bf16_t* w_uq;
    bf16_t* w_ukv;
    bf16_t* lw;
    bf16_t* rwh;
    bf16_t* rwl;
    bf16_t* ew1;
    bf16_t* ew2;
    float* rc;
    int* tk_e;
    float* tk_w;
    int* ppos;
    int* stok;
    float* sw;
    float* agg;
    float* carry;
    char* x1;
    char* x2;
    char* x4;
    bf16_t* h1;
    int nch;
    int chrows;
};

constexpr int TB_CR = 0, TB_SR = 2048, TB_CC = 4096, TB_SC = 5120, TB_CR4 = 6144, TB_SR4 = 6656, TB_CC4 = 7168, TB_SC4 = 7424, TB_TOTAL = 7680;

DI int unit_first() { return (int)((blockIdx.x & 7u) * (gridDim.x >> 3) + (blockIdx.x >> 3)); }
DI int tid() { int t = threadIdx.x; asm volatile("" : "+v"(t)); return t; }
DI unsigned pk_bf16(float a, float b) { f32x2_t v = {a, b}; bf16x2_t r = __builtin_convertvector(v, bf16x2_t); return __builtin_bit_cast(unsigned, r); }
DI bf16_t f2bf(float a) { return (bf16_t)(pk_bf16(a, 0.f) & 0xffffu); }
DI float bf2f(bf16_t v) { return __uint_as_float(((unsigned)v) << 16); }
DI float bflo(unsigned u) { return __uint_as_float(u << 16); }
DI float bfhi(unsigned u) { return __uint_as_float(u & 0xffff0000u); }
DI float sigm(float x) { return __builtin_amdgcn_rcpf(1.f + __builtin_amdgcn_exp2f(-1.4426950408889634f * x)); }
DI float silu_f(float x) { return x * sigm(x); }
DI float gelu_tanh(float x) { const float u = 0.7978845608028654f * (x + 0.044715f * x * x * x); return x * sigm(2.f * u); }
DI float wave_sum(float v) {
    const int l = tid() & 63;
#pragma unroll
    for (int o = 32; o > 0; o >>= 1) v += __int_as_float(__builtin_amdgcn_ds_bpermute((l ^ o) << 2, __float_as_int(v)));
    return v;
}
DI int shfl_up_i(int v, int o, int l) { return __builtin_amdgcn_ds_bpermute((l >= o ? l - o : l) << 2, v); }
DI float half_max(float x) { auto r = __builtin_amdgcn_permlane32_swap(__float_as_uint(x), __float_as_uint(x), false, false); return fmaxf(__uint_as_float(r[0]), __uint_as_float(r[1])); }
DI float half_sum(float x) { auto r = __builtin_amdgcn_permlane32_swap(__float_as_uint(x), __float_as_uint(x), false, false); return __uint_as_float(r[0]) + __uint_as_float(r[1]); }
#define MFMA32(a, b, c) __builtin_amdgcn_mfma_f32_32x32x16_bf16((a), (b), (c), 0, 0, 0)
DI int acc_row(int i, int h) { return (i & 3) + 8 * (i >> 2) + 4 * h; }

DI float* res_row(const Params& p, int r) {
    const int b = r / LT, pos = r - b * LT;
    return pos < LC ? p.rc + (size_t)(b * LC + pos) * DM : p.out + (size_t)(b * LX + pos - LC) * DM;
}
DI const float* in_row(const Params& p, int r) {
    const int b = r / LT, pos = r - b * LT;
    return pos < LC ? p.in[2] + (size_t)(b * LC + pos) * DM : p.in[0] + (size_t)(b * LX + pos - LC) * DM;
}
DI int mod_row(int r) { const int b = r / LT, pos = r - b * LT; return pos < LC ? 4 : b; }

DI void mod_gemv_unit(const Params& p, int u, char* smem) {
    float* s = (float*)smem;
    float* red = s + 5 * 1024;
    const int t = tid();
    for (int i = t; i < 5 * 1024; i += NTHR) { const int m = i >> 10, k = i & 1023; const float v = (m < 4) ? p.in[1][m * 1024 + k] : p.in[3][k]; s[i] = silu_f(v); }
    __syncthreads();
    const int layer = u / 96, n0 = (u % 96) * 64, col = t & 63, kg = t >> 6;
    const float* w = p.in[4] + (size_t)layer * 1024 * 6144 + n0 + col;
    float a0 = 0.f, a1 = 0.f, a2 = 0.f, a3 = 0.f, a4 = 0.f;
    for (int k0 = kg * 256; k0 < kg * 256 + 256; k0 += 16) {
        float wv[16];
#pragma unroll
        for (int j = 0; j < 16; ++j) wv[j] = w[(size_t)(k0 + j) * 6144];
#pragma unroll
        for (int j = 0; j < 16; ++j) { const int k = k0 + j;
            a0 += s[k] * wv[j]; a1 += s[1024 + k] * wv[j]; a2 += s[2048 + k] * wv[j]; a3 += s[3072 + k] * wv[j]; a4 += s[4096 + k] * wv[j]; }
    }
    red[(kg * 5 + 0) * 64 + col] = a0; red[(kg * 5 + 1) * 64 + col] = a1; red[(kg * 5 + 2) * 64 + col] = a2; red[(kg * 5 + 3) * 64 + col] = a3; red[(kg * 5 + 4) * 64 + col] = a4;
    __syncthreads();
    if (t < 64) {
        const float bias = p.in[5][layer * 6144 + n0 + t];
#pragma unroll
        for (int m = 0; m < 5; ++m) {
            const float v = red[(0 * 5 + m) * 64 + t] + red[(1 * 5 + m) * 64 + t] + red[(2 * 5 + m) * 64 + t] + red[(3 * 5 + m) * 64 + t] + bias;
            p.mod[(size_t)(layer * 5 + m) * 6144 + n0 + t] = v;
        }
    }
    __syncthreads();
}

DI void cvt_tile(const float* src, int ld_src, int k0, int n0, int nvalid, bf16_t* dst, int ld_dst, char* smem, bf16_t* dst_lo = nullptr, bool tiled = false) {
    float* s = (float*)smem;
    const int t = tid();
#pragma unroll
    for (int it = 0; it < 2; ++it) {
        const int idx = t + NTHR * it, k = idx >> 3, n4 = (idx & 7) * 4;
        const float* sp = src + (size_t)(k0 + k) * ld_src + n0 + n4;
        float v0 = 0.f, v1 = 0.f, v2 = 0.f, v3 = 0.f;
        if (n0 + n4 + 3 < nvalid) { const float4 v = *(const float4*)sp; v0 = v.x; v1 = v.y; v2 = v.z; v3 = v.w; }
        else { if (n0 + n4 + 0 < nvalid) v0 = sp[0]; if (n0 + n4 + 1 < nvalid) v1 = sp[1]; if (n0 + n4 + 2 < nvalid) v2 = sp[2]; if (n0 + n4 + 3 < nvalid) v3 = sp[3]; }
        s[k * 33 + n4 + 0] = v0; s[k * 33 + n4 + 1] = v1; s[k * 33 + n4 + 2] = v2; s[k * 33 + n4 + 3] = v3;
    }
    __syncthreads();
    {
        const int n = t >> 3, c = t & 7;
        uint4 o;
        o.x = pk_bf16(s[(c * 8 + 0) * 33 + n], s[(c * 8 + 1) * 33 + n]);
        o.y = pk_bf16(s[(c * 8 + 2) * 33 + n], s[(c * 8 + 3) * 33 + n]);
        o.z = pk_bf16(s[(c * 8 + 4) * 33 + n], s[(c * 8 + 5) * 33 + n]);
        o.w = pk_bf16(s[(c * 8 + 6) * 33 + n], s[(c * 8 + 7) * 33 + n]);
        if (tiled) *(uint4*)(dst + (size_t)((((k0 >> 4) + (c >> 1)) * 64 + (c & 1) * 32 + n) * 8)) = o;
        else *(uint4*)(dst + (size_t)n * ld_dst + k0 + c * 8) = o;
        if (dst_lo) {
            float r[8];
#pragma unroll
            for (int j = 0; j < 8; ++j) { const float w = s[(c * 8 + j) * 33 + n]; r[j] = w - bf2f(f2bf(w)); }
            uint4 o2; o2.x = pk_bf16(r[0], r[1]); o2.y = pk_bf16(r[2], r[3]); o2.z = pk_bf16(r[4], r[5]); o2.w = pk_bf16(r[6], r[7]);
            *(uint4*)(dst_lo + (size_t)n * ld_dst + k0 + c * 8) = o2;
        }
    }
    __syncthreads();
}

constexpr int CS0 = 1280, CS1 = CS0 + 512, CS2 = CS1 + 640, CS3 = CS2 + 512, CS4 = CS3 + 64, CS5 = CS4 + 48, CS6 = CS5 + 64, CS7 = CS6 + 64;
constexpr int CVT_SMALL_TILES = CS7;
DI void cvt_small(const Params& p, int u, char* smem) {
    if (u < CS0) { const int kt = u / 80, nt = u % 80; cvt_tile(p.in[6], AB_IN, kt * 64, nt * 32, AB_IN, p.w_in0 + (size_t)nt * 32 * 1024, 1024, smem, nullptr, true); }
    else if (u < CS1) { const int v = u - CS0, kt = v / 32, nt = v % 32; cvt_tile(p.in[7], 1024, kt * 64, nt * 32, 1024, p.w_out0 + (size_t)nt * 32 * 1024, 1024, smem, nullptr, true); }
    else if (u < CS2) { const int v = u - CS1, kt = v / 40, nt = v % 40; cvt_tile(p.in[18], CD_IN, kt * 64, nt * 32, CD_IN, p.w_in1 + (size_t)nt * 32 * 1024, 1024, smem, nullptr, true); }
    else if (u < CS3) { const int v = u - CS2, kt = v / 32, nt = v % 32; cvt_tile(p.in[19], 1024, kt * 64, nt * 32, 1024, p.w_out1 + (size_t)nt * 32 * 1024, 1024, smem, nullptr, true); }
    else if (u < CS4) { const int v = u - CS3, kt = v / 16, nt = v % 16; cvt_tile(p.in[24], 384, kt * 64, nt * 32, 384, p.w_uq + (size_t)nt * 32 * 256, 256, smem, nullptr, true); }
    else if (u < CS5) { const int v = u - CS4, kt = v / 24, nt = v % 24; cvt_tile(p.in[25], 768, kt * 64, nt * 32, 768, p.w_ukv + (size_t)nt * 32 * 128, 128, smem, nullptr, true); }
    else if (u < CS6) {
        const int v = u - CS5, gate = v & 1, jh = (v >> 1) & 1, d = (v >> 2) & 1, n = v >> 3;
        const float* src = (gate ? p.in[15] : p.in[13]) + (size_t)(d * 8 + n) * 64 * 64;
        cvt_tile(src, 64, 0, jh * 32, 64, p.lw + (size_t)v * 32 * 64, 64, smem);
    } else {
        const int v = u - CS6, layer = v >> 5, kt = (v >> 1) & 15, nt = v & 1;
        cvt_tile(p.in[26] + (size_t)layer * 1024 * 64, 64, kt * 64, nt * 32, 64, p.rwh + ((size_t)layer * 64 + nt * 32) * 1024, 1024, smem, p.rwl + ((size_t)layer * 64 + nt * 32) * 1024);
    }
}
constexpr int CVT_EXP_TILES = 3 * 8192 + 3 * 128;
DI void cvt_expert(const Params& p, int layer, int u, char* smem) {
    if (u < 16384) {
        const int up = u >= 8192, v = u & 8191, e = v >> 7, kt = (v >> 3) & 15, nt = v & 7;
        const float* src = (up ? p.in[29] : p.in[28]) + (size_t)(layer * NE + e) * 1024 * 256;
        cvt_tile(src, 256, kt * 64, nt * 32, 256, p.ew1 + ((size_t)e * 512 + nt * 64 + up * 32) * 1024, 1024, smem, nullptr, true);
    } else if (u < 24576) {
        const int v = u - 16384, e = v >> 7, kt = (v >> 5) & 3, nt = v & 31;
        const float* src = p.in[30] + (size_t)(layer * NE + e) * 256 * 1024;
        cvt_tile(src, 1024, kt * 64, nt * 32, 1024, p.ew2 + ((size_t)e * 1024 + nt * 32) * 256, 256, smem, nullptr, true);
    } else {
        const int v = u - 24576;
        if (v < 256) { const int up = v >= 128, w = v & 127, kt = w >> 3, nt = w & 7;
            const float* src = (up ? p.in[32] : p.in[31]) + (size_t)layer * 1024 * 256;
            cvt_tile(src, 256, kt * 64, nt * 32, 256, p.ew1 + ((size_t)NE * 512 + nt * 64 + up * 32) * 1024, 1024, smem, nullptr, true);
        } else { const int w = v - 256, kt = w >> 5, nt = w & 31;
            const float* src = p.in[33] + (size_t)layer * 256 * 1024;
            cvt_tile(src, 1024, kt * 64, nt * 32, 1024, p.ew2 + ((size_t)NE * 1024 + nt * 32) * 256, 256, smem, nullptr, true);
        }
    }
}
DI void tables_unit(const Params& p) {
    const int t = tid();
    for (int i = t; i < 128 * 16; i += NTHR) { const int pos = i >> 4, f = i & 15; const float ang = (float)pos * powf(10000.f, -(float)f / 16.f); float s, c; sincosf(ang, &s, &c); p.tab[TB_CR + i] = c; p.tab[TB_SR + i] = s; }
    for (int i = t; i < 64 * 16; i += NTHR) { const int pos = i >> 4, f = i & 15; const float ang = (float)pos * powf(10000.f, -(float)f / 16.f); float s, c; sincosf(ang, &s, &c); p.tab[TB_CC + i] = c; p.tab[TB_SC + i] = s; }
    for (int i = t; i < 128 * 4; i += NTHR) { const int pos = i >> 2, f = i & 3; const float ang = (float)pos * powf(10000.f, -(float)f / 4.f); float s, c; sincosf(ang, &s, &c); p.tab[TB_CR4 + i] = c; p.tab[TB_SR4 + i] = s; }
    for (int i = t; i < 64 * 4; i += NTHR) { const int pos = i >> 2, f = i & 3; const float ang = (float)pos * powf(10000.f, -(float)f / 4.f); float s, c; sincosf(ang, &s, &c); p.tab[TB_CC4 + i] = c; p.tab[TB_SC4 + i] = s; }
    if (t < 64) {
        const float s0 = wave_sum(p.in[8][t] * p.in[9][t]), s1 = wave_sum(p.in[8][64 + t] * p.in[9][64 + t]);
        if (t == 0) p.lamv[0] = expf(s0) - expf(s1) + 0.2f;
    }
}
DI void phase_prologue(const Params& p, char* smem) {
    const int n_units = 192 + 1 + CVT_SMALL_TILES;
    for (int u = unit_first(); u < n_units; u += gridDim.x) {
        if (u < 192) mod_gemv_unit(p, u, smem);
        else if (u == 192) tables_unit(p);
        else cvt_small(p, u - 193, smem);
    }
}

DI void phase_norm1(const Params& p, int layer) {
    const int lane = tid() & 63, wave = tid() >> 6;
    bf16_t* H = (bf16_t*)p.x4;
    for (int u = unit_first(); u < NT / 64; u += gridDim.x) {
        for (int rr = 0; rr < 16; rr += 4) {
            float4 v[4][4]; float ss[4];
#pragma unroll
            for (int q = 0; q < 4; ++q) {
                const int r = u * 64 + wave * 16 + rr + q;
                const float* src = layer == 0 ? in_row(p, r) : res_row(p, r);
#pragma unroll
                for (int i = 0; i < 4; ++i) v[q][i] = *(const float4*)(src + lane * 4 + 256 * i);
            }
#pragma unroll
            for (int q = 0; q < 4; ++q) {
                float s = 0.f;
#pragma unroll
                for (int i = 0; i < 4; ++i) s += v[q][i].x * v[q][i].x + v[q][i].y * v[q][i].y + v[q][i].z * v[q][i].z + v[q][i].w * v[q][i].w;
                ss[q] = wave_sum(s);
            }
#pragma unroll
            for (int q = 0; q < 4; ++q) {
                const int r = u * 64 + wave * 16 + rr + q;
                const float* md = p.mod + (size_t)(layer * 5 + mod_row(r)) * 6144;
                const float rinv = rsqrtf(ss[q] * (1.f / 1024.f) + EPSV);
#pragma unroll
                for (int i = 0; i < 4; ++i) {
                    const int c = lane * 4 + 256 * i;
                    const float4 sh = *(const float4*)(md + c), sc = *(const float4*)(md + 1024 + c);
                    uint2 o;
                    o.x = pk_bf16(v[q][i].x * rinv * (1.f + sc.x) + sh.x, v[q][i].y * rinv * (1.f + sc.y) + sh.y);
                    o.y = pk_bf16(v[q][i].z * rinv * (1.f + sc.z) + sh.z, v[q][i].w * rinv * (1.f + sc.w) + sh.w);
                    *(uint2*)(H + (size_t)r * DM + c) = o;
                }
            }
        }
    }
}

constexpr int LDT = 72;
constexpr int CT_LD = 132;
template <class Epi>
DI void gemm_tile(const bf16_t* a0, const bf16_t* a1, const bf16_t* a2, const bf16_t* a3,
                  const bf16_t* b0, const bf16_t* b1, const bf16_t* b2, const bf16_t* b3,
                  int K, char* smem, const Epi& epi, int row0, int col0) {
    bf16_t* As = (bf16_t*)smem;
    bf16_t* Bs = As + 2 * 128 * LDT;
    const int t = tid(), lane = t & 63, wave = t >> 6, wm = wave >> 1, wn = wave & 1, l32 = lane & 31, h = lane >> 5;
    const int srow = t >> 3, scol = (t & 7) * 8;
    uint4 ra0, ra1, ra2, ra3, rb0, rb1, rb2, rb3;
    ra0 = *(const uint4*)(a0 + scol); ra1 = *(const uint4*)(a1 + scol); ra2 = *(const uint4*)(a2 + scol); ra3 = *(const uint4*)(a3 + scol);
    rb0 = *(const uint4*)(b0 + scol); rb1 = *(const uint4*)(b1 + scol); rb2 = *(const uint4*)(b2 + scol); rb3 = *(const uint4*)(b3 + scol);
    {
        bf16_t* ad = As + srow * LDT + scol; bf16_t* bd = Bs + srow * LDT + scol;
        *(uint4*)(ad) = ra0; *(uint4*)(ad + 32 * LDT) = ra1; *(uint4*)(ad + 64 * LDT) = ra2; *(uint4*)(ad + 96 * LDT) = ra3;
        *(uint4*)(bd) = rb0; *(uint4*)(bd + 32 * LDT) = rb1; *(uint4*)(bd + 64 * LDT) = rb2; *(uint4*)(bd + 96 * LDT) = rb3;
    }
    __syncthreads();
    f32x16 acc[2][2];
#pragma unroll
    for (int i = 0; i < 2; ++i)
#pragma unroll
        for (int j = 0; j < 2; ++j)
#pragma unroll
            for (int e = 0; e < 16; ++e) acc[i][j][e] = 0.f;
    const int nk = K >> 6;
    for (int kt = 0; kt < nk; ++kt) {
        const int cur = kt & 1;
        const bool more = (kt + 1 < nk);
        if (more) {
            const int ko = (kt + 1) * 64 + scol;
            ra0 = *(const uint4*)(a0 + ko); ra1 = *(const uint4*)(a1 + ko); ra2 = *(const uint4*)(a2 + ko); ra3 = *(const uint4*)(a3 + ko);
            rb0 = *(const uint4*)(b0 + ko); rb1 = *(const uint4*)(b1 + ko); rb2 = *(const uint4*)(b2 + ko); rb3 = *(const uint4*)(b3 + ko);
        }
        __builtin_amdgcn_sched_barrier(0);
        const bf16_t* Ac = As + cur * 128 * LDT + (wm * 64 + l32) * LDT + h * 8;
        const bf16_t* Bc = Bs + cur * 128 * LDT + (wn * 64 + l32) * LDT + h * 8;
        bf16x8 fa0[4], fa1[4], fb0[4], fb1[4];
#pragma unroll
        for (int ks = 0; ks < 4; ++ks) {
            fa0[ks] = *(const bf16x8*)(Ac + ks * 16); fb0[ks] = *(const bf16x8*)(Bc + ks * 16);
            fa1[ks] = *(const bf16x8*)(Ac + 32 * LDT + ks * 16); fb1[ks] = *(const bf16x8*)(Bc + 32 * LDT + ks * 16);
        }
        __builtin_amdgcn_sched_barrier(0);
#pragma unroll
        for (int ks = 0; ks < 4; ++ks) {
            acc[0][0] = MFMA32(fa0[ks], fb0[ks], acc[0][0]); acc[0][1] = MFMA32(fa0[ks], fb1[ks], acc[0][1]);
            acc[1][0] = MFMA32(fa1[ks], fb0[ks], acc[1][0]); acc[1][1] = MFMA32(fa1[ks], fb1[ks], acc[1][1]);
        }
        __builtin_amdgcn_sched_barrier(0);
        if (more) {
            bf16_t* ad = As + (cur ^ 1) * 128 * LDT + srow * LDT + scol; bf16_t* bd = Bs + (cur ^ 1) * 128 * LDT + srow * LDT + scol;
            *(uint4*)(ad) = ra0; *(uint4*)(ad + 32 * LDT) = ra1; *(uint4*)(ad + 64 * LDT) = ra2; *(uint4*)(ad + 96 * LDT) = ra3;
            *(uint4*)(bd) = rb0; *(uint4*)(bd + 32 * LDT) = rb1; *(uint4*)(bd + 64 * LDT) = rb2; *(uint4*)(bd + 96 * LDT) = rb3;
        }
        __syncthreads();
    }
    {
        float* ct = (float*)smem;
#pragma unroll
        for (int mi = 0; mi < 2; ++mi)
#pragma unroll
            for (int ni = 0; ni < 2; ++ni)
#pragma unroll
                for (int i = 0; i < 16; ++i) ct[(wm * 64 + mi * 32 + acc_row(i, h)) * CT_LD + wn * 64 + ni * 32 + l32] = acc[mi][ni][i];
        __syncthreads();
        epi(ct, row0, col0);
        __syncthreads();
    }
}

template <class Epi, class RowOf>
DI void gemm_phase(const bf16_t* A, int lda, const bf16_t* Bt, int K, int n_mt, int ntn, char* smem, const Epi& epi, const RowOf& row_of) {
    const int srow = tid() >> 3;
    for (int u = unit_first(); u < n_mt * ntn; u += gridDim.x) {
        const int mt = u / ntn, nt = u - mt * ntn;
        const int row0 = row_of(mt), col0 = nt * 128;
        const bf16_t* ap = A + (size_t)(row0 + srow) * lda;
        const bf16_t* bp = Bt + (size_t)(col0 + srow) * K;
        gemm_tile(ap, ap + (size_t)32 * lda, ap + (size_t)64 * lda, ap + (size_t)96 * lda,
                  bp, bp + (size_t)32 * K, bp + (size_t)64 * K, bp + (size_t)96 * K, K, smem, epi, row0, col0);
    }
}

struct WEpiSplit { static constexpr int MODE = 0; static constexpr bool TILE = false; static constexpr bool PRELOAD = false; bf16_t* O0; int ld0; bf16_t* O1; int ld1; int split; int ncol;
    DI void store(int row, int col, uint4 v) const { if (col < split) { if (col < ncol) *(uint4*)(O0 + (size_t)row * ld0 + col) = v; } else *(uint4*)(O1 + (size_t)row * ld1 + (col - split)) = v; } };
struct WEpiResidual { static constexpr int MODE = 0; static constexpr bool TILE = false; static constexpr bool PRELOAD = true; const Params* pp; int layer;
    DI void preload(int row, int col, float4& x0, float4& x1) const {
        const Params& p = *pp;
        const float* srcp = layer == 0 ? in_row(p, row) + col : res_row(p, row) + col;
        x0 = *(const float4*)srcp; x1 = *(const float4*)(srcp + 4);
    }
    DI void store2(int row, int col, uint4 v, float4 x0, float4 x1) const {
        const Params& p = *pp;
        const float* md = p.mod + (size_t)(layer * 5 + mod_row(row)) * 6144 + 2048 + col;
        float* dst = res_row(p, row) + col;
        const float4 g0 = *(const float4*)md, g1 = *(const float4*)(md + 4);
        float4 o0 = {x0.x + g0.x * bflo(v.x), x0.y + g0.y * bfhi(v.x), x0.z + g0.z * bflo(v.y), x0.w + g0.w * bfhi(v.y)};
        float4 o1 = {x1.x + g1.x * bflo(v.z), x1.y + g1.y * bfhi(v.z), x1.z + g1.z * bflo(v.w), x1.w + g1.w * bfhi(v.w)};
        *(float4*)dst = o0; *(float4*)(dst + 4) = o1;
    }
    DI void store(int row, int col, uint4 v) const {
        const Params& p = *pp;
        const float* md = p.mod + (size_t)(layer * 5 + mod_row(row)) * 6144 + 2048 + col;
        float* dst = res_row(p, row) + col;
        const float* srcp = layer == 0 ? in_row(p, row) + col : dst;
        const float4 x0 = *(const float4*)srcp, x1 = *(const float4*)(srcp + 4), g0 = *(const float4*)md, g1 = *(const float4*)(md + 4);
        float4 o0 = {x0.x + g0.x * bflo(v.x), x0.y + g0.y * bfhi(v.x), x0.z + g0.z * bflo(v.y), x0.w + g0.w * bfhi(v.y)};
        float4 o1 = {x1.x + g1.x * bflo(v.z), x1.y + g1.y * bfhi(v.z), x1.z + g1.z * bflo(v.w), x1.w + g1.w * bfhi(v.w)};
        *(float4*)dst = o0; *(float4*)(dst + 4) = o1;
    } };
struct WEpiRows { static constexpr int MODE = 0; static constexpr bool TILE = false; static constexpr bool PRELOAD = false; bf16_t* O; int ld; int rbase; int row_end;
    DI void store(int row, int col, uint4 v) const { if (row < row_end) *(uint4*)(O + (size_t)(row - rbase) * ld + col) = v; } };
constexpr float YP_SCALE = 4.f;
struct WEpiRows8 { static constexpr int MODE = 2; static constexpr bool TILE = false; unsigned char* O; int rbase; int row_end;
    DI void store8(int row, int col, uint4 v) const { if (row < row_end) *(uint4*)(O + (size_t)(row - rbase) * DM + col) = v; } };
struct WEpiGateUp { static constexpr int MODE = 1; bf16_t* HID; const float* sw; int pos_end;
    DI float row_w(int pos) const { return pos < pos_end ? sw[pos] * YP_SCALE : 0.f; }
    DI void store(int pos, int f, uint4 v) const { if (pos < pos_end) *(uint4*)(HID + (size_t)pos * FF + f) = v; } };
constexpr int LDA = 72;
constexpr int CBP = 264;
template <class Epi> struct GUnit { const bf16_t *a0, *a1, *a2, *a3, *bw; int row0, col0, K; Epi epi; };
struct GOff { unsigned a0, a1, a2, a3, bw; };
template <class Epi, class UnitFn>
DI void gemm_stream_w(int n_units, const UnitFn& unit_fn, char* smem, const char* base) {
    bf16_t* As = (bf16_t*)smem;
    const int t = tid(), lane = t & 63, wave = t >> 6, l32 = lane & 31, h = lane >> 5;
    const int srow = t >> 3, scol = (t & 7) * 8;
    int u = unit_first();
    if (u >= n_units) return;
    uint4 ra0, ra1, ra2, ra3;
    bf16x8 fbA[2][2], fbB[2][2];
#define GW_OFF(g) GOff{(unsigned)((const char*)(g).a0 - base) + (unsigned)scol * 2u, (unsigned)((const char*)(g).a1 - base) + (unsigned)scol * 2u, \
                       (unsigned)((const char*)(g).a2 - base) + (unsigned)scol * 2u, (unsigned)((const char*)(g).a3 - base) + (unsigned)scol * 2u, (unsigned)((const char*)(g).bw - base)}
    const __amdgpu_buffer_rsrc_t wrs = __builtin_amdgcn_make_buffer_rsrc((void*)base, 0, 0x7FFFFFFF, 0x00020000);
#define GW_LD(vo, so) __builtin_bit_cast(uint4, __builtin_amdgcn_raw_buffer_load_b128(wrs, (int)(vo), (int)(so), 0))
#define GW_LDF(vo, so) __builtin_bit_cast(bf16x8, __builtin_amdgcn_raw_buffer_load_b128(wrs, (int)(vo), (int)(so), 0))
#define GW_LOADA(o, ko) do { ra0 = GW_LD((o).a0, ko); ra1 = GW_LD((o).a1, ko); ra2 = GW_LD((o).a2, ko); ra3 = GW_LD((o).a3, ko); } while (0)
#define GW_STOREA(buf) do { bf16_t* ad = As + (buf) * 128 * LDA + srow * LDA + scol; *(uint4*)(ad) = ra0; *(uint4*)(ad + 32 * LDA) = ra1; \
        *(uint4*)(ad + 64 * LDA) = ra2; *(uint4*)(ad + 96 * LDA) = ra3; } while (0)
#define GW_LOADB(fb, bv, bs, K) do { fb[0][0] = GW_LDF(bv, bs); fb[1][0] = GW_LDF(bv, (bs) + 1024u); \
        fb[0][1] = GW_LDF(bv, (bs) + 64u * (unsigned)(K)); fb[1][1] = GW_LDF(bv, (bs) + 64u * (unsigned)(K) + 1024u); } while (0)
#define GW_COMPUTE(Ac, fb) do { \
        bf16x8 fa[2][4]; \
        _Pragma("unroll") for (int ks = 0; ks < 2; ++ks) \
            _Pragma("unroll") for (int mi = 0; mi < 4; ++mi) fa[ks][mi] = *(const bf16x8*)((Ac) + mi * 32 * LDA + ks * 16); \
        __builtin_amdgcn_sched_barrier(0); \
        _Pragma("unroll") for (int ks = 0; ks < 2; ++ks) \
            _Pragma("unroll") for (int mi = 0; mi < 4; ++mi) { acc[mi][0] = MFMA32(fb[ks][0], fa[ks][mi], acc[mi][0]); acc[mi][1] = MFMA32(fb[ks][1], fa[ks][mi], acc[mi][1]); } \
        __builtin_amdgcn_sched_barrier(0); } while (0)
    GUnit<Epi> cur = unit_fn(u, srow, wave, lane);
    GOff co = GW_OFF(cur);
    GW_LOADA(co, 0u);
    GW_LOADB(fbA, co.bw, 0u, cur.K);
    for (;;) {
        const int ns = cur.K >> 6;
        GW_STOREA(0);
        __syncthreads();
        const int un = u + (int)gridDim.x;
        const bool has_next = un < n_units;
        GUnit<Epi> nxt = cur;
        if (has_next) nxt = unit_fn(un, srow, wave, lane);
        const GOff no = GW_OFF(nxt);
        f32x16 acc[4][2];
#pragma unroll
        for (int i = 0; i < 4; ++i)
#pragma unroll
            for (int j = 0; j < 2; ++j)
#pragma unroll
                for (int e = 0; e < 16; ++e) acc[i][j][e] = 0.f;
        for (int st = 0; st < ns; ++st) {
            const bool more = (st + 1 < ns);
            const bf16_t* Ac = As + (st & 1) * 128 * LDA + l32 * LDA + h * 8;
            {
                const unsigned ko = more ? (unsigned)(st + 1) * 128u : 0u;
                ra0 = GW_LD(more ? co.a0 : no.a0, ko); ra1 = GW_LD(more ? co.a1 : no.a1, ko);
                ra2 = GW_LD(more ? co.a2 : no.a2, ko); ra3 = GW_LD(more ? co.a3 : no.a3, ko);
            }
            GW_LOADB(fbB, co.bw, (unsigned)(2 * st + 1) * 2048u, cur.K);
            __builtin_amdgcn_sched_barrier(0);
            GW_COMPUTE(Ac, fbA);
            {
                const unsigned pbv = more ? co.bw : no.bw, pbs = more ? (unsigned)(2 * st + 2) * 2048u : 0u;
                const int K = more ? cur.K : nxt.K;
                GW_LOADB(fbA, pbv, pbs, K);
            }
            __builtin_amdgcn_sched_barrier(0);
            GW_COMPUTE(Ac + 32, fbB);
            if (more) GW_STOREA((st + 1) & 1);
            __syncthreads();
        }
        {
            bf16_t* cb = (bf16_t*)smem;
            if constexpr (Epi::MODE == 0) {
#pragma unroll
                for (int mi = 0; mi < 4; ++mi)
#pragma unroll
                    for (int ni = 0; ni < 2; ++ni)
#pragma unroll
                        for (int q = 0; q < 4; ++q) {
                            uint2 w; w.x = pk_bf16(acc[mi][ni][4 * q], acc[mi][ni][4 * q + 1]); w.y = pk_bf16(acc[mi][ni][4 * q + 2], acc[mi][ni][4 * q + 3]);
                            *(uint2*)(cb + (mi * 32 + l32) * CBP + wave * 64 + ni * 32 + 8 * q + 4 * h) = w;
                        }
                __syncthreads();
                if constexpr (Epi::TILE) cur.epi.tile(cb, cur.row0, cur.col0, smem);
                else if constexpr (Epi::PRELOAD) {
#pragma unroll 1
                    for (int hb = 0; hb < 2; ++hb) {
                        float4 xa[8][2];
#pragma unroll
                        for (int j = 0; j < 8; ++j) {
                            const int idx = t + NTHR * (hb * 8 + j), row = idx >> 5, c8 = (idx & 31) * 8;
                            cur.epi.preload(cur.row0 + row, cur.col0 + c8, xa[j][0], xa[j][1]);
                        }
#pragma unroll
                        for (int j = 0; j < 8; ++j) {
                            const int idx = t + NTHR * (hb * 8 + j), row = idx >> 5, c8 = (idx & 31) * 8;
                            cur.epi.store2(cur.row0 + row, cur.col0 + c8, *(const uint4*)(cb + row * CBP + c8), xa[j][0], xa[j][1]);
                        }
                    }
                } else {
#pragma unroll 4
                    for (int it = 0; it < 16; ++it) {
                        const int idx = t + NTHR * it, row = idx >> 5, c8 = (idx & 31) * 8;
                        cur.epi.store(cur.row0 + row, cur.col0 + c8, *(const uint4*)(cb + row * CBP + c8));
                    }
                }
            } else if constexpr (Epi::MODE == 2) {
                unsigned char* c8 = (unsigned char*)smem;
                constexpr int C8P = 272;
#pragma unroll
                for (int mi = 0; mi < 4; ++mi)
#pragma unroll
                    for (int ni = 0; ni < 2; ++ni)
#pragma unroll
                        for (int q = 0; q < 4; ++q) {
                            int w = __builtin_amdgcn_cvt_pk_fp8_f32(acc[mi][ni][4 * q], acc[mi][ni][4 * q + 1], 0, false);
                            w = __builtin_amdgcn_cvt_pk_fp8_f32(acc[mi][ni][4 * q + 2], acc[mi][ni][4 * q + 3], w, true);
                            *(int*)(c8 + (mi * 32 + l32) * C8P + wave * 64 + ni * 32 + 8 * q + 4 * h) = w;
                        }
                __syncthreads();
#pragma unroll 4
                for (int it = 0; it < 8; ++it) {
                    const int idx = t + NTHR * it, row = idx >> 4, c16 = (idx & 15) * 16;
                    cur.epi.store8(cur.row0 + row, cur.col0 + c16, *(const uint4*)(c8 + row * C8P + c16));
                }
            } else {
#pragma unroll
                for (int mi = 0; mi < 4; ++mi) {
                    const float wr = cur.epi.row_w(cur.row0 + mi * 32 + l32);
#pragma unroll
                    for (int q = 0; q < 4; ++q) {
                        float o[4];
#pragma unroll
                        for (int j = 0; j < 4; ++j) o[j] = silu_f(acc[mi][0][4 * q + j]) * acc[mi][1][4 * q + j] * wr;
                        uint2 w; w.x = pk_bf16(o[0], o[1]); w.y = pk_bf16(o[2], o[3]);
                        *(uint2*)(cb + (mi * 32 + l32) * CBP + wave * 32 + 8 * q + 4 * h) = w;
                    }
                }
                __syncthreads();
#pragma unroll 4
                for (int it = 0; it < 8; ++it) {
                    const int idx = t + NTHR * it, row = idx >> 4, c8 = (idx & 15) * 8;
                    cur.epi.store(cur.row0 + row, (cur.col0 >> 1) + c8, *(const uint4*)(cb + row * CBP + c8));
                }
            }
            __syncthreads();
        }
        if (!has_next) break;
        cur = nxt; co = no; u = un;
    }
#undef GW_OFF
#undef GW_LD
#undef GW_LDF
#undef GW_LOADA
#undef GW_STOREA
#undef GW_LOADB
#undef GW_COMPUTE
}
template <class Epi, class RowOf>
DI void gemm_phase_w(const char* base, const bf16_t* A, int lda, const bf16_t* Bt, int K, int n_mt, int ntn, char* smem, const Epi& epi, const RowOf& row_of) {
    auto unit_fn = [&](int u, int srow, int wave, int lane) {
        const int mt = u / ntn, nt = u - mt * ntn;
        const int row0 = row_of(mt), col0 = nt * 256;
        const bf16_t* ap = A + (size_t)(row0 + srow) * lda;
        const bf16_t* bw = Bt + (size_t)(col0 + wave * 64) * K + lane * 8;
        return GUnit<Epi>{ap, ap + (size_t)32 * lda, ap + (size_t)64 * lda, ap + (size_t)96 * lda, bw, row0, col0, K, epi};
    };
    gemm_stream_w<Epi>(n_mt * ntn, unit_fn, smem, base);
}
struct RowIdent { DI int operator()(int mt) const { return mt * 128; } };
struct RowLatent { DI int operator()(int mt) const { return (mt >> 6) * LT + LC + (mt & 63) * 128; } };

DI uint4 pack8(const float* s) {
    const float4 a = *(const float4*)s, b = *(const float4*)(s + 4);
    uint4 o; o.x = pk_bf16(a.x, a.y); o.y = pk_bf16(a.z, a.w); o.z = pk_bf16(b.x, b.y); o.w = pk_bf16(b.z, b.w); return o;
}
struct EpiSplitBf16 {
    bf16_t* O0; int ld0; bf16_t* O1; int ld1; int split;
    DI void operator()(const float* ct, int row0, int col0) const {
        bf16_t* base; int ld;
        if (col0 < split) { base = O0 + col0; ld = ld0; } else { base = O1 + (col0 - split); ld = ld1; }
#pragma unroll 2
        for (int it = 0; it < 8; ++it) {
            const int idx = tid() + NTHR * it, row = idx >> 4, c8 = (idx & 15) * 8;
            *(uint4*)(base + (size_t)(row0 + row) * ld + c8) = pack8(ct + row * CT_LD + c8);
        }
    }
};
struct EpiResidual {
    Params p; int layer;
    DI void operator()(const float* ct, int row0, int col0) const {
        const float* md = p.mod + (size_t)(layer * 5 + mod_row(row0)) * 6144 + 2048 + col0;
#pragma unroll 2
        for (int it = 0; it < 16; ++it) {
            const int idx = tid() + NTHR * it, row = idx >> 5, c4 = (idx & 31) * 4, r = row0 + row;
            const float4 a = *(const float4*)(ct + row * CT_LD + c4), g = *(const float4*)(md + c4);
            float* dst = res_row(p, r) + col0 + c4;
            const float4 x = layer == 0 ? *(const float4*)(in_row(p, r) + col0 + c4) : *(const float4*)dst;
            float4 o = {x.x + g.x * a.x, x.y + g.y * a.y, x.z + g.z * a.z, x.w + g.w * a.w};
            *(float4*)dst = o;
        }
    }
};

template <int DK, int DV, bool LSUM_MFMA>
DI void attn_core(const bf16_t* Qh, const bf16_t* Kh, const bf16_t* VTh, int qpos0, int nkeys, float c, float kmax2, char* smem,
                  f32x16 (&O)[DV / 32], float& l_tot) {
    constexpr int KS = DK / 16, NDB = DV / 32, LDK = DK + 8, KCH = DK / 8, NKCH = 64 * KCH, NKC = (NKCH + NTHR - 1) / NTHR, NVC = DV * 8 / NTHR;
    bf16_t* Ks = (bf16_t*)smem;
    bf16_t* Vs = Ks + 2 * 64 * LDK;
    const int t = tid(), lane = t & 63, wave = t >> 6, l32 = lane & 31, h = lane >> 5;
    bf16x8 qf[KS];
    {
        const bf16_t* qp = Qh + (size_t)(qpos0 + wave * 32 + l32) * DK + h * 8;
#pragma unroll
        for (int ks = 0; ks < KS; ++ks) qf[ks] = *(const bf16x8*)(qp + ks * 16);
    }
    static_assert(NKC == 2 && (NVC == 2 || NVC == 4), "staging shape");
    uint4 rk0, rk1, rv0, rv1, rv2 = {0u, 0u, 0u, 0u}, rv3 = {0u, 0u, 0u, 0u};
    const int kidx1 = (NKCH % NTHR == 0 || t + NTHR < NKCH) ? t + NTHR : NKCH - 1;
    const bool k1ok = (NKCH % NTHR == 0) || (t + NTHR < NKCH);
    const __amdgpu_buffer_rsrc_t krs = __builtin_amdgcn_make_buffer_rsrc((void*)Kh, 0, 0x7FFFFFFF, 0x00020000);
    const __amdgpu_buffer_rsrc_t vrs = __builtin_amdgcn_make_buffer_rsrc((void*)VTh, 0, 0x7FFFFFFF, 0x00020000);
    const int ko0 = t * 16, ko1 = kidx1 * 16;
    const int vo0 = ((t >> 3) * LT + (t & 7) * 8) * 2;
    const int ks0 = (t / KCH) * LDK + (t % KCH) * 8, ks1 = ((t + NTHR) / KCH) * LDK + ((t + NTHR) % KCH) * 8;
    const int vs0 = (t >> 3) * LDT + (t & 7) * 8;
#define ATT_BL(rs, vo, so) __builtin_bit_cast(uint4, __builtin_amdgcn_raw_buffer_load_b128(rs, vo, so, 0))
#define ATT_LOAD(key0) do { const int kso_ = (key0) * (DK * 2), vso_ = (key0) * 2; \
        rk0 = ATT_BL(krs, ko0, kso_); rk1 = ATT_BL(krs, ko1, kso_); \
        rv0 = ATT_BL(vrs, vo0, vso_); rv1 = ATT_BL(vrs, vo0, vso_ + 32 * LT * 2); \
        if constexpr (NVC == 4) { rv2 = ATT_BL(vrs, vo0, vso_ + 64 * LT * 2); rv3 = ATT_BL(vrs, vo0, vso_ + 96 * LT * 2); } } while (0)
#define ATT_STORE(buf) do { *(uint4*)(Ks + (buf) * 64 * LDK + ks0) = rk0; if (k1ok) *(uint4*)(Ks + (buf) * 64 * LDK + ks1) = rk1; \
        *(uint4*)(Vs + (buf) * DV * LDT + vs0) = rv0; *(uint4*)(Vs + (buf) * DV * LDT + 32 * LDT + vs0) = rv1; \
        if constexpr (NVC == 4) { *(uint4*)(Vs + (buf) * DV * LDT + 64 * LDT + vs0) = rv2; *(uint4*)(Vs + (buf) * DV * LDT + 96 * LDT + vs0) = rv3; } } while (0)
    ATT_LOAD(0);
    ATT_STORE(0);
    __syncthreads();
#pragma unroll
    for (int d = 0; d < NDB; ++d)
#pragma unroll
        for (int e = 0; e < 16; ++e) O[d][e] = 0.f;
    float qn2 = 0.f;
#pragma unroll
    for (int ks = 0; ks < KS; ++ks) {
        float qv[8];
#pragma unroll
        for (int j = 0; j < 8; ++j) qv[j] = bf2f((bf16_t)qf[ks][j]) * c;
        uint4 w; w.x = pk_bf16(qv[0], qv[1]); w.y = pk_bf16(qv[2], qv[3]); w.z = pk_bf16(qv[4], qv[5]); w.w = pk_bf16(qv[6], qv[7]);
        qf[ks] = __builtin_bit_cast(bf16x8, w);
#pragma unroll
        for (int j = 0; j < 8; ++j) { const float r = bf2f((bf16_t)qf[ks][j]); qn2 += r * r; }
    }
    qn2 = half_sum(qn2);
    const float Mrow = sqrtf(qn2 * kmax2) * 1.02f + 1e-3f;
    const bool fast = __all(Mrow < 50.f) != 0;
    float m_run = -1e30f, l_run = 0.f;
    const int nt = nkeys >> 6;
    auto tile_loop = [&](auto fast_tag) {
    constexpr bool FAST = decltype(fast_tag)::value;
    f32x16 Cinit;
#pragma unroll
    for (int e = 0; e < 16; ++e) Cinit[e] = FAST ? -Mrow : 0.f;
    f32x16 Lacc;
#pragma unroll
    for (int e = 0; e < 16; ++e) Lacc[e] = 0.f;
    const bf16x8 ones = {0x3F80, 0x3F80, 0x3F80, 0x3F80, 0x3F80, 0x3F80, 0x3F80, 0x3F80};
    auto body = [&](auto cur_c, const int kt, const bool more) {
        const int cur = cur_c;
        if (more) { const int key0 = (kt + 1) * 64; ATT_LOAD(key0); }
        __builtin_amdgcn_sched_barrier(0);
        f32x16 S0, S1;
        const bf16_t* kb = Ks + (cur * 64 + l32) * LDK + h * 8;
        bf16x8 kf0[KS], kf1[KS];
#pragma unroll
        for (int ks = 0; ks < KS; ++ks) { kf0[ks] = *(const bf16x8*)(kb + ks * 16); kf1[ks] = *(const bf16x8*)(kb + 32 * LDK + ks * 16); }
        __builtin_amdgcn_sched_barrier(0);
        S0 = MFMA32(kf0[0], qf[0], Cinit); S1 = MFMA32(kf1[0], qf[0], Cinit);
#pragma unroll
        for (int ks = 1; ks < KS; ++ks) { S0 = MFMA32(kf0[ks], qf[ks], S0); S1 = MFMA32(kf1[ks], qf[ks], S1); }
        constexpr int VPF = NDB < 2 ? NDB : 2;
        bf16x8 vf[VPF][4];
#pragma unroll
        for (int d = 0; d < VPF; ++d) {
            const bf16_t* vb = Vs + (cur * DV + d * 32 + l32) * LDT + h * 8;
#pragma unroll
            for (int j = 0; j < 4; ++j) vf[d][j] = *(const bf16x8*)(vb + j * 16);
        }
        __builtin_amdgcn_sched_barrier(0);
        if constexpr (FAST) {
#pragma unroll
            for (int e = 0; e < 16; ++e) { S0[e] = __builtin_amdgcn_exp2f(S0[e]); S1[e] = __builtin_amdgcn_exp2f(S1[e]); }
            if constexpr (!LSUM_MFMA) {
#pragma unroll
                for (int e = 0; e < 16; ++e) { l_run += S0[e]; l_run += S1[e]; }
            }
        } else {
            float mx = fmaxf(S0[0], S1[0]);
#pragma unroll
            for (int e = 1; e < 16; ++e) mx = fmaxf(mx, fmaxf(S0[e], S1[e]));
            mx = half_max(mx);
            const float m_new = fmaxf(m_run, mx);
            const float alpha = __builtin_amdgcn_exp2f(m_run - m_new);
            m_run = m_new;
            float ls = 0.f;
#pragma unroll
            for (int e = 0; e < 16; ++e) { S0[e] = __builtin_amdgcn_exp2f(S0[e] - m_new); S1[e] = __builtin_amdgcn_exp2f(S1[e] - m_new); ls += S0[e] + S1[e]; }
            l_run = l_run * alpha + ls;
#pragma unroll
            for (int d = 0; d < NDB; ++d)
#pragma unroll
                for (int e = 0; e < 16; ++e) O[d][e] *= alpha;
        }
        bf16x8 pf[4];
        {
            uint4 w;
            w.x = pk_bf16(S0[0], S0[1]); w.y = pk_bf16(S0[2], S0[3]); w.z = pk_bf16(S0[4], S0[5]); w.w = pk_bf16(S0[6], S0[7]); pf[0] = __builtin_bit_cast(bf16x8, w);
            w.x = pk_bf16(S0[8], S0[9]); w.y = pk_bf16(S0[10], S0[11]); w.z = pk_bf16(S0[12], S0[13]); w.w = pk_bf16(S0[14], S0[15]); pf[1] = __builtin_bit_cast(bf16x8, w);
            w.x = pk_bf16(S1[0], S1[1]); w.y = pk_bf16(S1[2], S1[3]); w.z = pk_bf16(S1[4], S1[5]); w.w = pk_bf16(S1[6], S1[7]); pf[2] = __builtin_bit_cast(bf16x8, w);
            w.x = pk_bf16(S1[8], S1[9]); w.y = pk_bf16(S1[10], S1[11]); w.z = pk_bf16(S1[12], S1[13]); w.w = pk_bf16(S1[14], S1[15]); pf[3] = __builtin_bit_cast(bf16x8, w);
        }
        if constexpr (FAST && LSUM_MFMA) {
#pragma unroll
            for (int j = 0; j < 4; ++j) Lacc = MFMA32(ones, pf[j], Lacc);
        }
        __builtin_amdgcn_sched_barrier(0);
        if constexpr (NDB > VPF) {
#pragma unroll
            for (int d = 0; d < NDB; ++d) {
#pragma unroll
                for (int j = 0; j < 4; ++j) O[d] = MFMA32(vf[d % VPF][j], pf[j], O[d]);
                if (d + VPF < NDB) {
                    __builtin_amdgcn_sched_barrier(0);
                    const bf16_t* vb = Vs + (cur * DV + (d + VPF) * 32 + l32) * LDT + h * 8;
#pragma unroll
                    for (int j = 0; j < 4; ++j) vf[d % VPF][j] = *(const bf16x8*)(vb + j * 16);
                    __builtin_amdgcn_sched_barrier(0);
                }
            }
        } else {
#pragma unroll
            for (int d = 0; d < VPF; ++d)
#pragma unroll
                for (int j = 0; j < 4; ++j) O[d] = MFMA32(vf[d][j], pf[j], O[d]);
        }
        __builtin_amdgcn_sched_barrier(0);
        if (more) { const int nb = cur ^ 1; ATT_STORE(nb); }
        __syncthreads();
    };
    for (int kt = 0; kt < nt; kt += 2) {
        body(std::integral_constant<int, 0>{}, kt, true);
        body(std::integral_constant<int, 1>{}, kt + 1, kt + 2 < nt);
    }
    if constexpr (FAST && LSUM_MFMA) l_run = 0.5f * Lacc[0];
    };
    if (fast) tile_loop(std::true_type{}); else tile_loop(std::false_type{});
    l_tot = half_sum(l_run);
#undef ATT_LOAD
#undef ATT_BL
#undef ATT_STORE
}

DI float kmax_of(const Params& p, int idx) { return __uint_as_float(__hip_atomic_load(p.kmax + idx, __ATOMIC_RELAXED, __HIP_MEMORY_SCOPE_AGENT)); }
DI void attn0_unit(const Params& p, int u, char* smem) {
    int b, hd, qb;
    if (u < NB * 4 * 64) { b = u / 256; hd = (u >> 6) & 3; qb = 2 + (u & 63); }
    else { const int v = u - NB * 4 * 64; b = v >> 3; hd = (v >> 1) & 3; qb = v & 1; }
    const int nkeys = qb < 2 ? LC : LT;
    const bf16_t* Q = (const bf16_t*)p.x2;
    const bf16_t* K = Q + (size_t)NB * 8 * LT * 64;
    const bf16_t* VT = K + (size_t)NB * 8 * LT * 64;
    float* Otmp = (float*)p.x1;
    bf16_t* CAT = (bf16_t*)p.x4;
    const int lane = tid() & 63, wave = tid() >> 6, l32 = lane & 31, h = lane >> 5;
    const int qpos0 = qb * 128;
    const int row = b * LT + qpos0 + wave * 32 + l32;
    const float c = 0.125f * LOG2E;
    const bf16_t* VTh = VT + (size_t)(b * 4 + hd) * 128 * LT;
    float* ot = Otmp + ((size_t)row * 4 + hd) * 128;
    f32x16 O[4]; float l_tot;
    attn_core<64, 128, false>(Q + (size_t)(b * 8 + hd * 2 + 0) * LT * 64, K + (size_t)(b * 8 + hd * 2 + 0) * LT * 64, VTh, qpos0, nkeys, c, kmax_of(p, b * 8 + hd * 2 + 0), smem, O, l_tot);
    {
        const float inv = 1.f / l_tot;
#pragma unroll
        for (int d = 0; d < 4; ++d)
#pragma unroll
            for (int g = 0; g < 4; ++g) {
                float4 v = {O[d][4 * g] * inv, O[d][4 * g + 1] * inv, O[d][4 * g + 2] * inv, O[d][4 * g + 3] * inv};
                *(float4*)(ot + d * 32 + 8 * g + 4 * h) = v;
            }
    }
    attn_core<64, 128, false>(Q + (size_t)(b * 8 + hd * 2 + 1) * LT * 64, K + (size_t)(b * 8 + hd * 2 + 1) * LT * 64, VTh, qpos0, nkeys, c, kmax_of(p, b * 8 + hd * 2 + 1), smem, O, l_tot);
    {
        const float inv = 1.f / l_tot, lam = p.lamv[0];
        float ss = 0.f;
#pragma unroll
        for (int d = 0; d < 4; ++d)
#pragma unroll
            for (int g = 0; g < 4; ++g) {
                const float4 o1 = *(const float4*)(ot + d * 32 + 8 * g + 4 * h);
                O[d][4 * g] = o1.x - lam * O[d][4 * g] * inv; O[d][4 * g + 1] = o1.y - lam * O[d][4 * g + 1] * inv;
                O[d][4 * g + 2] = o1.z - lam * O[d][4 * g + 2] * inv; O[d][4 * g + 3] = o1.w - lam * O[d][4 * g + 3] * inv;
                ss += O[d][4 * g] * O[d][4 * g] + O[d][4 * g + 1] * O[d][4 * g + 1] + O[d][4 * g + 2] * O[d][4 * g + 2] + O[d][4 * g + 3] * O[d][4 * g + 3];
            }
        ss = half_sum(ss);
        const float rinv = rsqrtf(ss * (1.f / 128.f) + EPSV) * 0.8f;
        const float* sub = p.in[10];
        bf16_t* op = CAT + (size_t)row * DM + hd * 128;
#pragma unroll
        for (int d = 0; d < 4; ++d)
#pragma unroll
            for (int g = 0; g < 4; ++g) {
                const int dv = d * 32 + 8 * g + 4 * h;
                const float4 sb = *(const float4*)(sub + dv);
                uint2 o; o.x = pk_bf16(O[d][4 * g] * rinv * sb.x, O[d][4 * g + 1] * rinv * sb.y); o.y = pk_bf16(O[d][4 * g + 2] * rinv * sb.z, O[d][4 * g + 3] * rinv * sb.w);
                *(uint2*)(op + dv) = o;
            }
    }
}

DI void attn1_unit(const Params& p, int u, char* smem) {
    const bf16_t* Q1 = (const bf16_t*)p.x2;
    const bf16_t* K1 = Q1 + (size_t)NB * 8 * LT * 64;
    const bf16_t* VT1 = K1 + (size_t)NB * 2 * LT * 64;
    const bf16_t* MQ = VT1 + (size_t)NB * 2 * 64 * LT;
    const bf16_t* MK = MQ + (size_t)NB * 8 * LT * 48;
    const bf16_t* MVT = MK + (size_t)NB * 8 * LT * 48;
    bf16_t* CAT = (bf16_t*)p.x4;
    const int lane = tid() & 63, wave = tid() >> 6, l32 = lane & 31, h = lane >> 5;
    const int mla = u >= 2048, v = u & 2047, b = v >> 9, hd = (v >> 6) & 7, qb = 2 + (v & 63);
    const int qpos0 = qb * 128;
    const int row = b * LT + qpos0 + wave * 32 + l32;
    f32x16 O[2]; float l_tot;
    if (!mla) attn_core<64, 64, false>(Q1 + (size_t)(b * 8 + hd) * LT * 64, K1 + (size_t)(b * 2 + (hd >> 2)) * LT * 64, VT1 + (size_t)(b * 2 + (hd >> 2)) * 64 * LT, qpos0, LT, 0.125f * LOG2E, kmax_of(p, 32 + b * 2 + (hd >> 2)), smem, O, l_tot);
    else attn_core<48, 64, false>(MQ + (size_t)(b * 8 + hd) * LT * 48, MK + (size_t)(b * 8 + hd) * LT * 48, MVT + (size_t)(b * 8 + hd) * 64 * LT, qpos0, LT, 0.14433756729740643f * LOG2E, kmax_of(p, 40 + b * 8 + hd), smem, O, l_tot);
    const float inv = 1.f / l_tot;
    bf16_t* op = CAT + (size_t)row * DM + mla * 512 + hd * 64;
#pragma unroll
    for (int d = 0; d < 2; ++d)
#pragma unroll
        for (int g = 0; g < 4; ++g) {
            uint2 o; o.x = pk_bf16(O[d][4 * g] * inv, O[d][4 * g + 1] * inv); o.y = pk_bf16(O[d][4 * g + 2] * inv, O[d][4 * g + 3] * inv);
            *(uint2*)(op + d * 32 + 8 * g + 4 * h) = o;
        }
}

#define ROPE64(x, cr, sr, cc, sc) do { _Pragma("unroll") for (int i_ = 0; i_ < 16; ++i_) { \
    const float a_ = x[i_], b_ = x[i_ + 16]; x[i_] = a_ * (cr)[i_] - b_ * (sr)[i_]; x[i_ + 16] = a_ * (sr)[i_] + b_ * (cr)[i_]; \
    const float c_ = x[32 + i_], d_ = x[48 + i_]; x[32 + i_] = c_ * (cc)[i_] - d_ * (sc)[i_]; x[48 + i_] = c_ * (sc)[i_] + d_ * (cc)[i_]; } } while (0)

constexpr int SEG_LDS_OFF_E = 73728;
struct WEpiInProj0 { static constexpr int MODE = 0; static constexpr bool TILE = true; static constexpr bool PRELOAD = false; const Params* pp;
    DI void store(int, int, uint4) const {}
    DI void tile(const bf16_t* cb, int row0, int col0, char* smem) const {
        const Params& p = *pp;
        const int t = tid(), nt = col0 >> 8;
        const int b = row0 / LT, pos0 = row0 - b * LT;
        const bool lat = pos0 >= LC;
        bf16_t* Q = (bf16_t*)p.x2;
        bf16_t* K = Q + (size_t)NB * 8 * LT * 64;
        bf16_t* VT = K + (size_t)NB * 8 * LT * 64;
        if (nt < 4) {
            const bool isk = nt >= 2; const int hj0 = (nt & 1) * 4;
            unsigned* lmax = (unsigned*)(smem + SEG_LDS_OFF_E);
            if (isk) { if (t < 4) lmax[t] = 0u; __syncthreads(); }
#pragma unroll 1
            for (int it = 0; it < 2; ++it) {
                const int item = t + NTHR * it, rr = item >> 2, v = item & 3;
                const bf16_t* src = cb + rr * CBP + v * 64;
                float x[64];
#pragma unroll
                for (int c8 = 0; c8 < 8; ++c8) {
                    const uint4 w = *(const uint4*)(src + c8 * 8);
                    x[c8 * 8 + 0] = bflo(w.x); x[c8 * 8 + 1] = bfhi(w.x); x[c8 * 8 + 2] = bflo(w.y); x[c8 * 8 + 3] = bfhi(w.y);
                    x[c8 * 8 + 4] = bflo(w.z); x[c8 * 8 + 5] = bfhi(w.z); x[c8 * 8 + 6] = bflo(w.w); x[c8 * 8 + 7] = bfhi(w.w);
                }
                if (lat) {
                    const int tpos = pos0 + rr - LC, gr = tpos >> 6, gc = tpos & 63;
                    const float* cr = p.tab + TB_CR + gr * 16; const float* sr = p.tab + TB_SR + gr * 16;
                    const float* cc = p.tab + TB_CC + gc * 16; const float* sc = p.tab + TB_SC + gc * 16;
                    ROPE64(x, cr, sr, cc, sc);
                }
                if (isk) { float ss = 0.f;
#pragma unroll
                    for (int i = 0; i < 64; ++i) ss += x[i] * x[i];
                    atomicMax(&lmax[v], __float_as_uint(ss)); }
                bf16_t* dst = (isk ? K : Q) + ((size_t)(b * 8 + hj0 + v) * LT + pos0 + rr) * 64;
#pragma unroll
                for (int c8 = 0; c8 < 8; ++c8) {
                    uint4 w; w.x = pk_bf16(x[c8 * 8], x[c8 * 8 + 1]); w.y = pk_bf16(x[c8 * 8 + 2], x[c8 * 8 + 3]); w.z = pk_bf16(x[c8 * 8 + 4], x[c8 * 8 + 5]); w.w = pk_bf16(x[c8 * 8 + 6], x[c8 * 8 + 7]);
                    *(uint4*)(dst + c8 * 8) = w;
                }
            }
            if (isk) { __syncthreads(); if (t < 4) atomicMax(&p.kmax[b * 8 + hj0 + t], lmax[t]); }
        } else if (nt < 6) {
#pragma unroll 4
            for (int it = 0; it < 16; ++it) {
                const int idx = t + NTHR * it, col = idx >> 4, q = idx & 15;
                const int kbase = 16 * (q >> 1) + 4 * (q & 1);
                unsigned short e[8];
#pragma unroll
                for (int j = 0; j < 8; ++j) e[j] = cb[(kbase + 8 * (j >> 2) + (j & 3)) * CBP + col];
                uint4 o; o.x = e[0] | ((unsigned)e[1] << 16); o.y = e[2] | ((unsigned)e[3] << 16); o.z = e[4] | ((unsigned)e[5] << 16); o.w = e[6] | ((unsigned)e[7] << 16);
                const int head = (nt - 4) * 2 + (col >> 7), dv = col & 127;
                *(uint4*)(VT + ((size_t)(b * 4 + head) * 128 + dv) * LT + pos0 + q * 8) = o;
            }
        } else {
            bf16_t* UG = (bf16_t*)(p.x1 + (size_t)NT * 1536 * 2);
#pragma unroll 4
            for (int it = 0; it < 16; ++it) {
                const int idx = t + NTHR * it, row = idx >> 5, c8 = (idx & 31) * 8;
                *(uint4*)(UG + (size_t)(row0 + row) * 1024 + (col0 - 1536) + c8) = *(const uint4*)(cb + row * CBP + c8);
            }
        }
    }
};

template <int NC, int LP>
DI void vt_write(const bf16_t* tile, bf16_t* dst, int pos0) {
    const int t = tid();
#pragma unroll
    for (int it = 0; it < NC * 8 / NTHR; ++it) {
        const int idx = t + NTHR * it, col = idx >> 3, q = idx & 7;
        const int kbase = 16 * (q >> 1) + 4 * (q & 1);
        unsigned short e[8];
#pragma unroll
        for (int j = 0; j < 8; ++j) e[j] = tile[(kbase + 8 * (j >> 2) + (j & 3)) * LP + col];
        uint4 o; o.x = e[0] | ((unsigned)e[1] << 16); o.y = e[2] | ((unsigned)e[3] << 16); o.z = e[4] | ((unsigned)e[5] << 16); o.w = e[6] | ((unsigned)e[7] << 16);
        *(uint4*)(dst + (size_t)col * LT + pos0 + q * 8) = o;
    }
}

DI void postproj0_unit(const Params& p, int u, char* smem) {
    const bf16_t* raw = (const bf16_t*)p.x1;
    bf16_t* Q = (bf16_t*)p.x2;
    bf16_t* K = Q + (size_t)NB * 8 * LT * 64;
    bf16_t* VT = K + (size_t)NB * 8 * LT * 64;
    float* tb = (float*)smem;
    bf16_t* tile = (bf16_t*)(smem + 8448);
    const int t = tid();
    const int r0 = u * 64, b = r0 / LT, pos0 = r0 - b * LT;
    const bool lat = pos0 >= LC;
    const int gr = lat ? (pos0 - LC) >> 6 : 0;
    unsigned* lmax = (unsigned*)(smem + 32768);
    if (t < 16) lmax[t] = 0u;
    for (int i = t; i < 1024; i += NTHR) { tb[i] = p.tab[TB_CC + i]; tb[1024 + i] = p.tab[TB_SC + i]; }
    if (t < 16) { tb[2048 + t] = p.tab[TB_CR + gr * 16 + t]; tb[2064 + t] = p.tab[TB_SR + gr * 16 + t]; }
    __syncthreads();
#pragma unroll 1
    for (int it = 0; it < 4; ++it) {
        const int item = t + NTHR * it, rr = item >> 4, vec = item & 15;
        const bf16_t* src = raw + (size_t)(r0 + rr) * 1536 + (vec < 8 ? vec * 64 : 512 + (vec - 8) * 64);
        float x[64];
#pragma unroll
        for (int c8 = 0; c8 < 8; ++c8) {
            const uint4 w = *(const uint4*)(src + c8 * 8);
            x[c8 * 8 + 0] = bflo(w.x); x[c8 * 8 + 1] = bfhi(w.x); x[c8 * 8 + 2] = bflo(w.y); x[c8 * 8 + 3] = bfhi(w.y);
            x[c8 * 8 + 4] = bflo(w.z); x[c8 * 8 + 5] = bfhi(w.z); x[c8 * 8 + 6] = bflo(w.w); x[c8 * 8 + 7] = bfhi(w.w);
        }
        if (lat) { const float* cc = tb + rr * 16; const float* sc = tb + 1024 + rr * 16; ROPE64(x, tb + 2048, tb + 2064, cc, sc); }
        if (vec >= 8) { float ss = 0.f;
#pragma unroll
            for (int i = 0; i < 64; ++i) ss += x[i] * x[i];
            atomicMax(&lmax[vec & 7], __float_as_uint(ss)); }
        bf16_t* dst = (vec < 8 ? Q : K) + ((size_t)(b * 8 + (vec & 7)) * LT + pos0 + rr) * 64;
#pragma unroll
        for (int c8 = 0; c8 < 8; ++c8) {
            uint4 w; w.x = pk_bf16(x[c8 * 8], x[c8 * 8 + 1]); w.y = pk_bf16(x[c8 * 8 + 2], x[c8 * 8 + 3]); w.z = pk_bf16(x[c8 * 8 + 4], x[c8 * 8 + 5]); w.w = pk_bf16(x[c8 * 8 + 6], x[c8 * 8 + 7]);
            *(uint4*)(dst + c8 * 8) = w;
        }
    }
    __syncthreads();
    if (t < 8) atomicMax(&p.kmax[b * 8 + t], lmax[t]);
    for (int hd = 0; hd < 4; ++hd) {
        __syncthreads();
#pragma unroll
        for (int it = 0; it < 4; ++it) {
            const int idx = t + NTHR * it, rr = idx >> 4, c16 = idx & 15;
            *(uint4*)(tile + rr * 136 + c16 * 8) = *(const uint4*)(raw + (size_t)(r0 + rr) * 1536 + 1024 + hd * 128 + c16 * 8);
        }
        __syncthreads();
        vt_write<128, 136>(tile, VT + (size_t)(b * 4 + hd) * 128 * LT, pos0);
    }
    __syncthreads();
}

DI void postproj1a_unit(const Params& p, int u, char* smem) {
    const bf16_t* raw = (const bf16_t*)p.x1;
    bf16_t* CQn = (bf16_t*)(p.x1 + (size_t)NT * CD_INP * 2);
    bf16_t* CKVn = CQn + (size_t)NT * 256;
    bf16_t* KR = CKVn + (size_t)NT * 128;
    bf16_t* Q1 = (bf16_t*)p.x2;
    bf16_t* K1 = Q1 + (size_t)NB * 8 * LT * 64;
    bf16_t* VT1 = K1 + (size_t)NB * 2 * LT * 64;
    float* tb = (float*)smem;
    bf16_t* tile = (bf16_t*)(smem + 8448);
    const int t = tid(), lane = t & 63, wave = t >> 6;
    const int r0 = u * 64, b = r0 / LT, pos0 = r0 - b * LT;
    const bool lat = pos0 >= LC;
    const int gr = lat ? (pos0 - LC) >> 6 : 0;
    unsigned* lmax = (unsigned*)(smem + 32768);
    if (t < 16) lmax[t] = 0u;
    for (int i = t; i < 1024; i += NTHR) { tb[i] = p.tab[TB_CC + i]; tb[1024 + i] = p.tab[TB_SC + i]; }
    if (t < 16) { tb[2048 + t] = p.tab[TB_CR + gr * 16 + t]; tb[2064 + t] = p.tab[TB_SR + gr * 16 + t]; }
    __syncthreads();
    uint4 rw[8];
    {
        const int rr = t / 10, vec = t - rr * 10;
        const bf16_t* src = raw + (size_t)(r0 + rr) * CD_INP + vec * 64;
#pragma unroll
        for (int c8 = 0; c8 < 8; ++c8) rw[c8] = *(const uint4*)(src + c8 * 8);
    }
#pragma unroll 1
    for (int it = 0; it < 3; ++it) {
        const int item = t + NTHR * it;
        uint4 rn[8];
        {
            int itn = item + NTHR; if (itn > 639) itn = 639;
            const int rrn = itn / 10, vecn = itn - rrn * 10;
            const bf16_t* srcn = raw + (size_t)(r0 + rrn) * CD_INP + vecn * 64;
#pragma unroll
            for (int c8 = 0; c8 < 8; ++c8) rn[c8] = *(const uint4*)(srcn + c8 * 8);
        }
        if (item < 640) {
            const int rr = item / 10, vec = item - rr * 10;
            const float* nw = vec < 8 ? p.in[20] : p.in[21];
            float x[64]; float ss = 0.f;
#pragma unroll
            for (int c8 = 0; c8 < 8; ++c8) {
                const uint4 w = rw[c8];
                x[c8 * 8 + 0] = bflo(w.x); x[c8 * 8 + 1] = bfhi(w.x); x[c8 * 8 + 2] = bflo(w.y); x[c8 * 8 + 3] = bfhi(w.y);
                x[c8 * 8 + 4] = bflo(w.z); x[c8 * 8 + 5] = bfhi(w.z); x[c8 * 8 + 6] = bflo(w.w); x[c8 * 8 + 7] = bfhi(w.w);
            }
#pragma unroll
            for (int i = 0; i < 64; ++i) ss += x[i] * x[i];
            const float rinv = rsqrtf(ss * (1.f / 64.f) + EPSV);
#pragma unroll
            for (int i = 0; i < 64; ++i) x[i] = x[i] * rinv * nw[i];
            if (lat) { const float* cc = tb + rr * 16; const float* sc = tb + 1024 + rr * 16; ROPE64(x, tb + 2048, tb + 2064, cc, sc); }
            if (vec >= 8) { float s2 = 0.f;
#pragma unroll
                for (int i = 0; i < 64; ++i) s2 += x[i] * x[i];
                atomicMax(&lmax[vec - 8], __float_as_uint(s2)); }
            bf16_t* dst = vec < 8 ? Q1 + ((size_t)(b * 8 + vec) * LT + pos0 + rr) * 64 : K1 + ((size_t)(b * 2 + (vec - 8)) * LT + pos0 + rr) * 64;
#pragma unroll
            for (int c8 = 0; c8 < 8; ++c8) {
                uint4 w; w.x = pk_bf16(x[c8 * 8], x[c8 * 8 + 1]); w.y = pk_bf16(x[c8 * 8 + 2], x[c8 * 8 + 3]); w.z = pk_bf16(x[c8 * 8 + 4], x[c8 * 8 + 5]); w.w = pk_bf16(x[c8 * 8 + 6], x[c8 * 8 + 7]);
                *(uint4*)(dst + c8 * 8) = w;
            }
        }
#pragma unroll
        for (int c8 = 0; c8 < 8; ++c8) rw[c8] = rn[c8];
    }
    __syncthreads();
    if (t < 2) atomicMax(&p.kmax[32 + b * 2 + t], lmax[t]);
#pragma unroll
    for (int it = 0; it < 4; ++it) {
        const int idx = t + NTHR * it, rr = idx >> 4, c16 = idx & 15;
        *(uint4*)(tile + rr * 136 + c16 * 8) = *(const uint4*)(raw + (size_t)(r0 + rr) * CD_INP + 640 + c16 * 8);
    }
    __syncthreads();
    vt_write<128, 136>(tile, VT1 + (size_t)b * 128 * LT, pos0);
    {
        uint2 wq[16]; unsigned wk[16];
#pragma unroll
        for (int rr = 0; rr < 16; ++rr) {
            const bf16_t* src = raw + (size_t)(r0 + wave * 16 + rr) * CD_INP;
            wq[rr] = *(const uint2*)(src + 768 + lane * 4);
            wk[rr] = *(const unsigned*)(src + 1024 + lane * 2);
        }
        const float4 nwq = *(const float4*)(p.in[22] + lane * 4);
        const float2 nwk = *(const float2*)(p.in[23] + lane * 2);
#pragma unroll
        for (int rr = 0; rr < 16; ++rr) {
            const int r = r0 + wave * 16 + rr;
            {
                const float a = bflo(wq[rr].x), bb = bfhi(wq[rr].x), cc = bflo(wq[rr].y), d = bfhi(wq[rr].y);
                const float ss = wave_sum(a * a + bb * bb + cc * cc + d * d);
                const float rinv = rsqrtf(ss * (1.f / 256.f) + EPSV);
                uint2 o; o.x = pk_bf16(a * rinv * nwq.x, bb * rinv * nwq.y); o.y = pk_bf16(cc * rinv * nwq.z, d * rinv * nwq.w);
                *(uint2*)(CQn + (size_t)r * 256 + lane * 4) = o;
            }
            {
                const float a = bflo(wk[rr]), bb = bfhi(wk[rr]);
                const float ss = wave_sum(a * a + bb * bb);
                const float rinv = rsqrtf(ss * (1.f / 128.f) + EPSV);
                *(unsigned*)(CKVn + (size_t)r * 128 + lane * 2) = pk_bf16(a * rinv * nwk.x, bb * rinv * nwk.y);
            }
        }
    }
    if (t < 64) {
        const int r = r0 + t;
        const bf16_t* src = raw + (size_t)r * CD_INP + 1152;
        const uint4 w0 = *(const uint4*)src, w1 = *(const uint4*)(src + 8);
        float x[16] = {bflo(w0.x), bfhi(w0.x), bflo(w0.y), bfhi(w0.y), bflo(w0.z), bfhi(w0.z), bflo(w0.w), bfhi(w0.w),
                       bflo(w1.x), bfhi(w1.x), bflo(w1.y), bfhi(w1.y), bflo(w1.z), bfhi(w1.z), bflo(w1.w), bfhi(w1.w)};
        if (lat) {
#pragma unroll
            for (int i = 0; i < 4; ++i) {
                const float cr = p.tab[TB_CR4 + gr * 4 + i], sr = p.tab[TB_SR4 + gr * 4 + i], cc = p.tab[TB_CC4 + t * 4 + i], sc = p.tab[TB_SC4 + t * 4 + i];
                const float a = x[i], bb = x[i + 4]; x[i] = a * cr - bb * sr; x[i + 4] = a * sr + bb * cr;
                const float c2 = x[8 + i], d2 = x[12 + i]; x[8 + i] = c2 * cc - d2 * sc; x[12 + i] = c2 * sc + d2 * cc;
            }
        }
        uint4 o0, o1;
        o0.x = pk_bf16(x[0], x[1]); o0.y = pk_bf16(x[2], x[3]); o0.z = pk_bf16(x[4], x[5]); o0.w = pk_bf16(x[6], x[7]);
        o1.x = pk_bf16(x[8], x[9]); o1.y = pk_bf16(x[10], x[11]); o1.z = pk_bf16(x[12], x[13]); o1.w = pk_bf16(x[14], x[15]);
        *(uint4*)(KR + (size_t)r * 16) = o0; *(uint4*)(KR + (size_t)r * 16 + 8) = o1;
    }
    __syncthreads();
}

DI void postproj1c_unit(const Params& p, int u, char* smem) {
    const bf16_t* MQraw = (const bf16_t*)p.x1;
    const bf16_t* MKVraw = MQraw + (size_t)NT * 384;
    const bf16_t* KR = (const bf16_t*)(p.x1 + (size_t)NT * CD_INP * 2) + (size_t)NT * 256 + (size_t)NT * 128;
    bf16_t* MQ = (bf16_t*)p.x2 + (size_t)NB * 8 * LT * 64 + (size_t)NB * 2 * LT * 64 + (size_t)NB * 2 * 64 * LT;
    bf16_t* MK = MQ + (size_t)NB * 8 * LT * 48;
    bf16_t* MVT = MK + (size_t)NB * 8 * LT * 48;
    bf16_t* tile = (bf16_t*)smem;
    unsigned* lmax = (unsigned*)(smem + 32768);
    const int t = tid();
    const int r0 = u * 64, b = r0 / LT, pos0 = r0 - b * LT;
    const bool lat = pos0 >= LC;
    const int gr = lat ? (pos0 - LC) >> 6 : 0;
    if (t < 16) lmax[t] = 0u;
    __syncthreads();
#pragma unroll 1
    for (int it = 0; it < 2; ++it) {
        const int item = t + NTHR * it, rr = item >> 3, hd = item & 7, r = r0 + rr;
        {
            const bf16_t* src = MQraw + (size_t)r * 384 + hd * 48;
            bf16_t* dst = MQ + ((size_t)(b * 8 + hd) * LT + pos0 + rr) * 48;
#pragma unroll
            for (int c8 = 0; c8 < 4; ++c8) *(uint4*)(dst + c8 * 8) = *(const uint4*)(src + c8 * 8);
            const uint4 w0 = *(const uint4*)(src + 32), w1 = *(const uint4*)(src + 40);
            float x[16] = {bflo(w0.x), bfhi(w0.x), bflo(w0.y), bfhi(w0.y), bflo(w0.z), bfhi(w0.z), bflo(w0.w), bfhi(w0.w),
                           bflo(w1.x), bfhi(w1.x), bflo(w1.y), bfhi(w1.y), bflo(w1.z), bfhi(w1.z), bflo(w1.w), bfhi(w1.w)};
            if (lat) {
#pragma unroll
                for (int i = 0; i < 4; ++i) {
                    const float cr = p.tab[TB_CR4 + gr * 4 + i], sr = p.tab[TB_SR4 + gr * 4 + i], cc = p.tab[TB_CC4 + rr * 4 + i], sc = p.tab[TB_SC4 + rr * 4 + i];
                    const float a = x[i], bb = x[i + 4]; x[i] = a * cr - bb * sr; x[i + 4] = a * sr + bb * cr;
                    const float c2 = x[8 + i], d2 = x[12 + i]; x[8 + i] = c2 * cc - d2 * sc; x[12 + i] = c2 * sc + d2 * cc;
                }
            }
            uint4 o0, o1;
            o0.x = pk_bf16(x[0], x[1]); o0.y = pk_bf16(x[2], x[3]); o0.z = pk_bf16(x[4], x[5]); o0.w = pk_bf16(x[6], x[7]);
            o1.x = pk_bf16(x[8], x[9]); o1.y = pk_bf16(x[10], x[11]); o1.z = pk_bf16(x[12], x[13]); o1.w = pk_bf16(x[14], x[15]);
            *(uint4*)(dst + 32) = o0; *(uint4*)(dst + 40) = o1;
        }
        {
            const bf16_t* src = MKVraw + (size_t)r * 768 + hd * 96;
            bf16_t* dst = MK + ((size_t)(b * 8 + hd) * LT + pos0 + rr) * 48;
            float s2 = 0.f;
#pragma unroll
            for (int c8 = 0; c8 < 6; ++c8) {
                const uint4 w = c8 < 4 ? *(const uint4*)(src + c8 * 8) : *(const uint4*)(KR + (size_t)r * 16 + (c8 - 4) * 8);
                *(uint4*)(dst + c8 * 8) = w;
                s2 += bflo(w.x) * bflo(w.x) + bfhi(w.x) * bfhi(w.x) + bflo(w.y) * bflo(w.y) + bfhi(w.y) * bfhi(w.y) + bflo(w.z) * bflo(w.z) + bfhi(w.z) * bfhi(w.z) + bflo(w.w) * bflo(w.w) + bfhi(w.w) * bfhi(w.w);
            }
            atomicMax(&lmax[hd], __float_as_uint(s2));
        }
    }
    __syncthreads();
    if (t < 8) atomicMax(&p.kmax[40 + b * 8 + t], lmax[t]);
    {
        const int rra = t >> 3, c8a = t & 7;
        const bf16_t* va_p = MKVraw + (size_t)(r0 + rra) * 768 + 32 + c8a * 8;
        const bf16_t* vb_p = va_p + (size_t)32 * 768;
        uint4 va = *(const uint4*)va_p, vb = *(const uint4*)vb_p;
        for (int hd = 0; hd < 8; ++hd) {
            __syncthreads();
            *(uint4*)(tile + rra * 72 + c8a * 8) = va;
            *(uint4*)(tile + (rra + 32) * 72 + c8a * 8) = vb;
            const int hn = hd < 7 ? hd + 1 : 7;
            va = *(const uint4*)(va_p + hn * 96); vb = *(const uint4*)(vb_p + hn * 96);
            __syncthreads();
            vt_write<64, 72>(tile, MVT + (size_t)(b * 8 + hd) * 64 * LT, pos0);
        }
    }
    __syncthreads();
}

template <int MODE>
DI void lru_unit(const Params& p, int u, char* smem) {
    const bf16_t* UG = (const bf16_t*)(p.x1 + (size_t)NT * 1536 * 2);
    bf16_t* CAT = (bf16_t*)p.x4;
    bf16_t* ys = (bf16_t*)smem;
    float* AB = (float*)(smem + 64 * 72 * 2);
    const int t = tid(), lane = t & 63, wave = t >> 6, l32 = lane & 31, h = lane >> 5;
    const int n = u & 7, ci = (u >> 3) % NCHUNK_T, b = (u >> 3) / NCHUNK_T;
    const int pos0 = ci * 64, r0 = b * LT + pos0;
    const int seq_lo = ci < 4 ? 0 : LC, seq_hi = ci < 4 ? LC : LT;
    {
        const int c = t & 63, tq = t >> 6, cg = n * 64 + c;
        const float w0 = p.in[11][cg], w1 = p.in[11][512 + cg], w2 = p.in[11][1024 + cg], w3 = p.in[11][1536 + cg], cb = p.in[12][cg];
        const int tp = pos0 + tq * 16;
        float uv[19];
#pragma unroll
        for (int i = 0; i < 19; ++i) { const int pos = tp - 2 + i; const int pc = pos < seq_lo ? seq_lo : (pos >= seq_hi ? seq_hi - 1 : pos);
            const float v = bf2f(UG[(size_t)(b * LT + pc) * 1024 + cg]); uv[i] = (pos >= seq_lo && pos < seq_hi) ? v : 0.f; }
#pragma unroll
        for (int tt = 0; tt < 16; ++tt) {
            const float y = cb + w0 * uv[tt] + w1 * uv[tt + 1] + w2 * uv[tt + 2] + w3 * uv[tt + 3];
            ys[(tq * 16 + tt) * 72 + c] = f2bf(y);
        }
    }
    __syncthreads();
    {
        const int d = wave >> 1, jh = wave & 1;
        f32x16 acc[2][2];
#pragma unroll
        for (int i = 0; i < 2; ++i)
#pragma unroll
            for (int j = 0; j < 2; ++j)
#pragma unroll
                for (int e = 0; e < 16; ++e) acc[i][j][e] = 0.f;
        const bf16_t* ap = ys + l32 * 72 + h * 8;
        const bf16_t* bp = p.lw + ((size_t)(((n * 2 + d) * 2 + jh) * 2) * 32 + l32) * 64 + h * 8;
#pragma unroll
        for (int ks = 0; ks < 4; ++ks) {
            const bf16x8 fa0 = *(const bf16x8*)(ap + ks * 16), fa1 = *(const bf16x8*)(ap + 32 * 72 + ks * 16);
            const bf16x8 fb0 = *(const bf16x8*)(bp + ks * 16), fb1 = *(const bf16x8*)(bp + 32 * 64 + ks * 16);
            acc[0][0] = MFMA32(fa0, fb0, acc[0][0]); acc[0][1] = MFMA32(fa0, fb1, acc[0][1]);
            acc[1][0] = MFMA32(fa1, fb0, acc[1][0]); acc[1][1] = MFMA32(fa1, fb1, acc[1][1]);
        }
        const int ch = jh * 32 + l32, cg = n * 64 + ch;
        const float ba = p.in[14][(d * 8 + n) * 64 + ch], bx = p.in[16][(d * 8 + n) * 64 + ch];
        const float lam = p.in[17][(d * 8 + n) * 64 + ch];
        const float sp = log1pf(expf(-lam));
        (void)cg;
#pragma unroll
        for (int mi = 0; mi < 2; ++mi)
#pragma unroll
            for (int i = 0; i < 16; ++i) {
                const int tm = mi * 32 + acc_row(i, h);
                AB[((d * 2 + 0) * 64 + tm) * 64 + ch] = acc[mi][0][i] + ba;
                AB[((d * 2 + 1) * 64 + tm) * 64 + ch] = acc[mi][1][i] + bx;
            }
#pragma unroll 2
        for (int e = 0; e < 32; ++e) {
            const int tm = (e >> 4) * 32 + acc_row(e & 15, h);
            float* pa = AB + ((d * 2 + 0) * 64 + tm) * 64 + ch;
            float* pb = AB + ((d * 2 + 1) * 64 + tm) * 64 + ch;
            const float r = sigm(*pa), ig = sigm(*pb);
            const float la = -8.f * r * sp;
            const float a = __builtin_amdgcn_exp2f(1.4426950408889634f * la);
            const float bb = __builtin_amdgcn_sqrtf(fmaxf(1.f - a * a, 0.f)) * ig * bf2f(ys[tm * 72 + ch]);
            *pa = a; *pb = bb;
        }
    }
    __syncthreads();
    if (t < 128) {
        const int d = t >> 6, c = t & 63, cg = n * 64 + c;
        const float* Aa = AB + (d * 2 + 0) * 4096 + c;
        float* Bb = AB + (d * 2 + 1) * 4096 + c;
        const size_t aidx = ((size_t)(b * NCHUNK_T + ci) * 2 + d) * 512 + cg;
        if (MODE == 1) {
            float hh = 0.f, P = 1.f;
#pragma unroll 4
            for (int s = 0; s < 64; ++s) { const int tt = d ? 63 - s : s; const float a = Aa[tt * 64]; hh = a * hh + Bb[tt * 64]; P *= a; }
            *(float2*)(p.agg + aidx * 2) = make_float2(P, hh);
        } else {
            float hh = p.carry[aidx];
#pragma unroll 4
            for (int s = 0; s < 64; ++s) { const int tt = d ? 63 - s : s; hh = Aa[tt * 64] * hh + Bb[tt * 64]; Bb[tt * 64] = hh; }
        }
    }
    __syncthreads();
    if (MODE == 3) {
        const int c = t & 63, tq = t >> 6, cg = n * 64 + c;
        float gv[16];
#pragma unroll
        for (int tt = 0; tt < 16; ++tt) gv[tt] = bf2f(UG[(size_t)(r0 + tq * 16 + tt) * 1024 + 512 + cg]);
#pragma unroll
        for (int tt = 0; tt < 16; ++tt) {
            const int tm = tq * 16 + tt;
            const float hs = AB[(1 * 64 + tm) * 64 + c] + AB[(3 * 64 + tm) * 64 + c];
            CAT[(size_t)(r0 + tm) * DM + 512 + cg] = f2bf(hs * gelu_tanh(gv[tt]));
        }
        __syncthreads();
    }
}
DI void lru_carry_unit(const Params& p, int v) {
    const int id = v * NTHR + tid();
    const int cg = id & 511, d = (id >> 9) & 1, b = id >> 10;
    float carry = 0.f;
    for (int s0 = 0; s0 < NCHUNK_T; s0 += 12) {
        float2 ag[12]; size_t ai[12];
#pragma unroll
        for (int j = 0; j < 12; ++j) {
            const int s = s0 + j;
            int ci;
            if (d == 0) ci = s; else ci = s < 4 ? 3 - s : NCHUNK_T - 1 - (s - 4);
            ai[j] = ((size_t)(b * NCHUNK_T + ci) * 2 + d) * 512 + cg;
            ag[j] = *(const float2*)(p.agg + ai[j] * 2);
        }
#pragma unroll
        for (int j = 0; j < 12; ++j) { p.carry[ai[j]] = carry; carry = ag[j].x * carry + ag[j].y; }
    }
}

DI float grp8_max(float v) { v = fmaxf(v, __shfl_xor(v, 1)); v = fmaxf(v, __shfl_xor(v, 2)); v = fmaxf(v, __shfl_xor(v, 4)); return v; }
constexpr int XP = 1032;
typedef float f32x4_t __attribute__((ext_vector_type(4)));
DI void norm2_router_unit(const Params& p, int layer, int r0, char* smem) {
    bf16_t* xh = (bf16_t*)smem;
    bf16_t* xl = xh + 16 * XP;
    float* lg = (float*)(xl + 16 * XP);
    float* ch = lg + 16 * 64;
    int* hist = (int*)(ch + 16 * 64);
    bf16_t* H2 = (bf16_t*)p.x4;
    const int t = tid(), lane = t & 63, wave = t >> 6;
    if (t < NSEGC) hist[t] = 0;
    const int l15 = lane & 15, q = lane >> 4;
    const bf16_t* bh = p.rwh + ((size_t)layer * 64 + wave * 16 + l15) * 1024 + q * 8;
    const bf16_t* bl = p.rwl + ((size_t)layer * 64 + wave * 16 + l15) * 1024 + q * 8;
    bf16x8 wA[8][2], wB[8][2];
#define RT_LOADW(w, k0) do { _Pragma("unroll") for (int i_ = 0; i_ < 8; ++i_) { w[i_][0] = *(const bf16x8*)(bh + ((k0) + i_) * 32); w[i_][1] = *(const bf16x8*)(bl + ((k0) + i_) * 32); } } while (0)
    RT_LOADW(wA, 0);
    {
        float4 v[4][4]; float ssv[4];
#pragma unroll
        for (int rr = 0; rr < 4; ++rr) {
            const float* src = res_row(p, r0 + wave * 4 + rr);
#pragma unroll
            for (int i = 0; i < 4; ++i) v[rr][i] = *(const float4*)(src + lane * 4 + 256 * i);
        }
#pragma unroll
        for (int rr = 0; rr < 4; ++rr) {
            float ss = 0.f;
#pragma unroll
            for (int i = 0; i < 4; ++i) ss += v[rr][i].x * v[rr][i].x + v[rr][i].y * v[rr][i].y + v[rr][i].z * v[rr][i].z + v[rr][i].w * v[rr][i].w;
            ssv[rr] = wave_sum(ss);
        }
#pragma unroll
        for (int rr = 0; rr < 4; ++rr) {
            const int lr = wave * 4 + rr, r = r0 + lr;
            const float* md = p.mod + (size_t)(layer * 5 + mod_row(r)) * 6144 + 3072;
            const float rinv = rsqrtf(ssv[rr] * (1.f / 1024.f) + EPSV);
#pragma unroll
            for (int i = 0; i < 4; ++i) {
                const int c = lane * 4 + 256 * i;
                const float4 sh = *(const float4*)(md + c), sc = *(const float4*)(md + 1024 + c);
                float4 o;
                o.x = v[rr][i].x * rinv * (1.f + sc.x) + sh.x; o.y = v[rr][i].y * rinv * (1.f + sc.y) + sh.y; o.z = v[rr][i].z * rinv * (1.f + sc.z) + sh.z; o.w = v[rr][i].w * rinv * (1.f + sc.w) + sh.w;
                uint2 ob; ob.x = pk_bf16(o.x, o.y); ob.y = pk_bf16(o.z, o.w);
                *(uint2*)(H2 + (size_t)r * DM + c) = ob;
                *(uint2*)(xh + lr * XP + c) = ob;
                uint2 ol; ol.x = pk_bf16(o.x - bflo(ob.x), o.y - bfhi(ob.x)); ol.y = pk_bf16(o.z - bflo(ob.y), o.w - bfhi(ob.y));
                *(uint2*)(xl + lr * XP + c) = ol;
            }
        }
    }
    __syncthreads();
    {
        const bf16_t* ah = xh + l15 * XP + q * 8;
        const bf16_t* al = xl + l15 * XP + q * 8;
        f32x4_t acc = {0.f, 0.f, 0.f, 0.f};
#define RT_MMA(w, k0) do { _Pragma("unroll") for (int i_ = 0; i_ < 8; ++i_) { \
            const bf16x8 fah = *(const bf16x8*)(ah + ((k0) + i_) * 32), fal = *(const bf16x8*)(al + ((k0) + i_) * 32); \
            acc = __builtin_amdgcn_mfma_f32_16x16x32_bf16(fah, w[i_][0], acc, 0, 0, 0); \
            acc = __builtin_amdgcn_mfma_f32_16x16x32_bf16(fah, w[i_][1], acc, 0, 0, 0); \
            acc = __builtin_amdgcn_mfma_f32_16x16x32_bf16(fal, w[i_][0], acc, 0, 0, 0); } } while (0)
        RT_LOADW(wB, 8);  RT_MMA(wA, 0);
        RT_LOADW(wA, 16); RT_MMA(wB, 8);
        RT_LOADW(wB, 24); RT_MMA(wA, 16);
        RT_MMA(wB, 24);
#undef RT_LOADW
#undef RT_MMA
        const int e = wave * 16 + l15;
        const float bias = p.in[27][layer * 64 + e];
#pragma unroll
        for (int j = 0; j < 4; ++j) { const float s = sigm(acc[j]); lg[(q * 4 + j) * 64 + e] = s; ch[(q * 4 + j) * 64 + e] = s + bias; }
    }
    __syncthreads();
    for (int rr = 0; rr < 4; ++rr) {
        const int lr = wave * 4 + rr, r = r0 + lr;
        const float c = ch[lr * 64 + lane], s = lg[lr * 64 + lane];
        const int g = lane >> 3;
        const float m1 = grp8_max(c);
        const unsigned long long bal = __ballot(c == m1);
        const int first = __ffs((unsigned)((bal >> (8 * g)) & 0xffull)) - 1;
        const float m2 = grp8_max(((lane & 7) == first) ? -3.0e38f : c);
        const float gsc = m1 + m2;
        int grank = 0;
#pragma unroll
        for (int gi = 0; gi < 8; ++gi) { const float o = __shfl(gsc, gi * 8); grank += (o > gsc || (o == gsc && gi < g)) ? 1 : 0; }
        const bool gsel = grank < 4;
        const float cand = gsel ? c : -3.0e38f;
        int erank = 0;
#pragma unroll 8
        for (int e2 = 0; e2 < 64; ++e2) { const float o = __shfl(cand, e2); erank += (o > cand || (o == cand && e2 < lane)) ? 1 : 0; }
        const bool sel = gsel && erank < 8;
        const float wsum = wave_sum(sel ? s : 0.f);
        if (sel) { p.tk_e[(size_t)r * 8 + erank] = lane; p.tk_w[(size_t)r * 8 + erank] = s * 2.5f / wsum; atomicAdd(&hist[lane], 1); }
        if (lane == 0) atomicAdd(&hist[64], 1);
    }
    __syncthreads();
    if (t < NSEGC && hist[t] > 0) atomicAdd(&p.cnt[(layer * 2 + 0) * NSEG + (r0 / p.chrows) * NSEGC + t], hist[t]);
    __syncthreads();
}
DI void phase_norm2_router(const Params& p, int layer, char* smem) {
    if (layer == 0) { for (int u = unit_first(); u < NT / 16; u += gridDim.x) norm2_router_unit(p, 0, u * 16, smem); }
    else { for (int u = unit_first(); u < NB * LX / 16; u += gridDim.x) norm2_router_unit(p, 1, (u / (LX / 16)) * LT + LC + (u % (LX / 16)) * 16, smem); }
}

DI void slots_unit(const Params& p, int layer, int r0, char* smem) {
    int* soff = (int*)smem;
    int* lcnt = soff + 272;
    int* lbase = lcnt + 80;
    const int t = tid();
    const int* cnt = p.cnt + (layer * 2 + 0) * NSEG;
    int* fill = p.cnt + (layer * 2 + 1) * NSEG;
    int* wsum = lbase + 80;
    {
        const int lane = t & 63, wave = t >> 6, sA = 2 * t, sB = 2 * t + 1;
        const int cA = sA < NSEG ? __hip_atomic_load(cnt + sA, __ATOMIC_RELAXED, __HIP_MEMORY_SCOPE_AGENT) : 0;
        const int cB = sB < NSEG ? __hip_atomic_load(cnt + sB, __ATOMIC_RELAXED, __HIP_MEMORY_SCOPE_AGENT) : 0;
        int ic = cA + cB;
#pragma unroll
        for (int o = 1; o < 64; o <<= 1) { const int vc = shfl_up_i(ic, o, lane); if (lane >= o) ic += vc; }
        if (lane == 63) wsum[wave] = ic;
        if (t < NSEGC) lcnt[t] = 0;
        __syncthreads();
        int oc = 0;
#pragma unroll
        for (int w = 0; w < 4; ++w) if (w < wave) oc += wsum[w];
        const int ex = oc + ic - cA - cB;
        if (sA <= NSEG) soff[sA] = ex;
        if (sB <= NSEG) soff[sB] = ex + cA;
    }
    __syncthreads();
    const int r = r0 + t, cbase = (r0 / p.chrows) * NSEGC;
    int e[9], loc[9]; float w[9];
#pragma unroll
    for (int k = 0; k < 8; ++k) { e[k] = p.tk_e[(size_t)r * 8 + k]; w[k] = p.tk_w[(size_t)r * 8 + k]; }
    e[8] = 64; w[8] = 1.f;
#pragma unroll
    for (int k = 0; k < 9; ++k) loc[k] = atomicAdd(&lcnt[e[k]], 1);
    __syncthreads();
    if (t < NSEGC) lbase[t] = lcnt[t] > 0 ? atomicAdd(&fill[cbase + t], lcnt[t]) : 0;
    __syncthreads();
#pragma unroll
    for (int k = 0; k < 9; ++k) {
        const int pos = soff[cbase + e[k]] + lbase[e[k]] + loc[k];
        p.ppos[(size_t)r * 16 + k] = pos; p.stok[pos] = r; p.sw[pos] = w[k];
    }
    __syncthreads();
}
DI void phase_slots(const Params& p, int layer, char* smem) {
    if (layer == 0) { for (int u = unit_first(); u < NT / 256; u += gridDim.x) slots_unit(p, 0, u * 256, smem); }
    else { for (int u = unit_first(); u < NB * LX / 256; u += gridDim.x) slots_unit(p, 1, (u / (LX / 256)) * LT + LC + (u % (LX / 256)) * 256, smem); }
}

constexpr int SEG_LDS_OFF = 68608;
DI void seg_tables(const Params& p, int layer, int s_lo, int s_hi, int* soff, int* toff) {
    const int* cnt = p.cnt + (layer * 2 + 0) * NSEG;
    int* wsum = toff + 272;
    const int t = tid(), lane = t & 63, wave = t >> 6;
    const int sA = 2 * t, sB = 2 * t + 1;
    const int cA = sA < NSEG ? __hip_atomic_load(cnt + sA, __ATOMIC_RELAXED, __HIP_MEMORY_SCOPE_AGENT) : 0;
    const int cB = sB < NSEG ? __hip_atomic_load(cnt + sB, __ATOMIC_RELAXED, __HIP_MEMORY_SCOPE_AGENT) : 0;
    const int tA = (sA >= s_lo && sA < s_hi) ? (cA + 127) >> 7 : 0, tB = (sB >= s_lo && sB < s_hi) ? (cB + 127) >> 7 : 0;
    int ic = cA + cB, it = tA + tB;
#pragma unroll
    for (int o = 1; o < 64; o <<= 1) { const int vc = shfl_up_i(ic, o, lane), vt = shfl_up_i(it, o, lane); if (lane >= o) { ic += vc; it += vt; } }
    if (lane == 63) { wsum[wave * 2] = ic; wsum[wave * 2 + 1] = it; }
    __syncthreads();
    int oc = 0, ot = 0;
#pragma unroll
    for (int w = 0; w < 4; ++w) if (w < wave) { oc += wsum[w * 2]; ot += wsum[w * 2 + 1]; }
    const int exA_c = oc + ic - cA - cB, exA_t = ot + it - tA - tB;
    if (sA >= s_lo && sA < s_hi) { soff[sA - s_lo] = exA_c; toff[sA - s_lo] = exA_t; }
    if (sB >= s_lo && sB < s_hi) { soff[sB - s_lo] = exA_c + cA; toff[sB - s_lo] = exA_t + tA; }
    if (sA + 1 == s_hi) { soff[s_hi - s_lo] = exA_c + cA; toff[s_hi - s_lo] = exA_t + tA; }
    if (sB + 1 == s_hi) { soff[s_hi - s_lo] = exA_c + cA + cB; toff[s_hi - s_lo] = exA_t + tA + tB; }
    __syncthreads();
}
DI int seg_find(const int* toff, int nseg, int tile) {
    int lo = 0, hi = nseg;
    while (hi - lo > 1) { const int mid = (lo + hi) >> 1; if (toff[mid] <= tile) lo = mid; else hi = mid; }
    return lo;
}
struct EpiGateUp {
    bf16_t* HID; const float* sw; int pos_end;
    DI void operator()(const float* ct, int row0, int col0) const {
#pragma unroll 2
        for (int it = 0; it < 4; ++it) {
            const int idx = tid() + NTHR * it, row = idx >> 3, wn = (idx >> 2) & 1, j0 = (idx & 3) * 8, pos = row0 + row;
            if (pos < pos_end) {
                const float* gp = ct + row * CT_LD + wn * 64 + j0;
                const float w = sw[pos];
                float o[8];
#pragma unroll
                for (int j = 0; j < 8; ++j) o[j] = silu_f(gp[j]) * gp[32 + j] * w;
                uint4 ov; ov.x = pk_bf16(o[0], o[1]); ov.y = pk_bf16(o[2], o[3]); ov.z = pk_bf16(o[4], o[5]); ov.w = pk_bf16(o[6], o[7]);
                *(uint4*)(HID + (size_t)pos * FF + ((col0 >> 6) + wn) * 32 + j0) = ov;
            }
        }
    }
};
struct EpiRowsBf16 {
    bf16_t* O; int ld; int rbase; int row_end;
    DI void operator()(const float* ct, int row0, int col0) const {
#pragma unroll 2
        for (int it = 0; it < 8; ++it) {
            const int idx = tid() + NTHR * it, row = idx >> 4, c8 = (idx & 15) * 8;
            if (row0 + row < row_end) *(uint4*)(O + (size_t)(row0 + row - rbase) * ld + col0 + c8) = pack8(ct + row * CT_LD + c8);
        }
    }
};
DI void phase_moe_gemm1(const Params& p, int layer, char* smem) {
    int* soff = (int*)(smem + SEG_LDS_OFF); int* toff = soff + 272;
    seg_tables(p, layer, 0, NSEG, soff, toff);
    const int ntiles = toff[NSEG];
    const bf16_t* H2 = (const bf16_t*)p.x4;
    bf16_t* HID = (bf16_t*)p.x1;
    auto unit_fn = [&](int u, int srow, int wave, int lane) {
        const int tile = u >> 1, nt = u & 1;
        const int s = seg_find(toff, NSEG, tile), e = s % NSEGC;
        const int pos0 = soff[s] + (tile - toff[s]) * 128, pos_end = soff[s + 1];
        int p0 = pos0 + srow, p1 = p0 + 32, p2 = p0 + 64, p3 = p0 + 96;
        if (p0 >= pos_end) p0 = pos_end - 1;
        if (p1 >= pos_end) p1 = pos_end - 1;
        if (p2 >= pos_end) p2 = pos_end - 1;
        if (p3 >= pos_end) p3 = pos_end - 1;
        const int t0 = p.stok[p0], t1 = p.stok[p1], t2 = p.stok[p2], t3 = p.stok[p3];
        const bf16_t* bw = p.ew1 + ((size_t)e * 512 + nt * 256 + wave * 64) * 1024 + lane * 8;
        return GUnit<WEpiGateUp>{H2 + (size_t)t0 * DM, H2 + (size_t)t1 * DM, H2 + (size_t)t2 * DM, H2 + (size_t)t3 * DM, bw, pos0, nt * 256, 1024, WEpiGateUp{HID, p.sw, pos_end}};
    };
    gemm_stream_w<WEpiGateUp>(ntiles * 2, unit_fn, smem, (const char*)p.bar);
}
DI void phase_moe_gemm2(const Params& p, int layer, int chunk, char* smem) {
    int* soff = (int*)(smem + SEG_LDS_OFF); int* toff = soff + 272;
    seg_tables(p, layer, chunk * NSEGC, (chunk + 1) * NSEGC, soff, toff);
    const int ntiles = toff[NSEGC];
    const bf16_t* HID = (const bf16_t*)p.x1;
    unsigned char* YP = (unsigned char*)p.x2;
    const int cbase = soff[0];
    auto unit_fn = [&](int u, int srow, int wave, int lane) {
        const int tile = u >> 2, nt = u & 3;
        const int e = seg_find(toff, NSEGC, tile);
        const int pos0 = soff[e] + (tile - toff[e]) * 128, pos_end = soff[e + 1];
        int p0 = pos0 + srow, p1 = p0 + 32, p2 = p0 + 64, p3 = p0 + 96;
        if (p0 >= pos_end) p0 = pos_end - 1;
        if (p1 >= pos_end) p1 = pos_end - 1;
        if (p2 >= pos_end) p2 = pos_end - 1;
        if (p3 >= pos_end) p3 = pos_end - 1;
        const bf16_t* bw = p.ew2 + ((size_t)e * 1024 + nt * 256 + wave * 64) * 256 + lane * 8;
        return GUnit<WEpiRows8>{HID + (size_t)p0 * FF, HID + (size_t)p1 * FF, HID + (size_t)p2 * FF, HID + (size_t)p3 * FF, bw, pos0, nt * 256, 256, WEpiRows8{YP, cbase, pos_end}};
    };
    gemm_stream_w<WEpiRows8>(ntiles * 4, unit_fn, smem, (const char*)p.bar);
}
DI void phase_moe_combine(const Params& p, int layer, int chunk, char* smem) {
    int* soff = (int*)(smem + SEG_LDS_OFF); int* toff = soff + 272;
    seg_tables(p, layer, chunk * NSEGC, (chunk + 1) * NSEGC, soff, toff);
    const int cbase = soff[0];
    const unsigned char* YP = (const unsigned char*)p.x2;
    const int lane = tid() & 63, wave = tid() >> 6;
    const int rbeg = chunk * p.chrows;
    for (int u = unit_first(); u < p.chrows / 4; u += gridDim.x) {
        const int r = rbeg + u * 4 + wave;
        if (layer == 1 && (r % LT) < LC) continue;
        float* rp = res_row(p, r);
        const float* g2 = p.mod + (size_t)(layer * 5 + mod_row(r)) * 6144 + 5120;
        const int4 pp0 = *(const int4*)(p.ppos + (size_t)r * 16), pp1 = *(const int4*)(p.ppos + (size_t)r * 16 + 4);
        const int pp8 = p.ppos[(size_t)r * 16 + 8];
        const int ppv[9] = {pp0.x, pp0.y, pp0.z, pp0.w, pp1.x, pp1.y, pp1.z, pp1.w, pp8};
        uint4 yw[9];
#pragma unroll
        for (int k = 0; k < 9; ++k) yw[k] = *(const uint4*)(YP + (size_t)(ppv[k] - cbase) * DM + lane * 16);
        const int c0 = lane * 16;
        float4 gv[4], xv[4];
#pragma unroll
        for (int i = 0; i < 4; ++i) { gv[i] = *(const float4*)(g2 + c0 + 4 * i); xv[i] = *(const float4*)(rp + c0 + 4 * i); }
        float a[16];
#pragma unroll
        for (int j = 0; j < 16; ++j) a[j] = 0.f;
#pragma unroll
        for (int k = 0; k < 9; ++k) {
            const int dw[4] = {(int)yw[k].x, (int)yw[k].y, (int)yw[k].z, (int)yw[k].w};
#pragma unroll
            for (int d = 0; d < 4; ++d) {
                const f32x2_t lo = __builtin_amdgcn_cvt_pk_f32_fp8(dw[d], false), hi = __builtin_amdgcn_cvt_pk_f32_fp8(dw[d], true);
                a[4 * d] += lo[0]; a[4 * d + 1] += lo[1]; a[4 * d + 2] += hi[0]; a[4 * d + 3] += hi[1];
            }
        }
        constexpr float UNS = 1.f / YP_SCALE;
        float ss = 0.f;
#pragma unroll
        for (int i = 0; i < 4; ++i) {
            a[4 * i] = xv[i].x + gv[i].x * UNS * a[4 * i]; a[4 * i + 1] = xv[i].y + gv[i].y * UNS * a[4 * i + 1];
            a[4 * i + 2] = xv[i].z + gv[i].z * UNS * a[4 * i + 2]; a[4 * i + 3] = xv[i].w + gv[i].w * UNS * a[4 * i + 3];
            ss += a[4 * i] * a[4 * i] + a[4 * i + 1] * a[4 * i + 1] + a[4 * i + 2] * a[4 * i + 2] + a[4 * i + 3] * a[4 * i + 3];
        }
        ss = wave_sum(ss);
        const float rinv = rsqrtf(ss * (1.f / 1024.f) + EPSV);
        if (layer == 0) {
            const float* md1 = p.mod + (size_t)(5 + mod_row(r)) * 6144;
            unsigned ob[8];
#pragma unroll
            for (int i = 0; i < 4; ++i) {
                *(float4*)(rp + c0 + 4 * i) = make_float4(a[4 * i], a[4 * i + 1], a[4 * i + 2], a[4 * i + 3]);
                const float4 sh = *(const float4*)(md1 + c0 + 4 * i), sc = *(const float4*)(md1 + 1024 + c0 + 4 * i);
                ob[2 * i] = pk_bf16(a[4 * i] * rinv * (1.f + sc.x) + sh.x, a[4 * i + 1] * rinv * (1.f + sc.y) + sh.y);
                ob[2 * i + 1] = pk_bf16(a[4 * i + 2] * rinv * (1.f + sc.z) + sh.z, a[4 * i + 3] * rinv * (1.f + sc.w) + sh.w);
            }
            *(uint4*)(p.h1 + (size_t)r * DM + c0) = make_uint4(ob[0], ob[1], ob[2], ob[3]);
            *(uint4*)(p.h1 + (size_t)r * DM + c0 + 8) = make_uint4(ob[4], ob[5], ob[6], ob[7]);
        } else {
#pragma unroll
            for (int i = 0; i < 4; ++i) {
                const float4 f = *(const float4*)(p.in[34] + c0 + 4 * i);
                *(float4*)(rp + c0 + 4 * i) = make_float4(a[4 * i] * rinv * f.x, a[4 * i + 1] * rinv * f.y, a[4 * i + 2] * rinv * f.z, a[4 * i + 3] * rinv * f.w);
            }
        }
    }
}

DI bool bg_first() { return (((blockIdx.x >> 3) + (blockIdx.x >> 8)) & 1u) == 0u; }
DI void bg_cvt_experts(const Params& p, int layer, char* smem) {
    for (int u = unit_first(); u < CVT_EXP_TILES; u += gridDim.x) cvt_expert(p, layer, u, smem);
    __syncthreads();
}
constexpr int N_PHASES = 22;
template <int PH, int NCHT>
DI void run_phase(const Params& p, char* smem, const XcdBarrier& bar) {
    if constexpr (PH == 0) phase_prologue(p, smem);
    else if constexpr (PH == 1) phase_norm1(p, 0);
    else if constexpr (PH == 2) {
        WEpiInProj0 epi{&p};
        gemm_phase_w((const char*)p.bar, (const bf16_t*)p.x4, DM, p.w_in0, 1024, NT / 128, AB_IN / 256, smem, epi, RowIdent{});
    } else if constexpr (PH == 3) {
        for (int u = unit_first(); u < NB * NCHUNK_T * 8; u += gridDim.x) lru_unit<1>(p, u, smem);
    } else if constexpr (PH == 4) {
        const bool bf = bg_first();
        if (bf) bg_cvt_experts(p, 0, smem);
        for (int u = unit_first(); u < 16 + NB * 4 * 64 + NB * 4 * 2; u += gridDim.x) { if (u < 16) lru_carry_unit(p, u); else attn0_unit(p, u - 16, smem); }
        if (!bf) { __syncthreads(); bg_cvt_experts(p, 0, smem); }
    } else if constexpr (PH == 5) {
        for (int u = unit_first(); u < NB * NCHUNK_T * 8; u += gridDim.x) lru_unit<3>(p, u, smem);
    } else if constexpr (PH == 6) {
        WEpiResidual epi{&p, 0};
        gemm_phase_w((const char*)p.bar, (const bf16_t*)p.x4, DM, p.w_out0, 1024, NT / 128, 4, smem, epi, RowIdent{});
    } else if constexpr (PH == 7) phase_norm2_router(p, 0, smem);
    else if constexpr (PH == 8) phase_slots(p, 0, smem);
    else if constexpr (PH == 9) phase_moe_gemm1(p, 0, smem);
    else if constexpr (PH == 10) {
        phase_moe_gemm2(p, 0, 0, smem); xcd_barrier(bar); phase_moe_combine(p, 0, 0, smem); xcd_barrier(bar);
        phase_moe_gemm2(p, 0, 1, smem); xcd_barrier(bar); phase_moe_combine(p, 0, 1, smem);
        if constexpr (NCHT >= 3) {
            xcd_barrier(bar);
            phase_moe_gemm2(p, 0, 2, smem); xcd_barrier(bar); phase_moe_combine(p, 0, 2, smem);
        }
        if constexpr (NCHT == 4) {
            xcd_barrier(bar);
            phase_moe_gemm2(p, 0, 3, smem); xcd_barrier(bar); phase_moe_combine(p, 0, 3, smem);
        }
    } else if constexpr (PH == 11) {   }
    else if constexpr (PH == 12) {
        WEpiSplit epi{(bf16_t*)p.x1, CD_INP, (bf16_t*)p.x1, CD_INP, 1 << 30, 1 << 30};
        gemm_phase_w((const char*)p.bar, p.h1, DM, p.w_in1, 1024, NT / 128, CD_INP / 256, smem, epi, RowIdent{});
    } else if constexpr (PH == 13) {
        for (int u = unit_first(); u < NT / 64; u += gridDim.x) postproj1a_unit(p, u, smem);
    } else if constexpr (PH == 14) {
        bf16_t* CQn = (bf16_t*)(p.x1 + (size_t)NT * CD_INP * 2);
        bf16_t* CKVn = CQn + (size_t)NT * 256;
        bf16_t* MQraw = (bf16_t*)p.x1;
        bf16_t* MKVraw = MQraw + (size_t)NT * 384;
        auto unit_fn = [&](int u, int srow, int wave, int lane) {
            if (u < (NT / 128) * 2) {
                const int mt = u >> 1, nt = u & 1, row0 = mt * 128;
                const bf16_t* ap = CQn + (size_t)(row0 + srow) * 256;
                const bf16_t* bw = p.w_uq + (size_t)(nt * 256 + wave * 64) * 256 + lane * 8;
                return GUnit<WEpiSplit>{ap, ap + (size_t)32 * 256, ap + (size_t)64 * 256, ap + (size_t)96 * 256, bw, row0, nt * 256, 256, WEpiSplit{MQraw, 384, MQraw, 384, 1 << 30, 384}};
            }
            const int v = u - (NT / 128) * 2, mt = v / 3, nt = v - mt * 3, row0 = mt * 128;
            const bf16_t* ap = CKVn + (size_t)(row0 + srow) * 128;
            const bf16_t* bw = p.w_ukv + (size_t)(nt * 256 + wave * 64) * 128 + lane * 8;
            return GUnit<WEpiSplit>{ap, ap + (size_t)32 * 128, ap + (size_t)64 * 128, ap + (size_t)96 * 128, bw, row0, nt * 256, 128, WEpiSplit{MKVraw, 768, MKVraw, 768, 1 << 30, 768}};
        };
        gemm_stream_w<WEpiSplit>((NT / 128) * 5, unit_fn, smem, (const char*)p.bar);
    } else if constexpr (PH == 15) {
        for (int u = unit_first(); u < NT / 64; u += gridDim.x) postproj1c_unit(p, u, smem);
    } else if constexpr (PH == 16) {
        const bool bf = bg_first();
        if (bf) bg_cvt_experts(p, 1, smem);
        for (int u = unit_first(); u < 4096; u += gridDim.x) attn1_unit(p, u, smem);
        if (!bf) { __syncthreads(); bg_cvt_experts(p, 1, smem); }
    } else if constexpr (PH == 17) {
        WEpiResidual epi{&p, 1};
        gemm_phase_w((const char*)p.bar, (const bf16_t*)p.x4, DM, p.w_out1, 1024, NB * 64, 4, smem, epi, RowLatent{});
    } else if constexpr (PH == 18) phase_norm2_router(p, 1, smem);
    else if constexpr (PH == 19) phase_slots(p, 1, smem);
    else if constexpr (PH == 20) phase_moe_gemm1(p, 1, smem);
    else if constexpr (PH == 21) {
        phase_moe_gemm2(p, 1, 0, smem); xcd_barrier(bar); phase_moe_combine(p, 1, 0, smem); xcd_barrier(bar);
        phase_moe_gemm2(p, 1, 1, smem); xcd_barrier(bar); phase_moe_combine(p, 1, 1, smem);
        if constexpr (NCHT >= 3) {
            xcd_barrier(bar);
            phase_moe_gemm2(p, 1, 2, smem); xcd_barrier(bar); phase_moe_combine(p, 1, 2, smem);
        }
        if constexpr (NCHT == 4) {
            xcd_barrier(bar);
            phase_moe_gemm2(p, 1, 3, smem); xcd_barrier(bar); phase_moe_combine(p, 1, 3, smem);
        }
    }
}

extern __shared__ __attribute__((aligned(16))) char dyn_smem[];

template <int PH, int HI, int NCHT>
DI void run_range(const Params& p, char* smem, const XcdBarrier& bar) {
    if constexpr (PH < HI) {
        run_phase<PH, NCHT>(p, smem, bar);
        if constexpr ((MK_REPEAT_MASK >> PH) & 1ull) { __syncthreads(); run_phase<PH, NCHT>(p, smem, bar); }
        if constexpr (PH + 1 < HI) { if constexpr (PH != 11) xcd_barrier(bar); run_range<PH + 1, HI, NCHT>(p, smem, bar); }
    }
}

template <int LO, int HI, int NCHT>
__global__ void __launch_bounds__(NTHR, 2) __attribute__((amdgpu_waves_per_eu(2, 2))) mk_kernel(Params p) {
    char* smem = dyn_smem + SM_OFF;
    if (threadIdx.x == 0) *(uint4*)dyn_smem = make_uint4(0u, 0u, 0u, 0u);
    __syncthreads();
    XcdBarrier bar = xcd_barrier_post(p.bar, (volatile LAS unsigned*)dyn_smem);
    run_range<LO, HI, NCHT>(p, smem, bar);
}

static size_t align_up(size_t x, size_t a) { return (x + a - 1) / a * a; }

extern "C" void kernel_launch(void* const* d_in, const int* in_sizes, int n_in, void* d_out, int out_size, void* d_ws, size_t ws_size, hipStream_t stream) {
    (void)in_sizes; (void)n_in; (void)out_size; (void)ws_size;
    Params p;
    memset(&p, 0, sizeof(p));
    for (int i = 0; i < 35; ++i) p.in[i] = (const float*)d_in[i];
    p.out = (float*)d_out;
    char* ws = (char*)d_ws;
    size_t off = 0;
    auto take = [&](size_t bytes) { char* r = ws + off; off = align_up(off + bytes, 256); return r; };
    const size_t zero_bytes = 16384 + 8192;
    p.bar = (unsigned*)take(16384);
    p.cnt = (int*)take(8192);
    p.kmax = (unsigned*)(p.cnt + 1536);
    p.mod = (float*)take((size_t)2 * 5 * 6144 * 4);
    p.tab = (float*)take((size_t)TB_TOTAL * 4);
    p.lamv = (float*)take(256);
    p.w_in0 = (bf16_t*)take((size_t)2560 * 1024 * 2);
    p.w_out0 = (bf16_t*)take((size_t)1024 * 1024 * 2);
    p.w_in1 = (bf16_t*)take((size_t)1280 * 1024 * 2);
    p.w_out1 = (bf16_t*)take((size_t)1024 * 1024 * 2);
    p.w_uq = (bf16_t*)take((size_t)512 * 256 * 2);
    p.w_ukv = (bf16_t*)take((size_t)768 * 128 * 2);
    p.lw = (bf16_t*)take((size_t)64 * 32 * 64 * 2);
    p.rwh = (bf16_t*)take((size_t)2 * 64 * 1024 * 2);
    p.rwl = (bf16_t*)take((size_t)2 * 64 * 1024 * 2);
    p.ew1 = (bf16_t*)take((size_t)65 * 512 * 1024 * 2);
    p.ew2 = (bf16_t*)take((size_t)65 * 1024 * 256 * 2);
    p.rc = (float*)take((size_t)NB * LC * DM * 4);
    p.tk_e = (int*)take((size_t)NT * 8 * 4);
    p.tk_w = (float*)take((size_t)NT * 8 * 4);
    p.ppos = (int*)take((size_t)NT * 16 * 4);
    p.stok = (int*)take((size_t)NPAIR * 4);
    p.sw = (float*)take((size_t)NPAIR * 4);
    p.agg = (float*)take((size_t)NB * NCHUNK_T * 2 * 512 * 2 * 4);
    p.carry = (float*)take((size_t)NB * NCHUNK_T * 2 * 512 * 4);
    p.x1 = take((size_t)NT * 2560 * 2);
    p.x2 = take((size_t)NB * LT * 2048 * 2);
    p.x4 = take((size_t)NT * DM * 2);
    p.h1 = (bf16_t*)take((size_t)NT * DM * 2);
    p.nch = 2;
    p.chrows = NT / p.nch;
    static bool warned = false;
    if (off > ws_size && !warned) { fprintf(stderr, "workspace too small: need %zu have %zu\n", off, ws_size); warned = true; }

    (void)hipMemsetAsync(d_ws, 0, zero_bytes, stream);
    static int grid = 0;
    if (!grid) {
        int dev = 0, cus = 0, per_cu = 2;
        (void)hipGetDevice(&dev);
        (void)hipDeviceGetAttribute(&cus, hipDeviceAttributeMultiprocessorCount, dev);
        (void)hipFuncSetAttribute((const void*)mk_kernel<0, N_PHASES, 2>, hipFuncAttributeMaxDynamicSharedMemorySize, SMEM_BYTES);
        int q2 = 0, q4 = 0;
        q2 = 2;
        (void)hipOccupancyMaxActiveBlocksPerMultiprocessor(&q4, (const void*)mk_kernel<0, N_PHASES, 2>, NTHR, SMEM_BYTES);
        per_cu = q2 < q4 ? q2 : q4;
        if (per_cu > 2) per_cu = 2;
        if (per_cu < 1) per_cu = 1;
        grid = cus * per_cu;
    }
    hipLaunchKernelGGL((mk_kernel<0, N_PHASES, 2>), dim3(grid), dim3(NTHR), SMEM_BYTES, stream, p);
}
```

```cpp
#include <hip/hip_runtime.h>
#include <stdint.h>
#include <stdio.h>
#include <string.h>
#include <type_traits>

#ifndef MK_REPEAT_MASK
#define MK_REPEAT_MASK 0ull
#endif
#ifndef MK_FUSED
#define MK_FUSED 1
#endif

#define DI __device__ __forceinline__
typedef unsigned short bf16_t;
typedef short bf16x8 __attribute__((ext_vector_type(8)));
typedef float f32x16 __attribute__((ext_vector_type(16)));
typedef float f32x2_t __attribute__((ext_vector_type(2)));
typedef __bf16 bf16x2_t __attribute__((ext_vector_type(2)));

constexpr int NB = 4, LX = 8192, LC = 256, LT = LX + LC, NT = NB * LT, DM = 1024;
constexpr int AB_IN = 2560, CD_IN = 1168, CD_INP = 1280;
constexpr int NE = 64, FF = 256, NSEGC = 65, NCH = 4, NSEG = NSEGC * NCH;
constexpr int NPAIR = NT * 9;
constexpr int NCHUNK_T = LT / 64;
constexpr int NTHR = 256;
constexpr int SMEM_BYTES = 76800;
constexpr int SM_OFF = 64;
constexpr float EPSV = 1e-6f;
constexpr float LOG2E = 1.4426950408889634f;

#define XB_TMO      128
#define XB_XCNT(j)  (256  + 64 * (j))
#define XB_XSUB(j)  (1280 + 64 * (j))
#define XB_XGEN(j)  (2304 + 64 * (j))
#define XB_TOP      3328
#define XB_TOPGEN   3392
#define XCD_BAR_WORDS 3456
#define XB_SPIN_CAP (1u << 18)
#define LAS __attribute__((address_space(3)))

__device__ __forceinline__ unsigned xb_ld(unsigned* p)              { return __hip_atomic_load(p, __ATOMIC_RELAXED, __HIP_MEMORY_SCOPE_AGENT); }
__device__ __forceinline__ unsigned xb_add(unsigned* p, unsigned v) { return __hip_atomic_fetch_add(p, v, __ATOMIC_RELAXED, __HIP_MEMORY_SCOPE_AGENT); }
__device__ __forceinline__ unsigned xb_xcc_id() { return (unsigned)__builtin_amdgcn_s_getreg((3 << 11) | 20) & 0xFu; }
#define XB_SPIN(cond, bar) do { unsigned _sp = 0; while (cond) { __builtin_amdgcn_s_sleep(1); \
    if ((++_sp & 255u) == 0u) { if (xb_ld(&(bar)[XB_TMO])) break; if (_sp > XB_SPIN_CAP) { atomicAdd(&(bar)[XB_TMO], 1u); break; } } } } while (0)

struct XcdBarrier { unsigned* bar; unsigned x; volatile LAS unsigned* st; };

__device__ __forceinline__ XcdBarrier xcd_barrier_post(unsigned* bar, volatile LAS unsigned* st) {
    XcdBarrier b; b.bar = bar; b.x = xb_xcc_id(); b.st = st;
    if (threadIdx.x == 0) (void)xb_add(&bar[XB_XCNT(b.x)], 1u);
    return b;
}
__device__ __forceinline__ void xcd_barrier_complete(unsigned* bar, unsigned x, unsigned& nloc, unsigned& nx) {
    const unsigned G = gridDim.x * gridDim.y * gridDim.z;
    unsigned sum, cnt, mine, sp = 0u;
    for (;;) {
        sum = 0u; cnt = 0u; mine = 0u;
#pragma unroll
        for (unsigned j = 0; j < 16; ++j) { const unsigned c = xb_ld(&bar[XB_XCNT(j)]); sum += c; cnt += (c > 0u) ? 1u : 0u; mine = (j == x) ? c : mine; }
        if (sum == G) break;
        __builtin_amdgcn_s_sleep(1);
        if ((++sp & 255u) == 0u) { if (xb_ld(&bar[XB_TMO])) break; if (sp > XB_SPIN_CAP) { atomicAdd(&bar[XB_TMO], 1u); break; } }
    }
    nloc = mine > 0u ? mine : 1u; nx = cnt > 0u ? cnt : 1u;
}
__device__ __forceinline__ void xcd_barrier(const XcdBarrier& b) {
    asm volatile("s_waitcnt vmcnt(0)" ::: "memory");
    __syncthreads();
    if (threadIdx.x == 0) {
        unsigned* bar = b.bar;
        __builtin_amdgcn_s_waitcnt(0);
        unsigned nloc = b.st[0], nx = b.st[1];
        if (nloc == 0u) { xcd_barrier_complete(bar, b.x, nloc, nx); b.st[0] = nloc; b.st[1] = nx; }
        const unsigned old = xb_add(&bar[XB_XSUB(b.x)], 1u);
        const unsigned gen = old / nloc;
        if (old + 1u == (gen + 1u) * nloc) {
            __builtin_amdgcn_fence(__ATOMIC_RELEASE, "agent");
            asm volatile("s_waitcnt vmcnt(0)" ::: "memory");
            const unsigned og = xb_add(&bar[XB_TOP], 1u);
            const unsigned tg = og / nx;
            if (og + 1u == (tg + 1u) * nx) xb_add(&bar[XB_TOPGEN], 1u);
            else XB_SPIN(xb_ld(&bar[XB_TOPGEN]) == tg, bar);
            __builtin_amdgcn_fence(__ATOMIC_ACQUIRE, "agent");
            xb_add(&bar[XB_XGEN(b.x)], 1u);
            asm volatile("s_waitcnt vmcnt(0)" ::: "memory");
        } else {
            XB_SPIN(xb_ld(&bar[XB_XGEN(b.x)]) == gen, bar);
            __builtin_amdgcn_fence(__ATOMIC_ACQUIRE, "agent");
            asm volatile("s_waitcnt vmcnt(0)" ::: "memory");
        }
    }
    __syncthreads();
}

struct Params {
    const float* in[35];
    float* out;
    unsigned* bar;
    int* cnt;
    unsigned* kmax;
    float* mod;
    float* tab;
    float* lamv;
    bf16_t* w_in0;
    bf16_t* w_out0;
    bf16_t* w_in1;
    bf16_t* w_out1;
    bf16_t* w_uq;
    bf16_t* w_ukv;
    bf16_t* lw;
    bf16_t* rwh;
    bf16_t* rwl;
    bf16_t* ew1;
    bf16_t* ew2;
    float* rc;
    int* tk_e;
    float* tk_w;
    int* ppos;
    int* stok;
    float* sw;
    float* agg;
    float* carry;
    char* x1;
    char* x2;
    char* x4;
    bf16_t* h1;
    int nch;
    int chrows;
};

constexpr int TB_CR = 0, TB_SR = 2048, TB_CC = 4096, TB_SC = 5120, TB_CR4 = 6144, TB_SR4 = 6656, TB_CC4 = 7168, TB_SC4 = 7424, TB_TOTAL = 7680;

DI int unit_first() { return (int)((blockIdx.x & 7u) * (gridDim.x >> 3) + (blockIdx.x >> 3)); }
DI int tid() { int t = threadIdx.x; asm volatile("" : "+v"(t)); return t; }
DI unsigned pk_bf16(float a, float b) { f32x2_t v = {a, b}; bf16x2_t r = __builtin_convertvector(v, bf16x2_t); return __builtin_bit_cast(unsigned, r); }
DI bf16_t f2bf(float a) { return (bf16_t)(pk_bf16(a, 0.f) & 0xffffu); }
DI float bf2f(bf16_t v) { return __uint_as_float(((unsigned)v) << 16); }
DI float bflo(unsigned u) { return __uint_as_float(u << 16); }
DI float bfhi(unsigned u) { return __uint_as_float(u & 0xffff0000u); }
DI float sigm(float x) { return __builtin_amdgcn_rcpf(1.f + __builtin_amdgcn_exp2f(-1.4426950408889634f * x)); }
DI float silu_f(float x) { return x * sigm(x); }
DI float gelu_tanh(float x) { const float u = 0.7978845608028654f * (x + 0.044715f * x * x * x); return x * sigm(2.f * u); }
DI float wave_sum(float v) {
    const int l = tid() & 63;
#pragma unroll
    for (int o = 32; o > 0; o >>= 1) v += __int_as_float(__builtin_amdgcn_ds_bpermute((l ^ o) << 2, __float_as_int(v)));
    return v;
}
DI int shfl_up_i(int v, int o, int l) { return __builtin_amdgcn_ds_bpermute((l >= o ? l - o : l) << 2, v); }
DI float half_max(float x) { auto r = __builtin_amdgcn_permlane32_swap(__float_as_uint(x), __float_as_uint(x), false, false); return fmaxf(__uint_as_float(r[0]), __uint_as_float(r[1])); }
DI float half_sum(float x) { auto r = __builtin_amdgcn_permlane32_swap(__float_as_uint(x), __float_as_uint(x), false, false); return __uint_as_float(r[0]) + __uint_as_float(r[1]); }
#define MFMA32(a, b, c) __builtin_amdgcn_mfma_f32_32x32x16_bf16((a), (b), (c), 0, 0, 0)
DI int acc_row(int i, int h) { return (i & 3) + 8 * (i >> 2) + 4 * h; }

DI float* res_row(const Params& p, int r) {
    const int b = r / LT, pos = r - b * LT;
    return pos < LC ? p.rc + (size_t)(b * LC + pos) * DM : p.out + (size_t)(b * LX + pos - LC) * DM;
}
DI const float* in_row(const Params& p, int r) {
    const int b = r / LT, pos = r - b * LT;
    return pos < LC ? p.in[2] + (size_t)(b * LC + pos) * DM : p.in[0] + (size_t)(b * LX + pos - LC) * DM;
}
DI int mod_row(int r) { const int b = r / LT, pos = r - b * LT; return pos < LC ? 4 : b; }

DI void mod_gemv_unit(const Params& p, int u, char* smem) {
    float* s = (float*)smem;
    float* red = s + 5 * 1024;
    const int t = tid();
    for (int i = t; i < 5 * 1024; i += NTHR) { const int m = i >> 10, k = i & 1023; const float v = (m < 4) ? p.in[1][m * 1024 + k] : p.in[3][k]; s[i] = silu_f(v); }
    __syncthreads();
    const int layer = u / 96, n0 = (u % 96) * 64, col = t & 63, kg = t >> 6;
    const float* w = p.in[4] + (size_t)layer * 1024 * 6144 + n0 + col;
    float a0 = 0.f, a1 = 0.f, a2 = 0.f, a3 = 0.f, a4 = 0.f;
    for (int k0 = kg * 256; k0 < kg * 256 + 256; k0 += 16) {
        float wv[16];
#pragma unroll
        for (int j = 0; j < 16; ++j) wv[j] = w[(size_t)(k0 + j) * 6144];
#pragma unroll
        for (int j = 0; j < 16; ++j) { const int k = k0 + j;
            a0 += s[k] * wv[j]; a1 += s[1024 + k] * wv[j]; a2 += s[2048 + k] * wv[j]; a3 += s[3072 + k] * wv[j]; a4 += s[4096 + k] * wv[j]; }
    }
    red[(kg * 5 + 0) * 64 + col] = a0; red[(kg * 5 + 1) * 64 + col] = a1; red[(kg * 5 + 2) * 64 + col] = a2; red[(kg * 5 + 3) * 64 + col] = a3; red[(kg * 5 + 4) * 64 + col] = a4;
    __syncthreads();
    if (t < 64) {
        const float bias = p.in[5][layer * 6144 + n0 + t];
#pragma unroll
        for (int m = 0; m < 5; ++m) {
            const float v = red[(0 * 5 + m) * 64 + t] + red[(1 * 5 + m) * 64 + t] + red[(2 * 5 + m) * 64 + t] + red[(3 * 5 + m) * 64 + t] + bias;
            p.mod[(size_t)(layer * 5 + m) * 6144 + n0 + t] = v;
        }
    }
    __syncthreads();
}

DI void cvt_tile(const float* src, int ld_src, int k0, int n0, int nvalid, bf16_t* dst, int ld_dst, char* smem, bf16_t* dst_lo = nullptr, bool tiled = false) {
    float* s = (float*)smem;
    const int t = tid();
#pragma unroll
    for (int it = 0; it < 2; ++it) {
        const int idx = t + NTHR * it, k = idx >> 3, n4 = (idx & 7) * 4;
        const float* sp = src + (size_t)(k0 + k) * ld_src + n0 + n4;
        float v0 = 0.f, v1 = 0.f, v2 = 0.f, v3 = 0.f;
        if (n0 + n4 + 3 < nvalid) { const float4 v = *(const float4*)sp; v0 = v.x; v1 = v.y; v2 = v.z; v3 = v.w; }
        else { if (n0 + n4 + 0 < nvalid) v0 = sp[0]; if (n0 + n4 + 1 < nvalid) v1 = sp[1]; if (n0 + n4 + 2 < nvalid) v2 = sp[2]; if (n0 + n4 + 3 < nvalid) v3 = sp[3]; }
        s[k * 33 + n4 + 0] = v0; s[k * 33 + n4 + 1] = v1; s[k * 33 + n4 + 2] = v2; s[k * 33 + n4 + 3] = v3;
    }
    __syncthreads();
    {
        const int n = t >> 3, c = t & 7;
        uint4 o;
        o.x = pk_bf16(s[(c * 8 + 0) * 33 + n], s[(c * 8 + 1) * 33 + n]);
        o.y = pk_bf16(s[(c * 8 + 2) * 33 + n], s[(c * 8 + 3) * 33 + n]);
        o.z = pk_bf16(s[(c * 8 + 4) * 33 + n], s[(c * 8 + 5) * 33 + n]);
        o.w = pk_bf16(s[(c * 8 + 6) * 33 + n], s[(c * 8 + 7) * 33 + n]);
        if (tiled) *(uint4*)(dst + (size_t)((((k0 >> 4) + (c >> 1)) * 64 + (c & 1) * 32 + n) * 8)) = o;
        else *(uint4*)(dst + (size_t)n * ld_dst + k0 + c * 8) = o;
        if (dst_lo) {
            float r[8];
#pragma unroll
            for (int j = 0; j < 8; ++j) { const float w = s[(c * 8 + j) * 33 + n]; r[j] = w - bf2f(f2bf(w)); }
            uint4 o2; o2.x = pk_bf16(r[0], r[1]); o2.y = pk_bf16(r[2], r[3]); o2.z = pk_bf16(r[4], r[5]); o2.w = pk_bf16(r[6], r[7]);
            *(uint4*)(dst_lo + (size_t)n * ld_dst + k0 + c * 8) = o2;
        }
    }
    __syncthreads();
}

constexpr int CS0 = 1280, CS1 = CS0 + 512, CS2 = CS1 + 640, CS3 = CS2 + 512, CS4 = CS3 + 64, CS5 = CS4 + 48, CS6 = CS5 + 64, CS7 = CS6 + 64;
constexpr int CVT_SMALL_TILES = CS7;
DI void cvt_small(const Params& p, int u, char* smem) {
    if (u < CS0) { const int kt = u / 80, nt = u % 80; cvt_tile(p.in[6], AB_IN, kt * 64, nt * 32, AB_IN, p.w_in0 + (size_t)nt * 32 * 1024, 1024, smem, nullptr, true); }
    else if (u < CS1) { const int v = u - CS0, kt = v / 32, nt = v % 32; cvt_tile(p.in[7], 1024, kt * 64, nt * 32, 1024, p.w_out0 + (size_t)nt * 32 * 1024, 1024, smem, nullptr, true); }
    else if (u < CS2) { const int v = u - CS1, kt = v / 40, nt = v % 40; cvt_tile(p.in[18], CD_IN, kt * 64, nt * 32, CD_IN, p.w_in1 + (size_t)nt * 32 * 1024, 1024, smem, nullptr, true); }
    else if (u < CS3) { const int v = u - CS2, kt = v / 32, nt = v % 32; cvt_tile(p.in[19], 1024, kt * 64, nt * 32, 1024, p.w_out1 + (size_t)nt * 32 * 1024, 1024, smem, nullptr, true); }
    else if (u < CS4) { const int v = u - CS3, kt = v / 16, nt = v % 16; cvt_tile(p.in[24], 384, kt * 64, nt * 32, 384, p.w_uq + (size_t)nt * 32 * 256, 256, smem, nullptr, true); }
    else if (u < CS5) { const int v = u - CS4, kt = v / 24, nt = v % 24; cvt_tile(p.in[25], 768, kt * 64, nt * 32, 768, p.w_ukv + (size_t)nt * 32 * 128, 128, smem, nullptr, true); }
    else if (u < CS6) {
        const int v = u - CS5, gate = v & 1, jh = (v >> 1) & 1, d = (v >> 2) & 1, n = v >> 3;
        const float* src = (gate ? p.in[15] : p.in[13]) + (size_t)(d * 8 + n) * 64 * 64;
        cvt_tile(src, 64, 0, jh * 32, 64, p.lw + (size_t)v * 32 * 64, 64, smem);
    } else {
        const int v = u - CS6, layer = v >> 5, kt = (v >> 1) & 15, nt = v & 1;
        cvt_tile(p.in[26] + (size_t)layer * 1024 * 64, 64, kt * 64, nt * 32, 64, p.rwh + ((size_t)layer * 64 + nt * 32) * 1024, 1024, smem, p.rwl + ((size_t)layer * 64 + nt * 32) * 1024);
    }
}
constexpr int CVT_EXP_TILES = 3 * 8192 + 3 * 128;
DI void cvt_expert(const Params& p, int layer, int u, char* smem) {
    if (u < 16384) {
        const int up = u >= 8192, v = u & 8191, e = v >> 7, kt = (v >> 3) & 15, nt = v & 7;
        const float* src = (up ? p.in[29] : p.in[28]) + (size_t)(layer * NE + e) * 1024 * 256;
        cvt_tile(src, 256, kt * 64, nt * 32, 256, p.ew1 + ((size_t)e * 512 + nt * 64 + up * 32) * 1024, 1024, smem, nullptr, true);
    } else if (u < 24576) {
        const int v = u - 16384, e = v >> 7, kt = (v >> 5) & 3, nt = v & 31;
        const float* src = p.in[30] + (size_t)(layer * NE + e) * 256 * 1024;
        cvt_tile(src, 1024, kt * 64, nt * 32, 1024, p.ew2 + ((size_t)e * 1024 + nt * 32) * 256, 256, smem, nullptr, true);
    } else {
        const int v = u - 24576;
        if (v < 256) { const int up = v >= 128, w = v & 127, kt = w >> 3, nt = w & 7;
            const float* src = (up ? p.in[32] : p.in[31]) + (size_t)layer * 1024 * 256;
            cvt_tile(src, 256, kt * 64, nt * 32, 256, p.ew1 + ((size_t)NE * 512 + nt * 64 + up * 32) * 1024, 1024, smem, nullptr, true);
        } else { const int w = v - 256, kt = w >> 5, nt = w & 31;
            const float* src = p.in[33] + (size_t)layer * 256 * 1024;
            cvt_tile(src, 1024, kt * 64, nt * 32, 1024, p.ew2 + ((size_t)NE * 1024 + nt * 32) * 256, 256, smem, nullptr, true);
        }
    }
}
DI void tables_unit(const Params& p) {
    const int t = tid();
    for (int i = t; i < 128 * 16; i += NTHR) { const int pos = i >> 4, f = i & 15; const float ang = (float)pos * powf(10000.f, -(float)f / 16.f); float s, c; sincosf(ang, &s, &c); p.tab[TB_CR + i] = c; p.tab[TB_SR + i] = s; }
    for (int i = t; i < 64 * 16; i += NTHR) { const int pos = i >> 4, f = i & 15; const float ang = (float)pos * powf(10000.f, -(float)f / 16.f); float s, c; sincosf(ang, &s, &c); p.tab[TB_CC + i] = c; p.tab[TB_SC + i] = s; }
    for (int i = t; i < 128 * 4; i += NTHR) { const int pos = i >> 2, f = i & 3; const float ang = (float)pos * powf(10000.f, -(float)f / 4.f); float s, c; sincosf(ang, &s, &c); p.tab[TB_CR4 + i] = c; p.tab[TB_SR4 + i] = s; }
    for (int i = t; i < 64 * 4; i += NTHR) { const int pos = i >> 2, f = i & 3; const float ang = (float)pos * powf(10000.f, -(float)f / 4.f); float s, c; sincosf(ang, &s, &c); p.tab[TB_CC4 + i] = c; p.tab[TB_SC4 + i] = s; }
    if (t < 64) {
        const float s0 = wave_sum(p.in[8][t] * p.in[9][t]), s1 = wave_sum(p.in[8][64 + t] * p.in[9][64 + t]);
        if (t == 0) p.lamv[0] = expf(s0) - expf(s1) + 0.2f;
    }
}
DI void phase_prologue(const Params& p, char* smem) {
    const int n_units = 192 + 1 + CVT_SMALL_TILES;
    for (int u = unit_first(); u < n_units; u += gridDim.x) {
        if (u < 192) mod_gemv_unit(p, u, smem);
        else if (u == 192) tables_unit(p);
        else cvt_small(p, u - 193, smem);
    }
}

DI void phase_norm1(const Params& p, int layer) {
    const int lane = tid() & 63, wave = tid() >> 6;
    bf16_t* H = (bf16_t*)p.x4;
    for (int u = unit_first(); u < NT / 64; u += gridDim.x) {
        for (int rr = 0; rr < 16; rr += 4) {
            float4 v[4][4]; float ss[4];
#pragma unroll
            for (int q = 0; q < 4; ++q) {
                const int r = u * 64 + wave * 16 + rr + q;
                const float* src = layer == 0 ? in_row(p, r) : res_row(p, r);
#pragma unroll
                for (int i = 0; i < 4; ++i) v[q][i] = *(const float4*)(src + lane * 4 + 256 * i);
            }
#pragma unroll
            for (int q = 0; q < 4; ++q) {
                float s = 0.f;
#pragma unroll
                for (int i = 0; i < 4; ++i) s += v[q][i].x * v[q][i].x + v[q][i].y * v[q][i].y + v[q][i].z * v[q][i].z + v[q][i].w * v[q][i].w;
                ss[q] = wave_sum(s);
            }
#pragma unroll
            for (int q = 0; q < 4; ++q) {
                const int r = u * 64 + wave * 16 + rr + q;
                const float* md = p.mod + (size_t)(layer * 5 + mod_row(r)) * 6144;
                const float rinv = rsqrtf(ss[q] * (1.f / 1024.f) + EPSV);
#pragma unroll
                for (int i = 0; i < 4; ++i) {
                    const int c = lane * 4 + 256 * i;
                    const float4 sh = *(const float4*)(md + c), sc = *(const float4*)(md + 1024 + c);
                    uint2 o;
                    o.x = pk_bf16(v[q][i].x * rinv * (1.f + sc.x) + sh.x, v[q][i].y * rinv * (1.f + sc.y) + sh.y);
                    o.y = pk_bf16(v[q][i].z * rinv * (1.f + sc.z) + sh.z, v[q][i].w * rinv * (1.f + sc.w) + sh.w);
                    *(uint2*)(H + (size_t)r * DM + c) = o;
                }
            }
        }
    }
}

constexpr int LDT = 72;
constexpr int CT_LD = 132;
template <class Epi>
DI void gemm_tile(const bf16_t* a0, const bf16_t* a1, const bf16_t* a2, const bf16_t* a3,
                  const bf16_t* b0, const bf16_t* b1, const bf16_t* b2, const bf16_t* b3,
                  int K, char* smem, const Epi& epi, int row0, int col0) {
    bf16_t* As = (bf16_t*)smem;
    bf16_t* Bs = As + 2 * 128 * LDT;
    const int t = tid(), lane = t & 63, wave = t >> 6, wm = wave >> 1, wn = wave & 1, l32 = lane & 31, h = lane >> 5;
    const int srow = t >> 3, scol = (t & 7) * 8;
    uint4 ra0, ra1, ra2, ra3, rb0, rb1, rb2, rb3;
    ra0 = *(const uint4*)(a0 + scol); ra1 = *(const uint4*)(a1 + scol); ra2 = *(const uint4*)(a2 + scol); ra3 = *(const uint4*)(a3 + scol);
    rb0 = *(const uint4*)(b0 + scol); rb1 = *(const uint4*)(b1 + scol); rb2 = *(const uint4*)(b2 + scol); rb3 = *(const uint4*)(b3 + scol);
    {
        bf16_t* ad = As + srow * LDT + scol; bf16_t* bd = Bs + srow * LDT + scol;
        *(uint4*)(ad) = ra0; *(uint4*)(ad + 32 * LDT) = ra1; *(uint4*)(ad + 64 * LDT) = ra2; *(uint4*)(ad + 96 * LDT) = ra3;
        *(uint4*)(bd) = rb0; *(uint4*)(bd + 32 * LDT) = rb1; *(uint4*)(bd + 64 * LDT) = rb2; *(uint4*)(bd + 96 * LDT) = rb3;
    }
    __syncthreads();
    f32x16 acc[2][2];
#pragma unroll
    for (int i = 0; i < 2; ++i)
#pragma unroll
        for (int j = 0; j < 2; ++j)
#pragma unroll
            for (int e = 0; e < 16; ++e) acc[i][j][e] = 0.f;
    const int nk = K >> 6;
    for (int kt = 0; kt < nk; ++kt) {
        const int cur = kt & 1;
        const bool more = (kt + 1 < nk);
        if (more) {
            const int ko = (kt + 1) * 64 + scol;
            ra0 = *(const uint4*)(a0 + ko); ra1 = *(const uint4*)(a1 + ko); ra2 = *(const uint4*)(a2 + ko); ra3 = *(const uint4*)(a3 + ko);
            rb0 = *(const uint4*)(b0 + ko); rb1 = *(const uint4*)(b1 + ko); rb2 = *(const uint4*)(b2 + ko); rb3 = *(const uint4*)(b3 + ko);
        }
        __builtin_amdgcn_sched_barrier(0);
        const bf16_t* Ac = As + cur * 128 * LDT + (wm * 64 + l32) * LDT + h * 8;
        const bf16_t* Bc = Bs + cur * 128 * LDT + (wn * 64 + l32) * LDT + h * 8;
        bf16x8 fa0[4], fa1[4], fb0[4], fb1[4];
#pragma unroll
        for (int ks = 0; ks < 4; ++ks) {
            fa0[ks] = *(const bf16x8*)(Ac + ks * 16); fb0[ks] = *(const bf16x8*)(Bc + ks * 16);
            fa1[ks] = *(const bf16x8*)(Ac + 32 * LDT + ks * 16); fb1[ks] = *(const bf16x8*)(Bc + 32 * LDT + ks * 16);
        }
        __builtin_amdgcn_sched_barrier(0);
#pragma unroll
        for (int ks = 0; ks < 4; ++ks) {
            acc[0][0] = MFMA32(fa0[ks], fb0[ks], acc[0][0]); acc[0][1] = MFMA32(fa0[ks], fb1[ks], acc[0][1]);
            acc[1][0] = MFMA32(fa1[ks], fb0[ks], acc[1][0]); acc[1][1] = MFMA32(fa1[ks], fb1[ks], acc[1][1]);
        }
        __builtin_amdgcn_sched_barrier(0);
        if (more) {
            bf16_t* ad = As + (cur ^ 1) * 128 * LDT + srow * LDT + scol; bf16_t* bd = Bs + (cur ^ 1) * 128 * LDT + srow * LDT + scol;
            *(uint4*)(ad) = ra0; *(uint4*)(ad + 32 * LDT) = ra1; *(uint4*)(ad + 64 * LDT) = ra2; *(uint4*)(ad + 96 * LDT) = ra3;
            *(uint4*)(bd) = rb0; *(uint4*)(bd + 32 * LDT) = rb1; *(uint4*)(bd + 64 * LDT) = rb2; *(uint4*)(bd + 96 * LDT) = rb3;
        }
        __syncthreads();
    }
    {
        float* ct = (float*)smem;
#pragma unroll
        for (int mi = 0; mi < 2; ++mi)
#pragma unroll
            for (int ni = 0; ni < 2; ++ni)
#pragma unroll
                for (int i = 0; i < 16; ++i) ct[(wm * 64 + mi * 32 + acc_row(i, h)) * CT_LD + wn * 64 + ni * 32 + l32] = acc[mi][ni][i];
        __syncthreads();
        epi(ct, row0, col0);
        __syncthreads();
    }
}

template <class Epi, class RowOf>
DI void gemm_phase(const bf16_t* A, int lda, const bf16_t* Bt, int K, int n_mt, int ntn, char* smem, const Epi& epi, const RowOf& row_of) {
    const int srow = tid() >> 3;
    for (int u = unit_first(); u < n_mt * ntn; u += gridDim.x) {
        const int mt = u / ntn, nt = u - mt * ntn;
        const int row0 = row_of(mt), col0 = nt * 128;
        const bf16_t* ap = A + (size_t)(row0 + srow) * lda;
        const bf16_t* bp = Bt + (size_t)(col0 + srow) * K;
        gemm_tile(ap, ap + (size_t)32 * lda, ap + (size_t)64 * lda, ap + (size_t)96 * lda,
                  bp, bp + (size_t)32 * K, bp + (size_t)64 * K, bp + (size_t)96 * K, K, smem, epi, row0, col0);
    }
}

struct WEpiSplit { static constexpr int MODE = 0; static constexpr bool TILE = false; static constexpr bool PRELOAD = false; bf16_t* O0; int ld0; bf16_t* O1; int ld1; int split; int ncol;
    DI void store(int row, int col, uint4 v) const { if (col < split) { if (col < ncol) *(uint4*)(O0 + (size_t)row * ld0 + col) = v; } else *(uint4*)(O1 + (size_t)row * ld1 + (col - split)) = v; } };
struct WEpiResidual { static constexpr int MODE = 0; static constexpr bool TILE = false; static constexpr bool PRELOAD = true; const Params* pp; int layer;
    DI void preload(int row, int col, float4& x0, float4& x1) const {
        const Params& p = *pp;
        const float* srcp = layer == 0 ? in_row(p, row) + col : res_row(p, row) + col;
        x0 = *(const float4*)srcp; x1 = *(const float4*)(srcp + 4);
    }
    DI void store2(int row, int col, uint4 v, float4 x0, float4 x1) const {
        const Params& p = *pp;
        const float* md = p.mod + (size_t)(layer * 5 + mod_row(row)) * 6144 + 2048 + col;
        float* dst = res_row(p, row) + col;
        const float4 g0 = *(const float4*)md, g1 = *(const float4*)(md + 4);
        float4 o0 = {x0.x + g0.x * bflo(v.x), x0.y + g0.y * bfhi(v.x), x0.z + g0.z * bflo(v.y), x0.w + g0.w * bfhi(v.y)};
        float4 o1 = {x1.x + g1.x * bflo(v.z), x1.y + g1.y * bfhi(v.z), x1.z + g1.z * bflo(v.w), x1.w + g1.w * bfhi(v.w)};
        *(float4*)dst = o0; *(float4*)(dst + 4) = o1;
    }
    DI void store(int row, int col, uint4 v) const {
        const Params& p = *pp;
        const float* md = p.mod + (size_t)(layer * 5 + mod_row(row)) * 6144 + 2048 + col;
        float* dst = res_row(p, row) + col;
        const float* srcp = layer == 0 ? in_row(p, row) + col : dst;
        const float4 x0 = *(const float4*)srcp, x1 = *(const float4*)(srcp + 4), g0 = *(const float4*)md, g1 = *(const float4*)(md + 4);
        float4 o0 = {x0.x + g0.x * bflo(v.x), x0.y + g0.y * bfhi(v.x), x0.z + g0.z * bflo(v.y), x0.w + g0.w * bfhi(v.y)};
        float4 o1 = {x1.x + g1.x * bflo(v.z), x1.y + g1.y * bfhi(v.z), x1.z + g1.z * bflo(v.w), x1.w + g1.w * bfhi(v.w)};
        *(float4*)dst = o0; *(float4*)(dst + 4) = o1;
    } };
struct WEpiRows { static constexpr int MODE = 0; static constexpr bool TILE = false; static constexpr bool PRELOAD = false; bf16_t* O; int ld; int rbase; int row_end;
    DI void store(int row, int col, uint4 v) const { if (row < row_end) *(uint4*)(O + (size_t)(row - rbase) * ld + col) = v; } };
constexpr float YP_SCALE = 4.f;
struct WEpiRows8 { static constexpr int MODE = 2; static constexpr bool TILE = false; unsigned char* O; int rbase; int row_end;
    DI void store8(int row, int col, uint4 v) const { if (row < row_end) *(uint4*)(O + (size_t)(row - rbase) * DM + col) = v; } };
struct WEpiGateUp { static constexpr int MODE = 1; bf16_t* HID; const float* sw; int pos_end;
    DI float row_w(int pos) const { return pos < pos_end ? sw[pos] * YP_SCALE : 0.f; }
    DI void store(int pos, int f, uint4 v) const { if (pos < pos_end) *(uint4*)(HID + (size_t)pos * FF + f) = v; } };
constexpr int LDA = 72;
constexpr int CBP = 264;
template <class Epi> struct GUnit { const bf16_t *a0, *a1, *a2, *a3, *bw; int row0, col0, K; Epi epi; };
struct GOff { unsigned a0, a1, a2, a3, bw; };
template <class Epi, class UnitFn>
DI void gemm_stream_w(int n_units, const UnitFn& unit_fn, char* smem, const char* base) {
    bf16_t* As = (bf16_t*)smem;
    const int t = tid(), lane = t & 63, wave = t >> 6, l32 = lane & 31, h = lane >> 5;
    const int srow = t >> 3, scol = (t & 7) * 8;
    int u = unit_first();
    if (u >= n_units) return;
    uint4 ra0, ra1, ra2, ra3;
    bf16x8 fbA[2][2], fbB[2][2];
#define GW_OFF(g) GOff{(unsigned)((const char*)(g).a0 - base) + (unsigned)scol * 2u, (unsigned)((const char*)(g).a1 - base) + (unsigned)scol * 2u, \
                       (unsigned)((const char*)(g).a2 - base) + (unsigned)scol * 2u, (unsigned)((const char*)(g).a3 - base) + (unsigned)scol * 2u, (unsigned)((const char*)(g).bw - base)}
    const __amdgpu_buffer_rsrc_t wrs = __builtin_amdgcn_make_buffer_rsrc((void*)base, 0, 0x7FFFFFFF, 0x00020000);
#define GW_LD(vo, so) __builtin_bit_cast(uint4, __builtin_amdgcn_raw_buffer_load_b128(wrs, (int)(vo), (int)(so), 0))
#define GW_LDF(vo, so) __builtin_bit_cast(bf16x8, __builtin_amdgcn_raw_buffer_load_b128(wrs, (int)(vo), (int)(so), 0))
#define GW_LOADA(o, ko) do { ra0 = GW_LD((o).a0, ko); ra1 = GW_LD((o).a1, ko); ra2 = GW_LD((o).a2, ko); ra3 = GW_LD((o).a3, ko); } while (0)
#define GW_STOREA(buf) do { bf16_t* ad = As + (buf) * 128 * LDA + srow * LDA + scol; *(uint4*)(ad) = ra0; *(uint4*)(ad + 32 * LDA) = ra1; \
        *(uint4*)(ad + 64 * LDA) = ra2; *(uint4*)(ad + 96 * LDA) = ra3; } while (0)
#define GW_LOADB(fb, bv, bs, K) do { fb[0][0] = GW_LDF(bv, bs); fb[1][0] = GW_LDF(bv, (bs) + 1024u); \
        fb[0][1] = GW_LDF(bv, (bs) + 64u * (unsigned)(K)); fb[1][1] = GW_LDF(bv, (bs) + 64u * (unsigned)(K) + 1024u); } while (0)
#define GW_COMPUTE(Ac, fb) do { \
        bf16x8 fa[2][4]; \
        _Pragma("unroll") for (int ks = 0; ks < 2; ++ks) \
            _Pragma("unroll") for (int mi = 0; mi < 4; ++mi) fa[ks][mi] = *(const bf16x8*)((Ac) + mi * 32 * LDA + ks * 16); \
        __builtin_amdgcn_sched_barrier(0); \
        _Pragma("unroll") for (int ks = 0; ks < 2; ++ks) \
            _Pragma("unroll") for (int mi = 0; mi < 4; ++mi) { acc[mi][0] = MFMA32(fb[ks][0], fa[ks][mi], acc[mi][0]); acc[mi][1] = MFMA32(fb[ks][1], fa[ks][mi], acc[mi][1]); } \
        __builtin_amdgcn_sched_barrier(0); } while (0)
    GUnit<Epi> cur = unit_fn(u, srow, wave, lane);
    GOff co = GW_OFF(cur);
    GW_LOADA(co, 0u);
    GW_LOADB(fbA, co.bw, 0u, cur.K);
    for (;;) {
        const int ns = cur.K >> 6;
        GW_STOREA(0);
        __syncthreads();
        const int un = u + (int)gridDim.x;
        const bool has_next = un < n_units;
        GUnit<Epi> nxt = cur;
        if (has_next) nxt = unit_fn(un, srow, wave, lane);
        const GOff no = GW_OFF(nxt);
        f32x16 acc[4][2];
#pragma unroll
        for (int i = 0; i < 4; ++i)
#pragma unroll
            for (int j = 0; j < 2; ++j)
#pragma unroll
                for (int e = 0; e < 16; ++e) acc[i][j][e] = 0.f;
        for (int st = 0; st < ns; ++st) {
            const bool more = (st + 1 < ns);
            const bf16_t* Ac = As + (st & 1) * 128 * LDA + l32 * LDA + h * 8;
            {
                const unsigned ko = more ? (unsigned)(st + 1) * 128u : 0u;
                ra0 = GW_LD(more ? co.a0 : no.a0, ko); ra1 = GW_LD(more ? co.a1 : no.a1, ko);
                ra2 = GW_LD(more ? co.a2 : no.a2, ko); ra3 = GW_LD(more ? co.a3 : no.a3, ko);
            }
            GW_LOADB(fbB, co.bw, (unsigned)(2 * st + 1) * 2048u, cur.K);
            __builtin_amdgcn_sched_barrier(0);
            GW_COMPUTE(Ac, fbA);
            {
                const unsigned pbv = more ? co.bw : no.bw, pbs = more ? (unsigned)(2 * st + 2) * 2048u : 0u;
                const int K = more ? cur.K : nxt.K;
                GW_LOADB(fbA, pbv, pbs, K);
            }
            __builtin_amdgcn_sched_barrier(0);
            GW_COMPUTE(Ac + 32, fbB);
            if (more) GW_STOREA((st + 1) & 1);
            __syncthreads();
        }
        {
            bf16_t* cb = (bf16_t*)smem;
            if constexpr (Epi::MODE == 0) {
#pragma unroll
                for (int mi = 0; mi < 4; ++mi)
#pragma unroll
                    for (int ni = 0; ni < 2; ++ni)
#pragma unroll
                        for (int q = 0; q < 4; ++q) {
                            uint2 w; w.x = pk_bf16(acc[mi][ni][4 * q], acc[mi][ni][4 * q + 1]); w.y = pk_bf16(acc[mi][ni][4 * q + 2], acc[mi][ni][4 * q + 3]);
                            *(uint2*)(cb + (mi * 32 + l32) * CBP + wave * 64 + ni * 32 + 8 * q + 4 * h) = w;
                        }
                __syncthreads();
                if constexpr (Epi::TILE) cur.epi.tile(cb, cur.row0, cur.col0, smem);
                else if constexpr (Epi::PRELOAD) {
#pragma unroll 1
                    for (int hb = 0; hb < 2; ++hb) {
                        float4 xa[8][2];
#pragma unroll
                        for (int j = 0; j < 8; ++j) {
                            const int idx = t + NTHR * (hb * 8 + j), row = idx >> 5, c8 = (idx & 31) * 8;
                            cur.epi.preload(cur.row0 + row, cur.col0 + c8, xa[j][0], xa[j][1]);
                        }
#pragma unroll
                        for (int j = 0; j < 8; ++j) {
                            const int idx = t + NTHR * (hb * 8 + j), row = idx >> 5, c8 = (idx & 31) * 8;
                            cur.epi.store2(cur.row0 + row, cur.col0 + c8, *(const uint4*)(cb + row * CBP + c8), xa[j][0], xa[j][1]);
                        }
                    }
                } else {
#pragma unroll 4
                    for (int it = 0; it < 16; ++it) {
                        const int idx = t + NTHR * it, row = idx >> 5, c8 = (idx & 31) * 8;
                        cur.epi.store(cur.row0 + row, cur.col0 + c8, *(const uint4*)(cb + row * CBP + c8));
                    }
                }
            } else if constexpr (Epi::MODE == 2) {
                unsigned char* c8 = (unsigned char*)smem;
                constexpr int C8P = 272;
#pragma unroll
                for (int mi = 0; mi < 4; ++mi)
#pragma unroll
                    for (int ni = 0; ni < 2; ++ni)
#pragma unroll
                        for (int q = 0; q < 4; ++q) {
                            int w = __builtin_amdgcn_cvt_pk_fp8_f32(acc[mi][ni][4 * q], acc[mi][ni][4 * q + 1], 0, false);
                            w = __builtin_amdgcn_cvt_pk_fp8_f32(acc[mi][ni][4 * q + 2], acc[mi][ni][4 * q + 3], w, true);
                            *(int*)(c8 + (mi * 32 + l32) * C8P + wave * 64 + ni * 32 + 8 * q + 4 * h) = w;
                        }
                __syncthreads();
#pragma unroll 4
                for (int it = 0; it < 8; ++it) {
                    const int idx = t + NTHR * it, row = idx >> 4, c16 = (idx & 15) * 16;
                    cur.epi.store8(cur.row0 + row, cur.col0 + c16, *(const uint4*)(c8 + row * C8P + c16));
                }
            } else {
#pragma unroll
                for (int mi = 0; mi < 4; ++mi) {
                    const float wr = cur.epi.row_w(cur.row0 + mi * 32 + l32);
#pragma unroll
                    for (int q = 0; q < 4; ++q) {
                        float o[4];
#pragma unroll
                        for (int j = 0; j < 4; ++j) o[j] = silu_f(acc[mi][0][4 * q + j]) * acc[mi][1][4 * q + j] * wr;
                        uint2 w; w.x = pk_bf16(o[0], o[1]); w.y = pk_bf16(o[2], o[3]);
                        *(uint2*)(cb + (mi * 32 + l32) * CBP + wave * 32 + 8 * q + 4 * h) = w;
                    }
                }
                __syncthreads();
#pragma unroll 4
                for (int it = 0; it < 8; ++it) {
                    const int idx = t + NTHR * it, row = idx >> 4, c8 = (idx & 15) * 8;
                    cur.epi.store(cur.row0 + row, (cur.col0 >> 1) + c8, *(const uint4*)(cb + row * CBP + c8));
                }
            }
            __syncthreads();
        }
        if (!has_next) break;
        cur = nxt; co = no; u = un;
    }
#undef GW_OFF
#undef GW_LD
#undef GW_LDF
#undef GW_LOADA
#undef GW_STOREA
#undef GW_LOADB
#undef GW_COMPUTE
}
template <class Epi, class RowOf>
DI void gemm_phase_w(const char* base, const bf16_t* A, int lda, const bf16_t* Bt, int K, int n_mt, int ntn, char* smem, const Epi& epi, const RowOf& row_of) {
    auto unit_fn = [&](int u, int srow, int wave, int lane) {
        const int mt = u / ntn, nt = u - mt * ntn;
        const int row0 = row_of(mt), col0 = nt * 256;
        const bf16_t* ap = A + (size_t)(row0 + srow) * lda;
        const bf16_t* bw = Bt + (size_t)(col0 + wave * 64) * K + lane * 8;
        return GUnit<Epi>{ap, ap + (size_t)32 * lda, ap + (size_t)64 * lda, ap + (size_t)96 * lda, bw, row0, col0, K, epi};
    };
    gemm_stream_w<Epi>(n_mt * ntn, unit_fn, smem, base);
}
struct RowIdent { DI int operator()(int mt) const { return mt * 128; } };
struct RowLatent { DI int operator()(int mt) const { return (mt >> 6) * LT + LC + (mt & 63) * 128; } };

DI uint4 pack8(const float* s) {
    const float4 a = *(const float4*)s, b = *(const float4*)(s + 4);
    uint4 o; o.x = pk_bf16(a.x, a.y); o.y = pk_bf16(a.z, a.w); o.z = pk_bf16(b.x, b.y); o.w = pk_bf16(b.z, b.w); return o;
}
struct EpiSplitBf16 {
    bf16_t* O0; int ld0; bf16_t* O1; int ld1; int split;
    DI void operator()(const float* ct, int row0, int col0) const {
        bf16_t* base; int ld;
        if (col0 < split) { base = O0 + col0; ld = ld0; } else { base = O1 + (col0 - split); ld = ld1; }
#pragma unroll 2
        for (int it = 0; it < 8; ++it) {
            const int idx = tid() + NTHR * it, row = idx >> 4, c8 = (idx & 15) * 8;
            *(uint4*)(base + (size_t)(row0 + row) * ld + c8) = pack8(ct + row * CT_LD + c8);
        }
    }
};
struct EpiResidual {
    Params p; int layer;
    DI void operator()(const float* ct, int row0, int col0) const {
        const float* md = p.mod + (size_t)(layer * 5 + mod_row(row0)) * 6144 + 2048 + col0;
#pragma unroll 2
        for (int it = 0; it < 16; ++it) {
            const int idx = tid() + NTHR * it, row = idx >> 5, c4 = (idx & 31) * 4, r = row0 + row;
            const float4 a = *(const float4*)(ct + row * CT_LD + c4), g = *(const float4*)(md + c4);
            float* dst = res_row(p, r) + col0 + c4;
            const float4 x = layer == 0 ? *(const float4*)(in_row(p, r) + col0 + c4) : *(const float4*)dst;
            float4 o = {x.x + g.x * a.x, x.y + g.y * a.y, x.z + g.z * a.z, x.w + g.w * a.w};
            *(float4*)dst = o;
        }
    }
};

template <int DK, int DV, bool LSUM_MFMA>
DI void attn_core(const bf16_t* Qh, const bf16_t* Kh, const bf16_t* VTh, int qpos0, int nkeys, float c, float kmax2, char* smem,
                  f32x16 (&O)[DV / 32], float& l_tot) {
    constexpr int KS = DK / 16, NDB = DV / 32, LDK = DK + 8, KCH = DK / 8, NKCH = 64 * KCH, NKC = (NKCH + NTHR - 1) / NTHR, NVC = DV * 8 / NTHR;
    bf16_t* Ks = (bf16_t*)smem;
    bf16_t* Vs = Ks + 2 * 64 * LDK;
    const int t = tid(), lane = t & 63, wave = t >> 6, l32 = lane & 31, h = lane >> 5;
    bf16x8 qf[KS];
    {
        const bf16_t* qp = Qh + (size_t)(qpos0 + wave * 32 + l32) * DK + h * 8;
#pragma unroll
        for (int ks = 0; ks < KS; ++ks) qf[ks] = *(const bf16x8*)(qp + ks * 16);
    }
    static_assert(NKC == 2 && (NVC == 2 || NVC == 4), "staging shape");
    uint4 rk0, rk1, rv0, rv1, rv2 = {0u, 0u, 0u, 0u}, rv3 = {0u, 0u, 0u, 0u};
    const int kidx1 = (NKCH % NTHR == 0 || t + NTHR < NKCH) ? t + NTHR : NKCH - 1;
    const bool k1ok = (NKCH % NTHR == 0) || (t + NTHR < NKCH);
    const __amdgpu_buffer_rsrc_t krs = __builtin_amdgcn_make_buffer_rsrc((void*)Kh, 0, 0x7FFFFFFF, 0x00020000);
    const __amdgpu_buffer_rsrc_t vrs = __builtin_amdgcn_make_buffer_rsrc((void*)VTh, 0, 0x7FFFFFFF, 0x00020000);
    const int ko0 = t * 16, ko1 = kidx1 * 16;
    const int vo0 = ((t >> 3) * LT + (t & 7) * 8) * 2;
    const int ks0 = (t / KCH) * LDK + (t % KCH) * 8, ks1 = ((t + NTHR) / KCH) * LDK + ((t + NTHR) % KCH) * 8;
    const int vs0 = (t >> 3) * LDT + (t & 7) * 8;
#define ATT_BL(rs, vo, so) __builtin_bit_cast(uint4, __builtin_amdgcn_raw_buffer_load_b128(rs, vo, so, 0))
#define ATT_LOAD(key0) do { const int kso_ = (key0) * (DK * 2), vso_ = (key0) * 2; \
        rk0 = ATT_BL(krs, ko0, kso_); rk1 = ATT_BL(krs, ko1, kso_); \
        rv0 = ATT_BL(vrs, vo0, vso_); rv1 = ATT_BL(vrs, vo0, vso_ + 32 * LT * 2); \
        if constexpr (NVC == 4) { rv2 = ATT_BL(vrs, vo0, vso_ + 64 * LT * 2); rv3 = ATT_BL(vrs, vo0, vso_ + 96 * LT * 2); } } while (0)
#define ATT_STORE(buf) do { *(uint4*)(Ks + (buf) * 64 * LDK + ks0) = rk0; if (k1ok) *(uint4*)(Ks + (buf) * 64 * LDK + ks1) = rk1; \
        *(uint4*)(Vs + (buf) * DV * LDT + vs0) = rv0; *(uint4*)(Vs + (buf) * DV * LDT + 32 * LDT + vs0) = rv1; \
        if constexpr (NVC == 4) { *(uint4*)(Vs + (buf) * DV * LDT + 64 * LDT + vs0) = rv2; *(uint4*)(Vs + (buf) * DV * LDT + 96 * LDT + vs0) = rv3; } } while (0)
    ATT_LOAD(0);
    ATT_STORE(0);
    __syncthreads();
#pragma unroll
    for (int d = 0; d < NDB; ++d)
#pragma unroll
        for (int e = 0; e < 16; ++e) O[d][e] = 0.f;
    float qn2 = 0.f;
#pragma unroll
    for (int ks = 0; ks < KS; ++ks) {
        float qv[8];
#pragma unroll
        for (int j = 0; j < 8; ++j) qv[j] = bf2f((bf16_t)qf[ks][j]) * c;
        uint4 w; w.x = pk_bf16(qv[0], qv[1]); w.y = pk_bf16(qv[2], qv[3]); w.z = pk_bf16(qv[4], qv[5]); w.w = pk_bf16(qv[6], qv[7]);
        qf[ks] = __builtin_bit_cast(bf16x8, w);
#pragma unroll
        for (int j = 0; j < 8; ++j) { const float r = bf2f((bf16_t)qf[ks][j]); qn2 += r * r; }
    }
    qn2 = half_sum(qn2);
    const float Mrow = sqrtf(qn2 * kmax2) * 1.02f + 1e-3f;
    const bool fast = __all(Mrow < 50.f) != 0;
    float m_run = -1e30f, l_run = 0.f;
    const int nt = nkeys >> 6;
    auto tile_loop = [&](auto fast_tag) {
    constexpr bool FAST = decltype(fast_tag)::value;
    f32x16 Cinit;
#pragma unroll
    for (int e = 0; e < 16; ++e) Cinit[e] = FAST ? -Mrow : 0.f;
    f32x16 Lacc;
#pragma unroll
    for (int e = 0; e < 16; ++e) Lacc[e] = 0.f;
    const bf16x8 ones = {0x3F80, 0x3F80, 0x3F80, 0x3F80, 0x3F80, 0x3F80, 0x3F80, 0x3F80};
    auto body = [&](auto cur_c, const int kt, const bool more) {
        const int cur = cur_c;
        if (more) { const int key0 = (kt + 1) * 64; ATT_LOAD(key0); }
        __builtin_amdgcn_sched_barrier(0);
        f32x16 S0, S1;
        const bf16_t* kb = Ks + (cur * 64 + l32) * LDK + h * 8;
        bf16x8 kf0[KS], kf1[KS];
#pragma unroll
        for (int ks = 0; ks < KS; ++ks) { kf0[ks] = *(const bf16x8*)(kb + ks * 16); kf1[ks] = *(const bf16x8*)(kb + 32 * LDK + ks * 16); }
        __builtin_amdgcn_sched_barrier(0);
        S0 = MFMA32(kf0[0], qf[0], Cinit); S1 = MFMA32(kf1[0], qf[0], Cinit);
#pragma unroll
        for (int ks = 1; ks < KS; ++ks) { S0 = MFMA32(kf0[ks], qf[ks], S0); S1 = MFMA32(kf1[ks], qf[ks], S1); }
        constexpr int VPF = NDB < 2 ? NDB : 2;
        bf16x8 vf[VPF][4];
#pragma unroll
        for (int d = 0; d < VPF; ++d) {
            const bf16_t* vb = Vs + (cur * DV + d * 32 + l32) * LDT + h * 8;
#pragma unroll
            for (int j = 0; j < 4; ++j) vf[d][j] = *(const bf16x8*)(vb + j * 16);
        }
        __builtin_amdgcn_sched_barrier(0);
        if constexpr (FAST) {
#pragma unroll
            for (int e = 0; e < 16; ++e) { S0[e] = __builtin_amdgcn_exp2f(S0[e]); S1[e] = __builtin_amdgcn_exp2f(S1[e]); }
            if constexpr (!LSUM_MFMA) {
#pragma unroll
                for (int e = 0; e < 16; ++e) { l_run += S0[e]; l_run += S1[e]; }
            }
        } else {
            float mx = fmaxf(S0[0], S1[0]);
#pragma unroll
            for (int e = 1; e < 16; ++e) mx = fmaxf(mx, fmaxf(S0[e], S1[e]));
            mx = half_max(mx);
            const float m_new = fmaxf(m_run, mx);
            const float alpha = __builtin_amdgcn_exp2f(m_run - m_new);
            m_run = m_new;
            float ls = 0.f;
#pragma unroll
            for (int e = 0; e < 16; ++e) { S0[e] = __builtin_amdgcn_exp2f(S0[e] - m_new); S1[e] = __builtin_amdgcn_exp2f(S1[e] - m_new); ls += S0[e] + S1[e]; }
            l_run = l_run * alpha + ls;
#pragma unroll
            for (int d = 0; d < NDB; ++d)
#pragma unroll
                for (int e = 0; e < 16; ++e) O[d][e] *= alpha;
        }
        bf16x8 pf[4];
        {
            uint4 w;
            w.x = pk_bf16(S0[0], S0[1]); w.y = pk_bf16(S0[2], S0[3]); w.z = pk_bf16(S0[4], S0[5]); w.w = pk_bf16(S0[6], S0[7]); pf[0] = __builtin_bit_cast(bf16x8, w);
            w.x = pk_bf16(S0[8], S0[9]); w.y = pk_bf16(S0[10], S0[11]); w.z = pk_bf16(S0[12], S0[13]); w.w = pk_bf16(S0[14], S0[15]); pf[1] = __builtin_bit_cast(bf16x8, w);
            w.x = pk_bf16(S1[0], S1[1]); w.y = pk_bf16(S1[2], S1[3]); w.z = pk_bf16(S1[4], S1[5]); w.w = pk_bf16(S1[6], S1[7]); pf[2] = __builtin_bit_cast(bf16x8, w);
            w.x = pk_bf16(S1[8], S1[9]); w.y = pk_bf16(S1[10], S1[11]); w.z = pk_bf16(S1[12], S1[13]); w.w = pk_bf16(S1[14], S1[15]); pf[3] = __builtin_bit_cast(bf16x8, w);
        }
        if constexpr (FAST && LSUM_MFMA) {
#pragma unroll
            for (int j = 0; j < 4; ++j) Lacc = MFMA32(ones, pf[j], Lacc);
        }
        __builtin_amdgcn_sched_barrier(0);
        if constexpr (NDB > VPF) {
#pragma unroll
            for (int d = 0; d < NDB; ++d) {
#pragma unroll
                for (int j = 0; j < 4; ++j) O[d] = MFMA32(vf[d % VPF][j], pf[j], O[d]);
                if (d + VPF < NDB) {
                    __builtin_amdgcn_sched_barrier(0);
                    const bf16_t* vb = Vs + (cur * DV + (d + VPF) * 32 + l32) * LDT + h * 8;
#pragma unroll
                    for (int j = 0; j < 4; ++j) vf[d % VPF][j] = *(const bf16x8*)(vb + j * 16);
                    __builtin_amdgcn_sched_barrier(0);
                }
            }
        } else {
#pragma unroll
            for (int d = 0; d < VPF; ++d)
#pragma unroll
                for (int j = 0; j < 4; ++j) O[d] = MFMA32(vf[d][j], pf[j], O[d]);
        }
        __builtin_amdgcn_sched_barrier(0);
        if (more) { const int nb = cur ^ 1; ATT_STORE(nb); }
        __syncthreads();
    };
    for (int kt = 0; kt < nt; kt += 2) {
        body(std::integral_constant<int, 0>{}, kt, true);
        body(std::integral_constant<int, 1>{}, kt + 1, kt + 2 < nt);
    }
    if constexpr (FAST && LSUM_MFMA) l_run = 0.5f * Lacc[0];
    };
    if (fast) tile_loop(std::true_type{}); else tile_loop(std::false_type{});
    l_tot = half_sum(l_run);
#undef ATT_LOAD
#undef ATT_BL
#undef ATT_STORE
}

DI float kmax_of(const Params& p, int idx) { return __uint_as_float(__hip_atomic_load(p.kmax + idx, __ATOMIC_RELAXED, __HIP_MEMORY_SCOPE_AGENT)); }
DI void attn0_unit(const Params& p, int u, char* smem) {
    int b, hd, qb;
    if (u < NB * 4 * 64) { b = u / 256; hd = (u >> 6) & 3; qb = 2 + (u & 63); }
    else { const int v = u - NB * 4 * 64; b = v >> 3; hd = (v >> 1) & 3; qb = v & 1; }
    const int nkeys = qb < 2 ? LC : LT;
    const bf16_t* Q = (const bf16_t*)p.x2;
    const bf16_t* K = Q + (size_t)NB * 8 * LT * 64;
    const bf16_t* VT = K + (size_t)NB * 8 * LT * 64;
    float* Otmp = (float*)p.x1;
    bf16_t* CAT = (bf16_t*)p.x4;
    const int lane = tid() & 63, wave = tid() >> 6, l32 = lane & 31, h = lane >> 5;
    const int qpos0 = qb * 128;
    const int row = b * LT + qpos0 + wave * 32 + l32;
    const float c = 0.125f * LOG2E;
    const bf16_t* VTh = VT + (size_t)(b * 4 + hd) * 128 * LT;
    float* ot = Otmp + ((size_t)row * 4 + hd) * 128;
    f32x16 O[4]; float l_tot;
    attn_core<64, 128, false>(Q + (size_t)(b * 8 + hd * 2 + 0) * LT * 64, K + (size_t)(b * 8 + hd * 2 + 0) * LT * 64, VTh, qpos0, nkeys, c, kmax_of(p, b * 8 + hd * 2 + 0), smem, O, l_tot);
    {
        const float inv = 1.f / l_tot;
#pragma unroll
        for (int d = 0; d < 4; ++d)
#pragma unroll
            for (int g = 0; g < 4; ++g) {
                float4 v = {O[d][4 * g] * inv, O[d][4 * g + 1] * inv, O[d][4 * g + 2] * inv, O[d][4 * g + 3] * inv};
                *(float4*)(ot + d * 32 + 8 * g + 4 * h) = v;
            }
    }
    attn_core<64, 128, false>(Q + (size_t)(b * 8 + hd * 2 + 1) * LT * 64, K + (size_t)(b * 8 + hd * 2 + 1) * LT * 64, VTh, qpos0, nkeys, c, kmax_of(p, b * 8 + hd * 2 + 1), smem, O, l_tot);
    {
        const float inv = 1.f / l_tot, lam = p.lamv[0];
        float ss = 0.f;
#pragma unroll
        for (int d = 0; d < 4; ++d)
#pragma unroll
            for (int g = 0; g < 4; ++g) {
                const float4 o1 = *(const float4*)(ot + d * 32 + 8 * g + 4 * h);
                O[d][4 * g] = o1.x - lam * O[d][4 * g] * inv; O[d][4 * g + 1] = o1.y - lam * O[d][4 * g + 1] * inv;
                O[d][4 * g + 2] = o1.z - lam * O[d][4 * g + 2] * inv; O[d][4 * g + 3] = o1.w - lam * O[d][4 * g + 3] * inv;
                ss += O[d][4 * g] * O[d][4 * g] + O[d][4 * g + 1] * O[d][4 * g + 1] + O[d][4 * g + 2] * O[d][4 * g + 2] + O[d][4 * g + 3] * O[d][4 * g + 3];
            }
        ss = half_sum(ss);
        const float rinv = rsqrtf(ss * (1.f / 128.f) + EPSV) * 0.8f;
        const float* sub = p.in[10];
        bf16_t* op = CAT + (size_t)row * DM + hd * 128;
#pragma unroll
        for (int d = 0; d < 4; ++d)
#pragma unroll
            for (int g = 0; g < 4; ++g) {
                const int dv = d * 32 + 8 * g + 4 * h;
                const float4 sb = *(const float4*)(sub + dv);
                uint2 o; o.x = pk_bf16(O[d][4 * g] * rinv * sb.x, O[d][4 * g + 1] * rinv * sb.y); o.y = pk_bf16(O[d][4 * g + 2] * rinv * sb.z, O[d][4 * g + 3] * rinv * sb.w);
                *(uint2*)(op + dv) = o;
            }
    }
}

DI void attn1_unit(const Params& p, int u, char* smem) {
    const bf16_t* Q1 = (const bf16_t*)p.x2;
    const bf16_t* K1 = Q1 + (size_t)NB * 8 * LT * 64;
    const bf16_t* VT1 = K1 + (size_t)NB * 2 * LT * 64;
    const bf16_t* MQ = VT1 + (size_t)NB * 2 * 64 * LT;
    const bf16_t* MK = MQ + (size_t)NB * 8 * LT * 48;
    const bf16_t* MVT = MK + (size_t)NB * 8 * LT * 48;
    bf16_t* CAT = (bf16_t*)p.x4;
    const int lane = tid() & 63, wave = tid() >> 6, l32 = lane & 31, h = lane >> 5;
    const int mla = u >= 2048, v = u & 2047, b = v >> 9, hd = (v >> 6) & 7, qb = 2 + (v & 63);
    const int qpos0 = qb * 128;
    const int row = b * LT + qpos0 + wave * 32 + l32;
    f32x16 O[2]; float l_tot;
    if (!mla) attn_core<64, 64, false>(Q1 + (size_t)(b * 8 + hd) * LT * 64, K1 + (size_t)(b * 2 + (hd >> 2)) * LT * 64, VT1 + (size_t)(b * 2 + (hd >> 2)) * 64 * LT, qpos0, LT, 0.125f * LOG2E, kmax_of(p, 32 + b * 2 + (hd >> 2)), smem, O, l_tot);
    else attn_core<48, 64, false>(MQ + (size_t)(b * 8 + hd) * LT * 48, MK + (size_t)(b * 8 + hd) * LT * 48, MVT + (size_t)(b * 8 + hd) * 64 * LT, qpos0, LT, 0.14433756729740643f * LOG2E, kmax_of(p, 40 + b * 8 + hd), smem, O, l_tot);
    const float inv = 1.f / l_tot;
    bf16_t* op = CAT + (size_t)row * DM + mla * 512 + hd * 64;
#pragma unroll
    for (int d = 0; d < 2; ++d)
#pragma unroll
        for (int g = 0; g < 4; ++g) {
            uint2 o; o.x = pk_bf16(O[d][4 * g] * inv, O[d][4 * g + 1] * inv); o.y = pk_bf16(O[d][4 * g + 2] * inv, O[d][4 * g + 3] * inv);
            *(uint2*)(op + d * 32 + 8 * g + 4 * h) = o;
        }
}

#define ROPE64(x, cr, sr, cc, sc) do { _Pragma("unroll") for (int i_ = 0; i_ < 16; ++i_) { \
    const float a_ = x[i_], b_ = x[i_ + 16]; x[i_] = a_ * (cr)[i_] - b_ * (sr)[i_]; x[i_ + 16] = a_ * (sr)[i_] + b_ * (cr)[i_]; \
    const float c_ = x[32 + i_], d_ = x[48 + i_]; x[32 + i_] = c_ * (cc)[i_] - d_ * (sc)[i_]; x[48 + i_] = c_ * (sc)[i_] + d_ * (cc)[i_]; } } while (0)

constexpr int SEG_LDS_OFF_E = 73728;
struct WEpiInProj0 { static constexpr int MODE = 0; static constexpr bool TILE = true; static constexpr bool PRELOAD = false; const Params* pp;
    DI void store(int, int, uint4) const {}
    DI void tile(const bf16_t* cb, int row0, int col0, char* smem) const {
        const Params& p = *pp;
        const int t = tid(), nt = col0 >> 8;
        const int b = row0 / LT, pos0 = row0 - b * LT;
        const bool lat = pos0 >= LC;
        bf16_t* Q = (bf16_t*)p.x2;
        bf16_t* K = Q + (size_t)NB * 8 * LT * 64;
        bf16_t* VT = K + (size_t)NB * 8 * LT * 64;
        if (nt < 4) {
            const bool isk = nt >= 2; const int hj0 = (nt & 1) * 4;
            unsigned* lmax = (unsigned*)(smem + SEG_LDS_OFF_E);
            if (isk) { if (t < 4) lmax[t] = 0u; __syncthreads(); }
#pragma unroll 1
            for (int it = 0; it < 2; ++it) {
                const int item = t + NTHR * it, rr = item >> 2, v = item & 3;
                const bf16_t* src = cb + rr * CBP + v * 64;
                float x[64];
#pragma unroll
                for (int c8 = 0; c8 < 8; ++c8) {
                    const uint4 w = *(const uint4*)(src + c8 * 8);
                    x[c8 * 8 + 0] = bflo(w.x); x[c8 * 8 + 1] = bfhi(w.x); x[c8 * 8 + 2] = bflo(w.y); x[c8 * 8 + 3] = bfhi(w.y);
                    x[c8 * 8 + 4] = bflo(w.z); x[c8 * 8 + 5] = bfhi(w.z); x[c8 * 8 + 6] = bflo(w.w); x[c8 * 8 + 7] = bfhi(w.w);
                }
                if (lat) {
                    const int tpos = pos0 + rr - LC, gr = tpos >> 6, gc = tpos & 63;
                    const float* cr = p.tab + TB_CR + gr * 16; const float* sr = p.tab + TB_SR + gr * 16;
                    const float* cc = p.tab + TB_CC + gc * 16; const float* sc = p.tab + TB_SC + gc * 16;
                    ROPE64(x, cr, sr, cc, sc);
                }
                if (isk) { float ss = 0.f;
#pragma unroll
                    for (int i = 0; i < 64; ++i) ss += x[i] * x[i];
                    atomicMax(&lmax[v], __float_as_uint(ss)); }
                bf16_t* dst = (isk ? K : Q) + ((size_t)(b * 8 + hj0 + v) * LT + pos0 + rr) * 64;
#pragma unroll
                for (int c8 = 0; c8 < 8; ++c8) {
                    uint4 w; w.x = pk_bf16(x[c8 * 8], x[c8 * 8 + 1]); w.y = pk_bf16(x[c8 * 8 + 2], x[c8 * 8 + 3]); w.z = pk_bf16(x[c8 * 8 + 4], x[c8 * 8 + 5]); w.w = pk_bf16(x[c8 * 8 + 6], x[c8 * 8 + 7]);
                    *(uint4*)(dst + c8 * 8) = w;
                }
            }
            if (isk) { __syncthreads(); if (t < 4) atomicMax(&p.kmax[b * 8 + hj0 + t], lmax[t]); }
        } else if (nt < 6) {
#pragma unroll 4
            for (int it = 0; it < 16; ++it) {
                const int idx = t + NTHR * it, col = idx >> 4, q = idx & 15;
                const int kbase = 16 * (q >> 1) + 4 * (q & 1);
                unsigned short e[8];
#pragma unroll
                for (int j = 0; j < 8; ++j) e[j] = cb[(kbase + 8 * (j >> 2) + (j & 3)) * CBP + col];
                uint4 o; o.x = e[0] | ((unsigned)e[1] << 16); o.y = e[2] | ((unsigned)e[3] << 16); o.z = e[4] | ((unsigned)e[5] << 16); o.w = e[6] | ((unsigned)e[7] << 16);
                const int head = (nt - 4) * 2 + (col >> 7), dv = col & 127;
                *(uint4*)(VT + ((size_t)(b * 4 + head) * 128 + dv) * LT + pos0 + q * 8) = o;
            }
        } else {
            bf16_t* UG = (bf16_t*)(p.x1 + (size_t)NT * 1536 * 2);
#pragma unroll 4
            for (int it = 0; it < 16; ++it) {
                const int idx = t + NTHR * it, row = idx >> 5, c8 = (idx & 31) * 8;
                *(uint4*)(UG + (size_t)(row0 + row) * 1024 + (col0 - 1536) + c8) = *(const uint4*)(cb + row * CBP + c8);
            }
        }
    }
};

template <int NC, int LP>
DI void vt_write(const bf16_t* tile, bf16_t* dst, int pos0) {
    const int t = tid();
#pragma unroll
    for (int it = 0; it < NC * 8 / NTHR; ++it) {
        const int idx = t + NTHR * it, col = idx >> 3, q = idx & 7;
        const int kbase = 16 * (q >> 1) + 4 * (q & 1);
        unsigned short e[8];
#pragma unroll
        for (int j = 0; j < 8; ++j) e[j] = tile[(kbase + 8 * (j >> 2) + (j & 3)) * LP + col];
        uint4 o; o.x = e[0] | ((unsigned)e[1] << 16); o.y = e[2] | ((unsigned)e[3] << 16); o.z = e[4] | ((unsigned)e[5] << 16); o.w = e[6] | ((unsigned)e[7] << 16);
        *(uint4*)(dst + (size_t)col * LT + pos0 + q * 8) = o;
    }
}

DI void postproj0_unit(const Params& p, int u, char* smem) {
    const bf16_t* raw = (const bf16_t*)p.x1;
    bf16_t* Q = (bf16_t*)p.x2;
    bf16_t* K = Q + (size_t)NB * 8 * LT * 64;
    bf16_t* VT = K + (size_t)NB * 8 * LT * 64;
    float* tb = (float*)smem;
    bf16_t* tile = (bf16_t*)(smem + 8448);
    const int t = tid();
    const int r0 = u * 64, b = r0 / LT, pos0 = r0 - b * LT;
    const bool lat = pos0 >= LC;
    const int gr = lat ? (pos0 - LC) >> 6 : 0;
    unsigned* lmax = (unsigned*)(smem + 32768);
    if (t < 16) lmax[t] = 0u;
    for (int i = t; i < 1024; i += NTHR) { tb[i] = p.tab[TB_CC + i]; tb[1024 + i] = p.tab[TB_SC + i]; }
    if (t < 16) { tb[2048 + t] = p.tab[TB_CR + gr * 16 + t]; tb[2064 + t] = p.tab[TB_SR + gr * 16 + t]; }
    __syncthreads();
#pragma unroll 1
    for (int it = 0; it < 4; ++it) {
        const int item = t + NTHR * it, rr = item >> 4, vec = item & 15;
        const bf16_t* src = raw + (size_t)(r0 + rr) * 1536 + (vec < 8 ? vec * 64 : 512 + (vec - 8) * 64);
        float x[64];
#pragma unroll
        for (int c8 = 0; c8 < 8; ++c8) {
            const uint4 w = *(const uint4*)(src + c8 * 8);
            x[c8 * 8 + 0] = bflo(w.x); x[c8 * 8 + 1] = bfhi(w.x); x[c8 * 8 + 2] = bflo(w.y); x[c8 * 8 + 3] = bfhi(w.y);
            x[c8 * 8 + 4] = bflo(w.z); x[c8 * 8 + 5] = bfhi(w.z); x[c8 * 8 + 6] = bflo(w.w); x[c8 * 8 + 7] = bfhi(w.w);
        }
        if (lat) { const float* cc = tb + rr * 16; const float* sc = tb + 1024 + rr * 16; ROPE64(x, tb + 2048, tb + 2064, cc, sc); }
        if (vec >= 8) { float ss = 0.f;
#pragma unroll
            for (int i = 0; i < 64; ++i) ss += x[i] * x[i];
            atomicMax(&lmax[vec & 7], __float_as_uint(ss)); }
        bf16_t* dst = (vec < 8 ? Q : K) + ((size_t)(b * 8 + (vec & 7)) * LT + pos0 + rr) * 64;
#pragma unroll
        for (int c8 = 0; c8 < 8; ++c8) {
            uint4 w; w.x = pk_bf16(x[c8 * 8], x[c8 * 8 + 1]); w.y = pk_bf16(x[c8 * 8 + 2], x[c8 * 8 + 3]); w.z = pk_bf16(x[c8 * 8 + 4], x[c8 * 8 + 5]); w.w = pk_bf16(x[c8 * 8 + 6], x[c8 * 8 + 7]);
            *(uint4*)(dst + c8 * 8) = w;
        }
    }
    __syncthreads();
    if (t < 8) atomicMax(&p.kmax[b * 8 + t], lmax[t]);
    for (int hd = 0; hd < 4; ++hd) {
        __syncthreads();
#pragma unroll
        for (int it = 0; it < 4; ++it) {
            const int idx = t + NTHR * it, rr = idx >> 4, c16 = idx & 15;
            *(uint4*)(tile + rr * 136 + c16 * 8) = *(const uint4*)(raw + (size_t)(r0 + rr) * 1536 + 1024 + hd * 128 + c16 * 8);
        }
        __syncthreads();
        vt_write<128, 136>(tile, VT + (size_t)(b * 4 + hd) * 128 * LT, pos0);
    }
    __syncthreads();
}

DI void postproj1a_unit(const Params& p, int u, char* smem) {
    const bf16_t* raw = (const bf16_t*)p.x1;
    bf16_t* CQn = (bf16_t*)(p.x1 + (size_t)NT * CD_INP * 2);
    bf16_t* CKVn = CQn + (size_t)NT * 256;
    bf16_t* KR = CKVn + (size_t)NT * 128;
    bf16_t* Q1 = (bf16_t*)p.x2;
    bf16_t* K1 = Q1 + (size_t)NB * 8 * LT * 64;
    bf16_t* VT1 = K1 + (size_t)NB * 2 * LT * 64;
    float* tb = (float*)smem;
    bf16_t* tile = (bf16_t*)(smem + 8448);
    const int t = tid(), lane = t & 63, wave = t >> 6;
    const int r0 = u * 64, b = r0 / LT, pos0 = r0 - b * LT;
    const bool lat = pos0 >= LC;
    const int gr = lat ? (pos0 - LC) >> 6 : 0;
    unsigned* lmax = (unsigned*)(smem + 32768);
    if (t < 16) lmax[t] = 0u;
    for (int i = t; i < 1024; i += NTHR) { tb[i] = p.tab[TB_CC + i]; tb[1024 + i] = p.tab[TB_SC + i]; }
    if (t < 16) { tb[2048 + t] = p.tab[TB_CR + gr * 16 + t]; tb[2064 + t] = p.tab[TB_SR + gr * 16 + t]; }
    __syncthreads();
    uint4 rw[8];
    {
        const int rr = t / 10, vec = t - rr * 10;
        const bf16_t* src = raw + (size_t)(r0 + rr) * CD_INP + vec * 64;
#pragma unroll
        for (int c8 = 0; c8 < 8; ++c8) rw[c8] = *(const uint4*)(src + c8 * 8);
    }
#pragma unroll 1
    for (int it = 0; it < 3; ++it) {
        const int item = t + NTHR * it;
        uint4 rn[8];
        {
            int itn = item + NTHR; if (itn > 639) itn = 639;
            const int rrn = itn / 10, vecn = itn - rrn * 10;
            const bf16_t* srcn = raw + (size_t)(r0 + rrn) * CD_INP + vecn * 64;
#pragma unroll
            for (int c8 = 0; c8 < 8; ++c8) rn[c8] = *(const uint4*)(srcn + c8 * 8);
        }
        if (item < 640) {
            const int rr = item / 10, vec = item - rr * 10;
            const float* nw = vec < 8 ? p.in[20] : p.in[21];
            float x[64]; float ss = 0.f;
#pragma unroll
            for (int c8 = 0; c8 < 8; ++c8) {
                const uint4 w = rw[c8];
                x[c8 * 8 + 0] = bflo(w.x); x[c8 * 8 + 1] = bfhi(w.x); x[c8 * 8 + 2] = bflo(w.y); x[c8 * 8 + 3] = bfhi(w.y);
                x[c8 * 8 + 4] = bflo(w.z); x[c8 * 8 + 5] = bfhi(w.z); x[c8 * 8 + 6] = bflo(w.w); x[c8 * 8 + 7] = bfhi(w.w);
            }
#pragma unroll
            for (int i = 0; i < 64; ++i) ss += x[i] * x[i];
            const float rinv = rsqrtf(ss * (1.f / 64.f) + EPSV);
#pragma unroll
            for (int i = 0; i < 64; ++i) x[i] = x[i] * rinv * nw[i];
            if (lat) { const float* cc = tb + rr * 16; const float* sc = tb + 1024 + rr * 16; ROPE64(x, tb + 2048, tb + 2064, cc, sc); }
            if (vec >= 8) { float s2 = 0.f;
#pragma unroll
                for (int i = 0; i < 64; ++i) s2 += x[i] * x[i];
                atomicMax(&lmax[vec - 8], __float_as_uint(s2)); }
            bf16_t* dst = vec < 8 ? Q1 + ((size_t)(b * 8 + vec) * LT + pos0 + rr) * 64 : K1 + ((size_t)(b * 2 + (vec - 8)) * LT + pos0 + rr) * 64;
#pragma unroll
            for (int c8 = 0; c8 < 8; ++c8) {
                uint4 w; w.x = pk_bf16(x[c8 * 8], x[c8 * 8 + 1]); w.y = pk_bf16(x[c8 * 8 + 2], x[c8 * 8 + 3]); w.z = pk_bf16(x[c8 * 8 + 4], x[c8 * 8 + 5]); w.w = pk_bf16(x[c8 * 8 + 6], x[c8 * 8 + 7]);
                *(uint4*)(dst + c8 * 8) = w;
            }
        }
#pragma unroll
        for (int c8 = 0; c8 < 8; ++c8) rw[c8] = rn[c8];
    }
    __syncthreads();
    if (t < 2) atomicMax(&p.kmax[32 + b * 2 + t], lmax[t]);
#pragma unroll
    for (int it = 0; it < 4; ++it) {
        const int idx = t + NTHR * it, rr = idx >> 4, c16 = idx & 15;
        *(uint4*)(tile + rr * 136 + c16 * 8) = *(const uint4*)(raw + (size_t)(r0 + rr) * CD_INP + 640 + c16 * 8);
    }
    __syncthreads();
    vt_write<128, 136>(tile, VT1 + (size_t)b * 128 * LT, pos0);
    {
        uint2 wq[16]; unsigned wk[16];
#pragma unroll
        for (int rr = 0; rr < 16; ++rr) {
            const bf16_t* src = raw + (size_t)(r0 + wave * 16 + rr) * CD_INP;
            wq[rr] = *(const uint2*)(src + 768 + lane * 4);
            wk[rr] = *(const unsigned*)(src + 1024 + lane * 2);
        }
        const float4 nwq = *(const float4*)(p.in[22] + lane * 4);
        const float2 nwk = *(const float2*)(p.in[23] + lane * 2);
#pragma unroll
        for (int rr = 0; rr < 16; ++rr) {
            const int r = r0 + wave * 16 + rr;
            {
                const float a = bflo(wq[rr].x), bb = bfhi(wq[rr].x), cc = bflo(wq[rr].y), d = bfhi(wq[rr].y);
                const float ss = wave_sum(a * a + bb * bb + cc * cc + d * d);
                const float rinv = rsqrtf(ss * (1.f / 256.f) + EPSV);
                uint2 o; o.x = pk_bf16(a * rinv * nwq.x, bb * rinv * nwq.y); o.y = pk_bf16(cc * rinv * nwq.z, d * rinv * nwq.w);
                *(uint2*)(CQn + (size_t)r * 256 + lane * 4) = o;
            }
            {
                const float a = bflo(wk[rr]), bb = bfhi(wk[rr]);
                const float ss = wave_sum(a * a + bb * bb);
                const float rinv = rsqrtf(ss * (1.f / 128.f) + EPSV);
                *(unsigned*)(CKVn + (size_t)r * 128 + lane * 2) = pk_bf16(a * rinv * nwk.x, bb * rinv * nwk.y);
            }
        }
    }
    if (t < 64) {
        const int r = r0 + t;
        const bf16_t* src = raw + (size_t)r * CD_INP + 1152;
        const uint4 w0 = *(const uint4*)src, w1 = *(const uint4*)(src + 8);
        float x[16] = {bflo(w0.x), bfhi(w0.x), bflo(w0.y), bfhi(w0.y), bflo(w0.z), bfhi(w0.z), bflo(w0.w), bfhi(w0.w),
                       bflo(w1.x), bfhi(w1.x), bflo(w1.y), bfhi(w1.y), bflo(w1.z), bfhi(w1.z), bflo(w1.w), bfhi(w1.w)};
        if (lat) {
#pragma unroll
            for (int i = 0; i < 4; ++i) {
                const float cr = p.tab[TB_CR4 + gr * 4 + i], sr = p.tab[TB_SR4 + gr * 4 + i], cc = p.tab[TB_CC4 + t * 4 + i], sc = p.tab[TB_SC4 + t * 4 + i];
                const float a = x[i], bb = x[i + 4]; x[i] = a * cr - bb * sr; x[i + 4] = a * sr + bb * cr;
                const float c2 = x[8 + i], d2 = x[12 + i]; x[8 + i] = c2 * cc - d2 * sc; x[12 + i] = c2 * sc + d2 * cc;
            }
        }
        uint4 o0, o1;
        o0.x = pk_bf16(x[0], x[1]); o0.y = pk_bf16(x[2], x[3]); o0.z = pk_bf16(x[4], x[5]); o0.w = pk_bf16(x[6], x[7]);
        o1.x = pk_bf16(x[8], x[9]); o1.y = pk_bf16(x[10], x[11]); o1.z = pk_bf16(x[12], x[13]); o1.w = pk_bf16(x[14], x[15]);
        *(uint4*)(KR + (size_t)r * 16) = o0; *(uint4*)(KR + (size_t)r * 16 + 8) = o1;
    }
    __syncthreads();
}

DI void postproj1c_unit(const Params& p, int u, char* smem) {
    const bf16_t* MQraw = (const bf16_t*)p.x1;
    const bf16_t* MKVraw = MQraw + (size_t)NT * 384;
    const bf16_t* KR = (const bf16_t*)(p.x1 + (size_t)NT * CD_INP * 2) + (size_t)NT * 256 + (size_t)NT * 128;
    bf16_t* MQ = (bf16_t*)p.x2 + (size_t)NB * 8 * LT * 64 + (size_t)NB * 2 * LT * 64 + (size_t)NB * 2 * 64 * LT;
    bf16_t* MK = MQ + (size_t)NB * 8 * LT * 48;
    bf16_t* MVT = MK + (size_t)NB * 8 * LT * 48;
    bf16_t* tile = (bf16_t*)smem;
    unsigned* lmax = (unsigned*)(smem + 32768);
    const int t = tid();
    const int r0 = u * 64, b = r0 / LT, pos0 = r0 - b * LT;
    const bool lat = pos0 >= LC;
    const int gr = lat ? (pos0 - LC) >> 6 : 0;
    if (t < 16) lmax[t] = 0u;
    __syncthreads();
#pragma unroll 1
    for (int it = 0; it < 2; ++it) {
        const int item = t + NTHR * it, rr = item >> 3, hd = item & 7, r = r0 + rr;
        {
            const bf16_t* src = MQraw + (size_t)r * 384 + hd * 48;
            bf16_t* dst = MQ + ((size_t)(b * 8 + hd) * LT + pos0 + rr) * 48;
#pragma unroll
            for (int c8 = 0; c8 < 4; ++c8) *(uint4*)(dst + c8 * 8) = *(const uint4*)(src + c8 * 8);
            const uint4 w0 = *(const uint4*)(src + 32), w1 = *(const uint4*)(src + 40);
            float x[16] = {bflo(w0.x), bfhi(w0.x), bflo(w0.y), bfhi(w0.y), bflo(w0.z), bfhi(w0.z), bflo(w0.w), bfhi(w0.w),
                           bflo(w1.x), bfhi(w1.x), bflo(w1.y), bfhi(w1.y), bflo(w1.z), bfhi(w1.z), bflo(w1.w), bfhi(w1.w)};
            if (lat) {
#pragma unroll
                for (int i = 0; i < 4; ++i) {
                    const float cr = p.tab[TB_CR4 + gr * 4 + i], sr = p.tab[TB_SR4 + gr * 4 + i], cc = p.tab[TB_CC4 + rr * 4 + i], sc = p.tab[TB_SC4 + rr * 4 + i];
                    const float a = x[i], bb = x[i + 4]; x[i] = a * cr - bb * sr; x[i + 4] = a * sr + bb * cr;
                    const float c2 = x[8 + i], d2 = x[12 + i]; x[8 + i] = c2 * cc - d2 * sc; x[12 + i] = c2 * sc + d2 * cc;
                }
            }
            uint4 o0, o1;
            o0.x = pk_bf16(x[0], x[1]); o0.y = pk_bf16(x[2], x[3]); o0.z = pk_bf16(x[4], x[5]); o0.w = pk_bf16(x[6], x[7]);
            o1.x = pk_bf16(x[8], x[9]); o1.y = pk_bf16(x[10], x[11]); o1.z = pk_bf16(x[12], x[13]); o1.w = pk_bf16(x[14], x[15]);
            *(uint4*)(dst + 32) = o0; *(uint4*)(dst + 40) = o1;
        }
        {
            const bf16_t* src = MKVraw + (size_t)r * 768 + hd * 96;
            bf16_t* dst = MK + ((size_t)(b * 8 + hd) * LT + pos0 + rr) * 48;
            float s2 = 0.f;
#pragma unroll
            for (int c8 = 0; c8 < 6; ++c8) {
                const uint4 w = c8 < 4 ? *(const uint4*)(src + c8 * 8) : *(const uint4*)(KR + (size_t)r * 16 + (c8 - 4) * 8);
                *(uint4*)(dst + c8 * 8) = w;
                s2 += bflo(w.x) * bflo(w.x) + bfhi(w.x) * bfhi(w.x) + bflo(w.y) * bflo(w.y) + bfhi(w.y) * bfhi(w.y) + bflo(w.z) * bflo(w.z) + bfhi(w.z) * bfhi(w.z) + bflo(w.w) * bflo(w.w) + bfhi(w.w) * bfhi(w.w);
            }
            atomicMax(&lmax[hd], __float_as_uint(s2));
        }
    }
    __syncthreads();
    if (t < 8) atomicMax(&p.kmax[40 + b * 8 + t], lmax[t]);
    {
        const int rra = t >> 3, c8a = t & 7;
        const bf16_t* va_p = MKVraw + (size_t)(r0 + rra) * 768 + 32 + c8a * 8;
        const bf16_t* vb_p = va_p + (size_t)32 * 768;
        uint4 va = *(const uint4*)va_p, vb = *(const uint4*)vb_p;
        for (int hd = 0; hd < 8; ++hd) {
            __syncthreads();
            *(uint4*)(tile + rra * 72 + c8a * 8) = va;
            *(uint4*)(tile + (rra + 32) * 72 + c8a * 8) = vb;
            const int hn = hd < 7 ? hd + 1 : 7;
            va = *(const uint4*)(va_p + hn * 96); vb = *(const uint4*)(vb_p + hn * 96);
            __syncthreads();
            vt_write<64, 72>(tile, MVT + (size_t)(b * 8 + hd) * 64 * LT, pos0);
        }
    }
    __syncthreads();
}

template <int MODE>
DI void lru_unit(const Params& p, int u, char* smem) {
    const bf16_t* UG = (const bf16_t*)(p.x1 + (size_t)NT * 1536 * 2);
    bf16_t* CAT = (bf16_t*)p.x4;
    bf16_t* ys = (bf16_t*)smem;
    float* AB = (float*)(smem + 64 * 72 * 2);
    const int t = tid(), lane = t & 63, wave = t >> 6, l32 = lane & 31, h = lane >> 5;
    const int n = u & 7, ci = (u >> 3) % NCHUNK_T, b = (u >> 3) / NCHUNK_T;
    const int pos0 = ci * 64, r0 = b * LT + pos0;
    const int seq_lo = ci < 4 ? 0 : LC, seq_hi = ci < 4 ? LC : LT;
    {
        const int c = t & 63, tq = t >> 6, cg = n * 64 + c;
        const float w0 = p.in[11][cg], w1 = p.in[11][512 + cg], w2 = p.in[11][1024 + cg], w3 = p.in[11][1536 + cg], cb = p.in[12][cg];
        const int tp = pos0 + tq * 16;
        float uv[19];
#pragma unroll
        for (int i = 0; i < 19; ++i) { const int pos = tp - 2 + i; const int pc = pos < seq_lo ? seq_lo : (pos >= seq_hi ? seq_hi - 1 : pos);
            const float v = bf2f(UG[(size_t)(b * LT + pc) * 1024 + cg]); uv[i] = (pos >= seq_lo && pos < seq_hi) ? v : 0.f; }
#pragma unroll
        for (int tt = 0; tt < 16; ++tt) {
            const float y = cb + w0 * uv[tt] + w1 * uv[tt + 1] + w2 * uv[tt + 2] + w3 * uv[tt + 3];
            ys[(tq * 16 + tt) * 72 + c] = f2bf(y);
        }
    }
    __syncthreads();
    {
        const int d = wave >> 1, jh = wave & 1;
        f32x16 acc[2][2];
#pragma unroll
        for (int i = 0; i < 2; ++i)
#pragma unroll
            for (int j = 0; j < 2; ++j)
#pragma unroll
                for (int e = 0; e < 16; ++e) acc[i][j][e] = 0.f;
        const bf16_t* ap = ys + l32 * 72 + h * 8;
        const bf16_t* bp = p.lw + ((size_t)(((n * 2 + d) * 2 + jh) * 2) * 32 + l32) * 64 + h * 8;
#pragma unroll
        for (int ks = 0; ks < 4; ++ks) {
            const bf16x8 fa0 = *(const bf16x8*)(ap + ks * 16), fa1 = *(const bf16x8*)(ap + 32 * 72 + ks * 16);
            const bf16x8 fb0 = *(const bf16x8*)(bp + ks * 16), fb1 = *(const bf16x8*)(bp + 32 * 64 + ks * 16);
            acc[0][0] = MFMA32(fa0, fb0, acc[0][0]); acc[0][1] = MFMA32(fa0, fb1, acc[0][1]);
            acc[1][0] = MFMA32(fa1, fb0, acc[1][0]); acc[1][1] = MFMA32(fa1, fb1, acc[1][1]);
        }
        const int ch = jh * 32 + l32, cg = n * 64 + ch;
        const float ba = p.in[14][(d * 8 + n) * 64 + ch], bx = p.in[16][(d * 8 + n) * 64 + ch];
        const float lam = p.in[17][(d * 8 + n) * 64 + ch];
        const float sp = log1pf(expf(-lam));
        (void)cg;
#pragma unroll
        for (int mi = 0; mi < 2; ++mi)
#pragma unroll
            for (int i = 0; i < 16; ++i) {
                const int tm = mi * 32 + acc_row(i, h);
                AB[((d * 2 + 0) * 64 + tm) * 64 + ch] = acc[mi][0][i] + ba;
                AB[((d * 2 + 1) * 64 + tm) * 64 + ch] = acc[mi][1][i] + bx;
            }
#pragma unroll 2
        for (int e = 0; e < 32; ++e) {
            const int tm = (e >> 4) * 32 + acc_row(e & 15, h);
            float* pa = AB + ((d * 2 + 0) * 64 + tm) * 64 + ch;
            float* pb = AB + ((d * 2 + 1) * 64 + tm) * 64 + ch;
            const float r = sigm(*pa), ig = sigm(*pb);
            const float la = -8.f * r * sp;
            const float a = __builtin_amdgcn_exp2f(1.4426950408889634f * la);
            const float bb = __builtin_amdgcn_sqrtf(fmaxf(1.f - a * a, 0.f)) * ig * bf2f(ys[tm * 72 + ch]);
            *pa = a; *pb = bb;
        }
    }
    __syncthreads();
    if (t < 128) {
        const int d = t >> 6, c = t & 63, cg = n * 64 + c;
        const float* Aa = AB + (d * 2 + 0) * 4096 + c;
        float* Bb = AB + (d * 2 + 1) * 4096 + c;
        const size_t aidx = ((size_t)(b * NCHUNK_T + ci) * 2 + d) * 512 + cg;
        if (MODE == 1) {
            float hh = 0.f, P = 1.f;
#pragma unroll 4
            for (int s = 0; s < 64; ++s) { const int tt = d ? 63 - s : s; const float a = Aa[tt * 64]; hh = a * hh + Bb[tt * 64]; P *= a; }
            *(float2*)(p.agg + aidx * 2) = make_float2(P, hh);
        } else {
            float hh = p.carry[aidx];
#pragma unroll 4
            for (int s = 0; s < 64; ++s) { const int tt = d ? 63 - s : s; hh = Aa[tt * 64] * hh + Bb[tt * 64]; Bb[tt * 64] = hh; }
        }
    }
    __syncthreads();
    if (MODE == 3) {
        const int c = t & 63, tq = t >> 6, cg = n * 64 + c;
        float gv[16];
#pragma unroll
        for (int tt = 0; tt < 16; ++tt) gv[tt] = bf2f(UG[(size_t)(r0 + tq * 16 + tt) * 1024 + 512 + cg]);
#pragma unroll
        for (int tt = 0; tt < 16; ++tt) {
            const int tm = tq * 16 + tt;
            const float hs = AB[(1 * 64 + tm) * 64 + c] + AB[(3 * 64 + tm) * 64 + c];
            CAT[(size_t)(r0 + tm) * DM + 512 + cg] = f2bf(hs * gelu_tanh(gv[tt]));
        }
        __syncthreads();
    }
}
DI void lru_carry_unit(const Params& p, int v) {
    const int id = v * NTHR + tid();
    const int cg = id & 511, d = (id >> 9) & 1, b = id >> 10;
    float carry = 0.f;
    for (int s0 = 0; s0 < NCHUNK_T; s0 += 12) {
        float2 ag[12]; size_t ai[12];
#pragma unroll
        for (int j = 0; j < 12; ++j) {
            const int s = s0 + j;
            int ci;
            if (d == 0) ci = s; else ci = s < 4 ? 3 - s : NCHUNK_T - 1 - (s - 4);
            ai[j] = ((size_t)(b * NCHUNK_T + ci) * 2 + d) * 512 + cg;
            ag[j] = *(const float2*)(p.agg + ai[j] * 2);
        }
#pragma unroll
        for (int j = 0; j < 12; ++j) { p.carry[ai[j]] = carry; carry = ag[j].x * carry + ag[j].y; }
    }
}

DI float grp8_max(float v) { v = fmaxf(v, __shfl_xor(v, 1)); v = fmaxf(v, __shfl_xor(v, 2)); v = fmaxf(v, __shfl_xor(v, 4)); return v; }
constexpr int XP = 1032;
typedef float f32x4_t __attribute__((ext_vector_type(4)));
DI void norm2_router_unit(const Params& p, int layer, int r0, char* smem) {
    bf16_t* xh = (bf16_t*)smem;
    bf16_t* xl = xh + 16 * XP;
    float* lg = (float*)(xl + 16 * XP);
    float* ch = lg + 16 * 64;
    int* hist = (int*)(ch + 16 * 64);
    bf16_t* H2 = (bf16_t*)p.x4;
    const int t = tid(), lane = t & 63, wave = t >> 6;
    if (t < NSEGC) hist[t] = 0;
    const int l15 = lane & 15, q = lane >> 4;
    const bf16_t* bh = p.rwh + ((size_t)layer * 64 + wave * 16 + l15) * 1024 + q * 8;
    const bf16_t* bl = p.rwl + ((size_t)layer * 64 + wave * 16 + l15) * 1024 + q * 8;
    bf16x8 wA[8][2], wB[8][2];
#define RT_LOADW(w, k0) do { _Pragma("unroll") for (int i_ = 0; i_ < 8; ++i_) { w[i_][0] = *(const bf16x8*)(bh + ((k0) + i_) * 32); w[i_][1] = *(const bf16x8*)(bl + ((k0) + i_) * 32); } } while (0)
    RT_LOADW(wA, 0);
    {
        float4 v[4][4]; float ssv[4];
#pragma unroll
        for (int rr = 0; rr < 4; ++rr) {
            const float* src = res_row(p, r0 + wave * 4 + rr);
#pragma unroll
            for (int i = 0; i < 4; ++i) v[rr][i] = *(const float4*)(src + lane * 4 + 256 * i);
        }
#pragma unroll
        for (int rr = 0; rr < 4; ++rr) {
            float ss = 0.f;
#pragma unroll
            for (int i = 0; i < 4; ++i) ss += v[rr][i].x * v[rr][i].x + v[rr][i].y * v[rr][i].y + v[rr][i].z * v[rr][i].z + v[rr][i].w * v[rr][i].w;
            ssv[rr] = wave_sum(ss);
        }
#pragma unroll
        for (int rr = 0; rr < 4; ++rr) {
            const int lr = wave * 4 + rr, r = r0 + lr;
            const float* md = p.mod + (size_t)(layer * 5 + mod_row(r)) * 6144 + 3072;
            const float rinv = rsqrtf(ssv[rr] * (1.f / 1024.f) + EPSV);
#pragma unroll
            for (int i = 0; i < 4; ++i) {
                const int c = lane * 4 + 256 * i;
                const float4 sh = *(const float4*)(md + c), sc = *(const float4*)(md + 1024 + c);
                float4 o;
                o.x = v[rr][i].x * rinv * (1.f + sc.x) + sh.x; o.y = v[rr][i].y * rinv * (1.f + sc.y) + sh.y; o.z = v[rr][i].z * rinv * (1.f + sc.z) + sh.z; o.w = v[rr][i].w * rinv * (1.f + sc.w) + sh.w;
                uint2 ob; ob.x = pk_bf16(o.x, o.y); ob.y = pk_bf16(o.z, o.w);
                *(uint2*)(H2 + (size_t)r * DM + c) = ob;
                *(uint2*)(xh + lr * XP + c) = ob;
                uint2 ol; ol.x = pk_bf16(o.x - bflo(ob.x), o.y - bfhi(ob.x)); ol.y = pk_bf16(o.z - bflo(ob.y), o.w - bfhi(ob.y));
                *(uint2*)(xl + lr * XP + c) = ol;
            }
        }
    }
    __syncthreads();
    {
        const bf16_t* ah = xh + l15 * XP + q * 8;
        const bf16_t* al = xl + l15 * XP + q * 8;
        f32x4_t acc = {0.f, 0.f, 0.f, 0.f};
#define RT_MMA(w, k0) do { _Pragma("unroll") for (int i_ = 0; i_ < 8; ++i_) { \
            const bf16x8 fah = *(const bf16x8*)(ah + ((k0) + i_) * 32), fal = *(const bf16x8*)(al + ((k0) + i_) * 32); \
            acc = __builtin_amdgcn_mfma_f32_16x16x32_bf16(fah, w[i_][0], acc, 0, 0, 0); \
            acc = __builtin_amdgcn_mfma_f32_16x16x32_bf16(fah, w[i_][1], acc, 0, 0, 0); \
            acc = __builtin_amdgcn_mfma_f32_16x16x32_bf16(fal, w[i_][0], acc, 0, 0, 0); } } while (0)
        RT_LOADW(wB, 8);  RT_MMA(wA, 0);
        RT_LOADW(wA, 16); RT_MMA(wB, 8);
        RT_LOADW(wB, 24); RT_MMA(wA, 16);
        RT_MMA(wB, 24);
#undef RT_LOADW
#undef RT_MMA
        const int e = wave * 16 + l15;
        const float bias = p.in[27][layer * 64 + e];
#pragma unroll
        for (int j = 0; j < 4; ++j) { const float s = sigm(acc[j]); lg[(q * 4 + j) * 64 + e] = s; ch[(q * 4 + j) * 64 + e] = s + bias; }
    }
    __syncthreads();
    for (int rr = 0; rr < 4; ++rr) {
        const int lr = wave * 4 + rr, r = r0 + lr;
        const float c = ch[lr * 64 + lane], s = lg[lr * 64 + lane];
        const int g = lane >> 3;
        const float m1 = grp8_max(c);
        const unsigned long long bal = __ballot(c == m1);
        const int first = __ffs((unsigned)((bal >> (8 * g)) & 0xffull)) - 1;
        const float m2 = grp8_max(((lane & 7) == first) ? -3.0e38f : c);
        const float gsc = m1 + m2;
        int grank = 0;
#pragma unroll
        for (int gi = 0; gi < 8; ++gi) { const float o = __shfl(gsc, gi * 8); grank += (o > gsc || (o == gsc && gi < g)) ? 1 : 0; }
        const bool gsel = grank < 4;
        const float cand = gsel ? c : -3.0e38f;
        int erank = 0;
#pragma unroll 8
        for (int e2 = 0; e2 < 64; ++e2) { const float o = __shfl(cand, e2); erank += (o > cand || (o == cand && e2 < lane)) ? 1 : 0; }
        const bool sel = gsel && erank < 8;
        const float wsum = wave_sum(sel ? s : 0.f);
        if (sel) { p.tk_e[(size_t)r * 8 + erank] = lane; p.tk_w[(size_t)r * 8 + erank] = s * 2.5f / wsum; atomicAdd(&hist[lane], 1); }
        if (lane == 0) atomicAdd(&hist[64], 1);
    }
    __syncthreads();
    if (t < NSEGC && hist[t] > 0) atomicAdd(&p.cnt[(layer * 2 + 0) * NSEG + (r0 / p.chrows) * NSEGC + t], hist[t]);
    __syncthreads();
}
DI void phase_norm2_router(const Params& p, int layer, char* smem) {
    if (layer == 0) { for (int u = unit_first(); u < NT / 16; u += gridDim.x) norm2_router_unit(p, 0, u * 16, smem); }
    else { for (int u = unit_first(); u < NB * LX / 16; u += gridDim.x) norm2_router_unit(p, 1, (u / (LX / 16)) * LT + LC + (u % (LX / 16)) * 16, smem); }
}

DI void slots_unit(const Params& p, int layer, int r0, char* smem) {
    int* soff = (int*)smem;
    int* lcnt = soff + 272;
    int* lbase = lcnt + 80;
    const int t = tid();
    const int* cnt = p.cnt + (layer * 2 + 0) * NSEG;
    int* fill = p.cnt + (layer * 2 + 1) * NSEG;
    int* wsum = lbase + 80;
    {
        const int lane = t & 63, wave = t >> 6, sA = 2 * t, sB = 2 * t + 1;
        const int cA = sA < NSEG ? __hip_atomic_load(cnt + sA, __ATOMIC_RELAXED, __HIP_MEMORY_SCOPE_AGENT) : 0;
        const int cB = sB < NSEG ? __hip_atomic_load(cnt + sB, __ATOMIC_RELAXED, __HIP_MEMORY_SCOPE_AGENT) : 0;
        int ic = cA + cB;
#pragma unroll
        for (int o = 1; o < 64; o <<= 1) { const int vc = shfl_up_i(ic, o, lane); if (lane >= o) ic += vc; }
        if (lane == 63) wsum[wave] = ic;
        if (t < NSEGC) lcnt[t] = 0;
        __syncthreads();
        int oc = 0;
#pragma unroll
        for (int w = 0; w < 4; ++w) if (w < wave) oc += wsum[w];
        const int ex = oc + ic - cA - cB;
        if (sA <= NSEG) soff[sA] = ex;
        if (sB <= NSEG) soff[sB] = ex + cA;
    }
    __syncthreads();
    const int r = r0 + t, cbase = (r0 / p.chrows) * NSEGC;
    int e[9], loc[9]; float w[9];
#pragma unroll
    for (int k = 0; k < 8; ++k) { e[k] = p.tk_e[(size_t)r * 8 + k]; w[k] = p.tk_w[(size_t)r * 8 + k]; }
    e[8] = 64; w[8] = 1.f;
#pragma unroll
    for (int k = 0; k < 9; ++k) loc[k] = atomicAdd(&lcnt[e[k]], 1);
    __syncthreads();
    if (t < NSEGC) lbase[t] = lcnt[t] > 0 ? atomicAdd(&fill[cbase + t], lcnt[t]) : 0;
    __syncthreads();
#pragma unroll
    for (int k = 0; k < 9; ++k) {
        const int pos = soff[cbase + e[k]] + lbase[e[k]] + loc[k];
        p.ppos[(size_t)r * 16 + k] = pos; p.stok[pos] = r; p.sw[pos] = w[k];
    }
    __syncthreads();
}
DI void phase_slots(const Params& p, int layer, char* smem) {
    if (layer == 0) { for (int u = unit_first(); u < NT / 256; u += gridDim.x) slots_unit(p, 0, u * 256, smem); }
    else { for (int u = unit_first(); u < NB * LX / 256; u += gridDim.x) slots_unit(p, 1, (u / (LX / 256)) * LT + LC + (u % (LX / 256)) * 256, smem); }
}

constexpr int SEG_LDS_OFF = 68608;
DI void seg_tables(const Params& p, int layer, int s_lo, int s_hi, int* soff, int* toff) {
    const int* cnt = p.cnt + (layer * 2 + 0) * NSEG;
    int* wsum = toff + 272;
    const int t = tid(), lane = t & 63, wave = t >> 6;
    const int sA = 2 * t, sB = 2 * t + 1;
    const int cA = sA < NSEG ? __hip_atomic_load(cnt + sA, __ATOMIC_RELAXED, __HIP_MEMORY_SCOPE_AGENT) : 0;
    const int cB = sB < NSEG ? __hip_atomic_load(cnt + sB, __ATOMIC_RELAXED, __HIP_MEMORY_SCOPE_AGENT) : 0;
    const int tA = (sA >= s_lo && sA < s_hi) ? (cA + 127) >> 7 : 0, tB = (sB >= s_lo && sB < s_hi) ? (cB + 127) >> 7 : 0;
    int ic = cA + cB, it = tA + tB;
#pragma unroll
    for (int o = 1; o < 64; o <<= 1) { const int vc = shfl_up_i(ic, o, lane), vt = shfl_up_i(it, o, lane); if (lane >= o) { ic += vc; it += vt; } }
    if (lane == 63) { wsum[wave * 2] = ic; wsum[wave * 2 + 1] = it; }
    __syncthreads();
    int oc = 0, ot = 0;
#pragma unroll
    for (int w = 0; w < 4; ++w) if (w < wave) { oc += wsum[w * 2]; ot += wsum[w * 2 + 1]; }
    const int exA_c = oc + ic - cA - cB, exA_t = ot + it - tA - tB;
    if (sA >= s_lo && sA < s_hi) { soff[sA - s_lo] = exA_c; toff[sA - s_lo] = exA_t; }
    if (sB >= s_lo && sB < s_hi) { soff[sB - s_lo] = exA_c + cA; toff[sB - s_lo] = exA_t + tA; }
    if (sA + 1 == s_hi) { soff[s_hi - s_lo] = exA_c + cA; toff[s_hi - s_lo] = exA_t + tA; }
    if (sB + 1 == s_hi) { soff[s_hi - s_lo] = exA_c + cA + cB; toff[s_hi - s_lo] = exA_t + tA + tB; }
    __syncthreads();
}
DI int seg_find(const int* toff, int nseg, int tile) {
    int lo = 0, hi = nseg;
    while (hi - lo > 1) { const int mid = (lo + hi) >> 1; if (toff[mid] <= tile) lo = mid; else hi = mid; }
    return lo;
}
struct EpiGateUp {
    bf16_t* HID; const float* sw; int pos_end;
    DI void operator()(const float* ct, int row0, int col0) const {
#pragma unroll 2
        for (int it = 0; it < 4; ++it) {
            const int idx = tid() + NTHR * it, row = idx >> 3, wn = (idx >> 2) & 1, j0 = (idx & 3) * 8, pos = row0 + row;
            if (pos < pos_end) {
                const float* gp = ct + row * CT_LD + wn * 64 + j0;
                const float w = sw[pos];
                float o[8];
#pragma unroll
                for (int j = 0; j < 8; ++j) o[j] = silu_f(gp[j]) * gp[32 + j] * w;
                uint4 ov; ov.x = pk_bf16(o[0], o[1]); ov.y = pk_bf16(o[2], o[3]); ov.z = pk_bf16(o[4], o[5]); ov.w = pk_bf16(o[6], o[7]);
                *(uint4*)(HID + (size_t)pos * FF + ((col0 >> 6) + wn) * 32 + j0) = ov;
            }
        }
    }
};
struct EpiRowsBf16 {
    bf16_t* O; int ld; int rbase; int row_end;
    DI void operator()(const float* ct, int row0, int col0) const {
#pragma unroll 2
        for (int it = 0; it < 8; ++it) {
            const int idx = tid() + NTHR * it, row = idx >> 4, c8 = (idx & 15) * 8;
            if (row0 + row < row_end) *(uint4*)(O + (size_t)(row0 + row - rbase) * ld + col0 + c8) = pack8(ct + row * CT_LD + c8);
        }
    }
};
DI void phase_moe_gemm1(const Params& p, int layer, char* smem) {
    int* soff = (int*)(smem + SEG_LDS_OFF); int* toff = soff + 272;
    seg_tables(p, layer, 0, NSEG, soff, toff);
    const int ntiles = toff[NSEG];
    const bf16_t* H2 = (const bf16_t*)p.x4;
    bf16_t* HID = (bf16_t*)p.x1;
    auto unit_fn = [&](int u, int srow, int wave, int lane) {
        const int tile = u >> 1, nt = u & 1;
        const int s = seg_find(toff, NSEG, tile), e = s % NSEGC;
        const int pos0 = soff[s] + (tile - toff[s]) * 128, pos_end = soff[s + 1];
        int p0 = pos0 + srow, p1 = p0 + 32, p2 = p0 + 64, p3 = p0 + 96;
        if (p0 >= pos_end) p0 = pos_end - 1;
        if (p1 >= pos_end) p1 = pos_end - 1;
        if (p2 >= pos_end) p2 = pos_end - 1;
        if (p3 >= pos_end) p3 = pos_end - 1;
        const int t0 = p.stok[p0], t1 = p.stok[p1], t2 = p.stok[p2], t3 = p.stok[p3];
        const bf16_t* bw = p.ew1 + ((size_t)e * 512 + nt * 256 + wave * 64) * 1024 + lane * 8;
        return GUnit<WEpiGateUp>{H2 + (size_t)t0 * DM, H2 + (size_t)t1 * DM, H2 + (size_t)t2 * DM, H2 + (size_t)t3 * DM, bw, pos0, nt * 256, 1024, WEpiGateUp{HID, p.sw, pos_end}};
    };
    gemm_stream_w<WEpiGateUp>(ntiles * 2, unit_fn, smem, (const char*)p.bar);
}
DI void phase_moe_gemm2(const Params& p, int layer, int chunk, char* smem) {
    const int* soff = (const int*)(smem + SEG_LDS_OFF) + chunk * NSEGC; const int* toff = (const int*)(smem + SEG_LDS_OFF) + 272 + chunk * NSEGC;
    const int tbase = toff[0];
    const int ntiles = toff[NSEGC] - tbase;
    const bf16_t* HID = (const bf16_t*)p.x1;
    unsigned char* YP = (unsigned char*)p.x2;
    const int cbase = soff[0];
    auto unit_fn = [&](int u, int srow, int wave, int lane) {
        const int tile = (u >> 2) + tbase, nt = u & 3;
        const int e = seg_find(toff, NSEGC, tile);
        const int pos0 = soff[e] + (tile - toff[e]) * 128, pos_end = soff[e + 1];
        int p0 = pos0 + srow, p1 = p0 + 32, p2 = p0 + 64, p3 = p0 + 96;
        if (p0 >= pos_end) p0 = pos_end - 1;
        if (p1 >= pos_end) p1 = pos_end - 1;
        if (p2 >= pos_end) p2 = pos_end - 1;
        if (p3 >= pos_end) p3 = pos_end - 1;
        const bf16_t* bw = p.ew2 + ((size_t)e * 1024 + nt * 256 + wave * 64) * 256 + lane * 8;
        return GUnit<WEpiRows8>{HID + (size_t)p0 * FF, HID + (size_t)p1 * FF, HID + (size_t)p2 * FF, HID + (size_t)p3 * FF, bw, pos0, nt * 256, 256, WEpiRows8{YP, cbase, pos_end}};
    };
    gemm_stream_w<WEpiRows8>(ntiles * 4, unit_fn, smem, (const char*)p.bar);
}
DI void phase_moe_combine(const Params& p, int layer, int chunk, char* smem) {
    const int cbase = ((const int*)(smem + SEG_LDS_OFF))[chunk * NSEGC];
    (void)layer;
    const unsigned char* YP = (const unsigned char*)p.x2;
    const int lane = tid() & 63, wave = tid() >> 6;
    const int rbeg = chunk * p.chrows;
    for (int u = unit_first(); u < p.chrows / 4; u += gridDim.x) {
        const int r = rbeg + u * 4 + wave;
        if (layer == 1 && (r % LT) < LC) continue;
        float* rp = res_row(p, r);
        const float* g2 = p.mod + (size_t)(layer * 5 + mod_row(r)) * 6144 + 5120;
        const int4 pp0 = *(const int4*)(p.ppos + (size_t)r * 16), pp1 = *(const int4*)(p.ppos + (size_t)r * 16 + 4);
        const int pp8 = p.ppos[(size_t)r * 16 + 8];
        const int ppv[9] = {pp0.x, pp0.y, pp0.z, pp0.w, pp1.x, pp1.y, pp1.z, pp1.w, pp8};
        uint4 yw[9];
#pragma unroll
        for (int k = 0; k < 9; ++k) yw[k] = *(const uint4*)(YP + (size_t)(ppv[k] - cbase) * DM + lane * 16);
        const int c0 = lane * 16;
        float4 gv[4], xv[4];
#pragma unroll
        for (int i = 0; i < 4; ++i) { gv[i] = *(const float4*)(g2 + c0 + 4 * i); xv[i] = *(const float4*)(rp + c0 + 4 * i); }
        float a[16];
#pragma unroll
        for (int j = 0; j < 16; ++j) a[j] = 0.f;
#pragma unroll
        for (int k = 0; k < 9; ++k) {
            const int dw[4] = {(int)yw[k].x, (int)yw[k].y, (int)yw[k].z, (int)yw[k].w};
#pragma unroll
            for (int d = 0; d < 4; ++d) {
                const f32x2_t lo = __builtin_amdgcn_cvt_pk_f32_fp8(dw[d], false), hi = __builtin_amdgcn_cvt_pk_f32_fp8(dw[d], true);
                a[4 * d] += lo[0]; a[4 * d + 1] += lo[1]; a[4 * d + 2] += hi[0]; a[4 * d + 3] += hi[1];
            }
        }
        constexpr float UNS = 1.f / YP_SCALE;
        float ss = 0.f;
#pragma unroll
        for (int i = 0; i < 4; ++i) {
            a[4 * i] = xv[i].x + gv[i].x * UNS * a[4 * i]; a[4 * i + 1] = xv[i].y + gv[i].y * UNS * a[4 * i + 1];
            a[4 * i + 2] = xv[i].z + gv[i].z * UNS * a[4 * i + 2]; a[4 * i + 3] = xv[i].w + gv[i].w * UNS * a[4 * i + 3];
            ss += a[4 * i] * a[4 * i] + a[4 * i + 1] * a[4 * i + 1] + a[4 * i + 2] * a[4 * i + 2] + a[4 * i + 3] * a[4 * i + 3];
        }
        ss = wave_sum(ss);
        const float rinv = rsqrtf(ss * (1.f / 1024.f) + EPSV);
        if (layer == 0) {
            const float* md1 = p.mod + (size_t)(5 + mod_row(r)) * 6144;
            unsigned ob[8];
#pragma unroll
            for (int i = 0; i < 4; ++i) {
                *(float4*)(rp + c0 + 4 * i) = make_float4(a[4 * i], a[4 * i + 1], a[4 * i + 2], a[4 * i + 3]);
                const float4 sh = *(const float4*)(md1 + c0 + 4 * i), sc = *(const float4*)(md1 + 1024 + c0 + 4 * i);
                ob[2 * i] = pk_bf16(a[4 * i] * rinv * (1.f + sc.x) + sh.x, a[4 * i + 1] * rinv * (1.f + sc.y) + sh.y);
                ob[2 * i + 1] = pk_bf16(a[4 * i + 2] * rinv * (1.f + sc.z) + sh.z, a[4 * i + 3] * rinv * (1.f + sc.w) + sh.w);
            }
            *(uint4*)(p.h1 + (size_t)r * DM + c0) = make_uint4(ob[0], ob[1], ob[2], ob[3]);
            *(uint4*)(p.h1 + (size_t)r * DM + c0 + 8) = make_uint4(ob[4], ob[5], ob[6], ob[7]);
        } else {
#pragma unroll
            for (int i = 0; i < 4; ++i) {
                const float4 f = *(const float4*)(p.in[34] + c0 + 4 * i);
                *(float4*)(rp + c0 + 4 * i) = make_float4(a[4 * i] * rinv * f.x, a[4 * i + 1] * rinv * f.y, a[4 * i + 2] * rinv * f.z, a[4 * i + 3] * rinv * f.w);
            }
        }
    }
}

DI bool bg_first() { return (((blockIdx.x >> 3) + (blockIdx.x >> 8)) & 1u) == 0u; }
DI void bg_cvt_experts(const Params& p, int layer, char* smem) {
    for (int u = unit_first(); u < CVT_EXP_TILES; u += gridDim.x) cvt_expert(p, layer, u, smem);
    __syncthreads();
}
constexpr int N_PHASES = 22;
template <int PH, int NCHT>
DI void run_phase(const Params& p, char* smem, const XcdBarrier& bar) {
    if constexpr (PH == 0) phase_prologue(p, smem);
    else if constexpr (PH == 1) phase_norm1(p, 0);
    else if constexpr (PH == 2) {
        WEpiInProj0 epi{&p};
        gemm_phase_w((const char*)p.bar, (const bf16_t*)p.x4, DM, p.w_in0, 1024, NT / 128, AB_IN / 256, smem, epi, RowIdent{});
    } else if constexpr (PH == 3) {
        for (int u = unit_first(); u < NB * NCHUNK_T * 8; u += gridDim.x) lru_unit<1>(p, u, smem);
    } else if constexpr (PH == 4) {
        const bool bf = bg_first();
        if (bf) bg_cvt_experts(p, 0, smem);
        for (int u = unit_first(); u < 16 + NB * 4 * 64 + NB * 4 * 2; u += gridDim.x) { if (u < 16) lru_carry_unit(p, u); else attn0_unit(p, u - 16, smem); }
        if (!bf) { __syncthreads(); bg_cvt_experts(p, 0, smem); }
    } else if constexpr (PH == 5) {
        for (int u = unit_first(); u < NB * NCHUNK_T * 8; u += gridDim.x) lru_unit<3>(p, u, smem);
    } else if constexpr (PH == 6) {
        WEpiResidual epi{&p, 0};
        gemm_phase_w((const char*)p.bar, (const bf16_t*)p.x4, DM, p.w_out0, 1024, NT / 128, 4, smem, epi, RowIdent{});
    } else if constexpr (PH == 7) phase_norm2_router(p, 0, smem);
    else if constexpr (PH == 8) phase_slots(p, 0, smem);
    else if constexpr (PH == 9) phase_moe_gemm1(p, 0, smem);
    else if constexpr (PH == 10) {
        phase_moe_gemm2(p, 0, 0, smem); xcd_barrier(bar); phase_moe_combine(p, 0, 0, smem); xcd_barrier(bar);
        phase_moe_gemm2(p, 0, 1, smem); xcd_barrier(bar); phase_moe_combine(p, 0, 1, smem);
        if constexpr (NCHT >= 3) {
            xcd_barrier(bar);
            phase_moe_gemm2(p, 0, 2, smem); xcd_barrier(bar); phase_moe_combine(p, 0, 2, smem);
        }
        if constexpr (NCHT == 4) {
            xcd_barrier(bar);
            phase_moe_gemm2(p, 0, 3, smem); xcd_barrier(bar); phase_moe_combine(p, 0, 3, smem);
        }
    } else if constexpr (PH == 11) {   }
    else if constexpr (PH == 12) {
        WEpiSplit epi{(bf16_t*)p.x1, CD_INP, (bf16_t*)p.x1, CD_INP, 1 << 30, 1 << 30};
        gemm_phase_w((const char*)p.bar, p.h1, DM, p.w_in1, 1024, NT / 128, CD_INP / 256, smem, epi, RowIdent{});
    } else if constexpr (PH == 13) {
        for (int u = unit_first(); u < NT / 64; u += gridDim.x) postproj1a_unit(p, u, smem);
    } else if constexpr (PH == 14) {
        bf16_t* CQn = (bf16_t*)(p.x1 + (size_t)NT * CD_INP * 2);
        bf16_t* CKVn = CQn + (size_t)NT * 256;
        bf16_t* MQraw = (bf16_t*)p.x1;
        bf16_t* MKVraw = MQraw + (size_t)NT * 384;
        auto unit_fn = [&](int u, int srow, int wave, int lane) {
            if (u < (NT / 128) * 2) {
                const int mt = u >> 1, nt = u & 1, row0 = mt * 128;
                const bf16_t* ap = CQn + (size_t)(row0 + srow) * 256;
                const bf16_t* bw = p.w_uq + (size_t)(nt * 256 + wave * 64) * 256 + lane * 8;
                return GUnit<WEpiSplit>{ap, ap + (size_t)32 * 256, ap + (size_t)64 * 256, ap + (size_t)96 * 256, bw, row0, nt * 256, 256, WEpiSplit{MQraw, 384, MQraw, 384, 1 << 30, 384}};
            }
            const int v = u - (NT / 128) * 2, mt = v / 3, nt = v - mt * 3, row0 = mt * 128;
            const bf16_t* ap = CKVn + (size_t)(row0 + srow) * 128;
            const bf16_t* bw = p.w_ukv + (size_t)(nt * 256 + wave * 64) * 128 + lane * 8;
            return GUnit<WEpiSplit>{ap, ap + (size_t)32 * 128, ap + (size_t)64 * 128, ap + (size_t)96 * 128, bw, row0, nt * 256, 128, WEpiSplit{MKVraw, 768, MKVraw, 768, 1 << 30, 768}};
        };
        gemm_stream_w<WEpiSplit>((NT / 128) * 5, unit_fn, smem, (const char*)p.bar);
    } else if constexpr (PH == 15) {
        for (int u = unit_first(); u < NT / 64; u += gridDim.x) postproj1c_unit(p, u, smem);
    } else if constexpr (PH == 16) {
        const bool bf = bg_first();
        if (bf) bg_cvt_experts(p, 1, smem);
        for (int u = unit_first(); u < 4096; u += gridDim.x) attn1_unit(p, u, smem);
        if (!bf) { __syncthreads(); bg_cvt_experts(p, 1, smem); }
    } else if constexpr (PH == 17) {
        WEpiResidual epi{&p, 1};
        gemm_phase_w((const char*)p.bar, (const bf16_t*)p.x4, DM, p.w_out1, 1024, NB * 64, 4, smem, epi, RowLatent{});
    } else if constexpr (PH == 18) phase_norm2_router(p, 1, smem);
    else if constexpr (PH == 19) phase_slots(p, 1, smem);
    else if constexpr (PH == 20) phase_moe_gemm1(p, 1, smem);
    else if constexpr (PH == 21) {
        phase_moe_gemm2(p, 1, 0, smem); xcd_barrier(bar); phase_moe_combine(p, 1, 0, smem); xcd_barrier(bar);
        phase_moe_gemm2(p, 1, 1, smem); xcd_barrier(bar); phase_moe_combine(p, 1, 1, smem);
        if constexpr (NCHT >= 3) {
            xcd_barrier(bar);
            phase_moe_gemm2(p, 1, 2, smem); xcd_barrier(bar); phase_moe_combine(p, 1, 2, smem);
        }
        if constexpr (NCHT == 4) {
            xcd_barrier(bar);
            phase_moe_gemm2(p, 1, 3, smem); xcd_barrier(bar); phase_moe_combine(p, 1, 3, smem);
        }
    }
}

extern __shared__ __attribute__((aligned(16))) char dyn_smem[];

template <int PH, int HI, int NCHT>
DI void run_range(const Params& p, char* smem, const XcdBarrier& bar) {
    if constexpr (PH < HI) {
        run_phase<PH, NCHT>(p, smem, bar);
        if constexpr ((MK_REPEAT_MASK >> PH) & 1ull) { __syncthreads(); run_phase<PH, NCHT>(p, smem, bar); }
        if constexpr (PH + 1 < HI) { if constexpr (PH != 11) xcd_barrier(bar); run_range<PH + 1, HI, NCHT>(p, smem, bar); }
    }
}

template <int LO, int HI, int NCHT>
__global__ void __launch_bounds__(NTHR, 2) __attribute__((amdgpu_waves_per_eu(2, 2))) mk_kernel(Params p) {
    char* smem = dyn_smem + SM_OFF;
    if (threadIdx.x == 0) *(uint4*)dyn_smem = make_uint4(0u, 0u, 0u, 0u);
    __syncthreads();
    XcdBarrier bar = xcd_barrier_post(p.bar, (volatile LAS unsigned*)dyn_smem);
    run_range<LO, HI, NCHT>(p, smem, bar);
}

static size_t align_up(size_t x, size_t a) { return (x + a - 1) / a * a; }

extern "C" void kernel_launch(void* const* d_in, const int* in_sizes, int n_in, void* d_out, int out_size, void* d_ws, size_t ws_size, hipStream_t stream) {
    (void)in_sizes; (void)n_in; (void)out_size; (void)ws_size;
    Params p;
    memset(&p, 0, sizeof(p));
    for (int i = 0; i < 35; ++i) p.in[i] = (const float*)d_in[i];
    p.out = (float*)d_out;
    char* ws = (char*)d_ws;
    size_t off = 0;
    auto take = [&](size_t bytes) { char* r = ws + off; off = align_up(off + bytes, 256); return r; };
    const size_t zero_bytes = 16384 + 8192;
    p.bar = (unsigned*)take(16384);
    p.cnt = (int*)take(8192);
    p.kmax = (unsigned*)(p.cnt + 1536);
    p.mod = (float*)take((size_t)2 * 5 * 6144 * 4);
    p.tab = (float*)take((size_t)TB_TOTAL * 4);
    p.lamv = (float*)take(256);
    p.w_in0 = (bf16_t*)take((size_t)2560 * 1024 * 2);
    p.w_out0 = (bf16_t*)take((size_t)1024 * 1024 * 2);
    p.w_in1 = (bf16_t*)take((size_t)1280 * 1024 * 2);
    p.w_out1 = (bf16_t*)take((size_t)1024 * 1024 * 2);
    p.w_uq = (bf16_t*)take((size_t)512 * 256 * 2);
    p.w_ukv = (bf16_t*)take((size_t)768 * 128 * 2);
    p.lw = (bf16_t*)take((size_t)64 * 32 * 64 * 2);
    p.rwh = (bf16_t*)take((size_t)2 * 64 * 1024 * 2);
    p.rwl = (bf16_t*)take((size_t)2 * 64 * 1024 * 2);
    p.ew1 = (bf16_t*)take((size_t)65 * 512 * 1024 * 2);
    p.ew2 = (bf16_t*)take((size_t)65 * 1024 * 256 * 2);
    p.rc = (float*)take((size_t)NB * LC * DM * 4);
    p.tk_e = (int*)take((size_t)NT * 8 * 4);
    p.tk_w = (float*)take((size_t)NT * 8 * 4);
    p.ppos = (int*)take((size_t)NT * 16 * 4);
    p.stok = (int*)take((size_t)NPAIR * 4);
    p.sw = (float*)take((size_t)NPAIR * 4);
    p.agg = (float*)take((size_t)NB * NCHUNK_T * 2 * 512 * 2 * 4);
    p.carry = (float*)take((size_t)NB * NCHUNK_T * 2 * 512 * 4);
    p.x1 = take((size_t)NT * 2560 * 2);
    p.x2 = take((size_t)NB * LT * 2048 * 2);
    p.x4 = take((size_t)NT * DM * 2);
    p.h1 = (bf16_t*)take((size_t)NT * DM * 2);
    p.nch = 2;
    p.chrows = NT / p.nch;
    static bool warned = false;
    if (off > ws_size && !warned) { fprintf(stderr, "workspace too small: need %zu have %zu\n", off, ws_size); warned = true; }

    (void)hipMemsetAsync(d_ws, 0, zero_bytes, stream);
    static int grid = 0;
    if (!grid) {
        int dev = 0, cus = 0, per_cu = 2;
        (void)hipGetDevice(&dev);
        (void)hipDeviceGetAttribute(&cus, hipDeviceAttributeMultiprocessorCount, dev);
        (void)hipFuncSetAttribute((const void*)mk_kernel<0, N_PHASES, 2>, hipFuncAttributeMaxDynamicSharedMemorySize, SMEM_BYTES);
        int q2 = 0, q4 = 0;
        q2 = 2;
        (void)hipOccupancyMaxActiveBlocksPerMultiprocessor(&q4, (const void*)mk_kernel<0, N_PHASES, 2>, NTHR, SMEM_BYTES);
        per_cu = q2 < q4 ? q2 : q4;
        if (per_cu > 2) per_cu = 2;
        if (per_cu < 1) per_cu = 1;
        grid = cus * per_cu;
    }
    hipLaunchKernelGGL((mk_kernel<0, N_PHASES, 2>), dim3(grid), dim3(NTHR), SMEM_BYTES, stream, p);
}
```
